# Optimizing an MI355X kernel written in HIP

```python
import math
import jax, jax.numpy as jnp
from jax import lax
import numpy as np

D_MODEL = 2048
BATCH = 1
SEQ = 16384
DEPTH = 2
DEC_BATCH = 16
DEC_SEQ = 16
PAST_LEN = 2048

CHUNK = 64
N_META = 16
N_A = DEPTH // 2
N_B = DEPTH - N_A
D_FF = 5632
D_RNN = D_MODEL
N_RG_BLOCKS = 16
RG_BLOCK = D_RNN // N_RG_BLOCKS
CONV_W = 4
LRU_C = 8.0
N_HEADS = 16
HEAD_DIM = D_MODEL // (2 * N_HEADS)
V_HEAD_DIM = 2 * HEAD_DIM
QK_WIDTH = N_HEADS * 2 * HEAD_DIM
V_WIDTH = N_HEADS * V_HEAD_DIM
Q_BLOCK = 128
EPS = 1e-6

kernel_name = 'hybrid_rglru_diffattn_yoco_stream_step'


def _rms(x, g):
    x32 = x.astype(jnp.float32)
    y = x32 * lax.rsqrt(jnp.mean(x32 * x32, axis=-1, keepdims=True) + EPS)
    return (y * g.astype(jnp.float32)).astype(x.dtype)


def _swiglu(u, w_gate, w_up, w_down):
    return (jax.nn.silu(u @ w_gate) * (u @ w_up)) @ w_down


def _alibi_slopes():
    return 2.0 ** (-8.0 * jnp.arange(1, N_HEADS + 1, dtype=jnp.float32) / N_HEADS)


def _lambda_init(layer_idx):
    return 0.8 - 0.6 * math.exp(-0.3 * layer_idx)


def _lin_combine(e1, e2):
    a1, b1 = e1
    a2, b2 = e2
    return a1 * a2, a2 * b1 + b2


def _rglru_mixer(u, conv_state, h_state, w_in, conv_w, conv_b, gate_w, gate_b, lam, w_out):
    B, T, _ = u.shape
    proj = u @ w_in
    gate_br, xb = proj[..., :D_RNN], proj[..., D_RNN:]
    xp = jnp.concatenate([conv_state.astype(xb.dtype), xb], axis=1)
    new_conv = xp[:, T:]
    xc = conv_b
    for k in range(CONV_W):
        xc = xc + xp[:, k:k + T] * conv_w[k]
    xg = xc.reshape(B, T, N_RG_BLOCKS, RG_BLOCK)
    g = jnp.einsum('btnc,kncd->kbtnd', xg, gate_w).reshape(2, B, T, D_RNN) + gate_b[:, None, None, :]
    r = jax.nn.sigmoid(g[0].astype(jnp.float32))
    i = jax.nn.sigmoid(g[1].astype(jnp.float32))
    log_a = LRU_C * r * jax.nn.log_sigmoid(lam.astype(jnp.float32))
    a = jnp.exp(log_a)
    b = jnp.sqrt(-jnp.expm1(2.0 * log_a)) * (i * xc.astype(jnp.float32))
    b = b.at[:, 0].add(a[:, 0] * h_state.astype(jnp.float32))
    _, h = lax.associative_scan(_lin_combine, (a, b), axis=1)
    y = (jax.nn.gelu(gate_br) * h.astype(u.dtype)) @ w_out
    return y, new_conv, h[:, -1].astype(h_state.dtype)


def _diff_attn_block(q, q_pos, q_chunk, k, v, k_pos, k_chunk, lam, sub_g, lam_init):
    s = jnp.einsum('bqhcd,bkhcd->bchqk', q, k).astype(jnp.float32) * (HEAD_DIM ** -0.5)
    dist = jnp.abs(q_pos[:, None] - k_pos[None, :]).astype(jnp.float32)
    bias = -_alibi_slopes()[:, None, None] * dist[None]
    allowed = k_chunk[None, :] <= q_chunk[:, None]
    s = jnp.where(allowed, s + bias, -jnp.inf)
    p = jax.nn.softmax(s, axis=-1)
    w = p[:, 0] - lam * p[:, 1]
    o = jnp.einsum('bhqk,bkhe->bqhe', w.astype(v.dtype), v)
    return _rms(o, sub_g) * (1.0 - lam_init)


def _diff_attn_mixer(u, k_all, v_all, k_pos, k_chunk, q_pos, q_chunk, w_q, q_g, lam_vecs, sub_g, w_o, lam_init):
    B, T, _ = u.shape
    q = _rms((u @ w_q).reshape(B, T, N_HEADS, 2, HEAD_DIM), q_g)
    lv = lam_vecs.astype(jnp.float32)
    lam = jnp.exp(jnp.sum(lv[0] * lv[1])) - jnp.exp(jnp.sum(lv[2] * lv[3])) + lam_init
    if T <= Q_BLOCK:
        o = _diff_attn_block(q, q_pos, q_chunk, k_all, v_all, k_pos, k_chunk, lam, sub_g, lam_init)
    else:
        nb = T // Q_BLOCK
        qb = jnp.moveaxis(q.reshape(B, nb, Q_BLOCK, N_HEADS, 2, HEAD_DIM), 1, 0)
        ob = lax.map(lambda a: _diff_attn_block(a[0], a[1], a[2], k_all, v_all, k_pos, k_chunk, lam, sub_g, lam_init),
                     (qb, q_pos.reshape(nb, Q_BLOCK), q_chunk.reshape(nb, Q_BLOCK)))
        o = jnp.moveaxis(ob, 0, 1)
    return o.reshape(B, T, V_WIDTH) @ w_o


def _shared_kv(h, kv_g, w_kv, k_g):
    B, T, _ = h.shape
    kv = _rms(h, kv_g) @ w_kv
    k = _rms(kv[..., :QK_WIDTH].reshape(B, T, N_HEADS, 2, HEAD_DIM), k_g)
    v = kv[..., QK_WIDTH:].reshape(B, T, N_HEADS, V_HEAD_DIM)
    return k, v


def setup_inputs(seed: int = 0) -> dict:
    key = jax.random.key(seed)
    ks = jax.random.split(key, 32)
    f32 = jnp.float32

    def nrm(k, shape, scale=1.0):
        return jax.random.normal(k, shape, f32) * scale

    def gain(k, shape):
        return 1.0 + 0.01 * jax.random.normal(k, shape, f32)

    a0 = jax.random.uniform(ks[17], (N_A, D_RNN), f32, 0.9, 0.999)
    return {
        'x_prompt': nrm(ks[0], (BATCH, SEQ, D_MODEL)),
        'x_sample': nrm(ks[1], (DEC_BATCH, DEC_SEQ, D_MODEL)),
        'cache_k': nrm(ks[2], (DEC_BATCH, PAST_LEN, N_HEADS, 2, HEAD_DIM)),
        'cache_v': nrm(ks[3], (DEC_BATCH, PAST_LEN, N_HEADS, V_HEAD_DIM)),
        'state_conv': nrm(ks[4], (N_A, DEC_BATCH, CONV_W - 1, D_RNN)),
        'state_h': nrm(ks[5], (N_A, DEC_BATCH, D_RNN), 0.5),
        'meta_tokens': nrm(ks[6], (N_META, D_MODEL)),
        'ffn_norm': gain(ks[7], (DEPTH, 2, D_MODEL)),
        'ffn_w_gate': nrm(ks[8], (DEPTH, 2, D_MODEL, D_FF), D_MODEL ** -0.5),
        'ffn_w_up': nrm(ks[9], (DEPTH, 2, D_MODEL, D_FF), D_MODEL ** -0.5),
        'ffn_w_down': nrm(ks[10], (DEPTH, 2, D_FF, D_MODEL), D_FF ** -0.5),
        'rg_norm': gain(ks[11], (N_A, D_MODEL)),
        'rg_w_in': nrm(ks[12], (N_A, D_MODEL, 2 * D_RNN), D_MODEL ** -0.5),
        'rg_conv_w': nrm(ks[13], (N_A, CONV_W, D_RNN), CONV_W ** -0.5),
        'rg_conv_b': nrm(ks[14], (N_A, D_RNN), 0.01),
        'rg_gate_w': nrm(ks[15], (N_A, 2, N_RG_BLOCKS, RG_BLOCK, RG_BLOCK), RG_BLOCK ** -0.5),
        'rg_gate_b': nrm(ks[16], (N_A, 2, D_RNN), 0.01),
        'rg_lambda': jnp.log(a0) - jnp.log1p(-a0),
        'rg_w_out': nrm(ks[18], (N_A, D_RNN, D_MODEL), D_RNN ** -0.5),
        'kv_norm': gain(ks[19], (D_MODEL,)),
        'w_kv': nrm(ks[20], (D_MODEL, QK_WIDTH + V_WIDTH), D_MODEL ** -0.5),
        'k_norm': gain(ks[21], (HEAD_DIM,)),
        'attn_norm': gain(ks[22], (N_B, D_MODEL)),
        'w_q': nrm(ks[23], (N_B, D_MODEL, QK_WIDTH), D_MODEL ** -0.5),
        'q_norm': gain(ks[24], (N_B, HEAD_DIM)),
        'diff_lambda': nrm(ks[25], (N_B, 4, HEAD_DIM), 0.1),
        'sub_norm': gain(ks[26], (N_B, V_HEAD_DIM)),
        'w_o': nrm(ks[27], (N_B, V_WIDTH, D_MODEL), V_WIDTH ** -0.5),
    }


def reference(x_prompt, x_sample, cache_k, cache_v, state_conv, state_h, meta_tokens,
              ffn_norm, ffn_w_gate, ffn_w_up, ffn_w_down,
              rg_norm, rg_w_in, rg_conv_w, rg_conv_b, rg_gate_w, rg_gate_b, rg_lambda, rg_w_out,
              kv_norm, w_kv, k_norm,
              attn_norm, w_q, q_norm, diff_lambda, sub_norm, w_o):
    def ffn_half(x, l, s):
        u = _rms(x, ffn_norm[l, s])
        return x + 0.5 * _swiglu(u, ffn_w_gate[l, s], ffn_w_up[l, s], ffn_w_down[l, s])

    def rg_layer(x, conv_st, h_st, l):
        x = ffn_half(x, l, 0)
        y, conv_new, h_new = _rglru_mixer(_rms(x, rg_norm[l]), conv_st, h_st, rg_w_in[l], rg_conv_w[l],
                                          rg_conv_b[l], rg_gate_w[l], rg_gate_b[l], rg_lambda[l], rg_w_out[l])
        return ffn_half(x + y, l, 1), conv_new, h_new

    def diff_layer(x, j, k_all, v_all, k_pos, k_chunk, q_pos, q_chunk):
        l = N_A + j
        x = ffn_half(x, l, 0)
        x = x + _diff_attn_mixer(_rms(x, attn_norm[j]), k_all, v_all, k_pos, k_chunk, q_pos, q_chunk,
                                 w_q[j], q_norm[j], diff_lambda[j], sub_norm[j], w_o[j], _lambda_init(l))
        return ffn_half(x, l, 1)

    B, T_p, _ = x_prompt.shape
    B_s, T_s, _ = x_sample.shape
    past = cache_k.shape[1]
    i32 = jnp.int32
    meta_chunk = jnp.full((N_META,), -1, i32)
    kp_pos = jnp.arange(N_META + T_p, dtype=i32)
    kp_chunk = jnp.concatenate([meta_chunk, jnp.arange(T_p, dtype=i32) // CHUNK])
    qp_pos = N_META + jnp.arange(T_p, dtype=i32)
    qp_chunk = jnp.arange(T_p, dtype=i32) // CHUNK
    ks_pos = jnp.arange(N_META + past + T_s, dtype=i32)
    ks_chunk = jnp.concatenate([meta_chunk, jnp.arange(past + T_s, dtype=i32) // CHUNK])
    qs_pos = N_META + past + jnp.arange(T_s, dtype=i32)
    qs_chunk = (past + jnp.arange(T_s, dtype=i32)) // CHUNK

    x_m = meta_tokens[None]
    conv_zero = jnp.zeros((1, CONV_W - 1, D_RNN), meta_tokens.dtype)
    h_zero = jnp.zeros((1, D_RNN), meta_tokens.dtype)
    x_p, x_s = x_prompt, x_sample
    conv_p, h_p, conv_s, h_s = [], [], [], []
    for l in range(DEPTH):
        if l < N_A:
            x_m, conv_m, h_m = rg_layer(x_m, conv_zero, h_zero, l)
            x_p, c, h = rg_layer(x_p, jnp.broadcast_to(conv_m, (B, CONV_W - 1, D_RNN)),
                                 jnp.broadcast_to(h_m, (B, D_RNN)), l)
            conv_p.append(c)
            h_p.append(h)
            x_s, c, h = rg_layer(x_s, state_conv[l], state_h[l], l)
            conv_s.append(c)
            h_s.append(h)
        else:
            if l == N_A:
                k_m, v_m = _shared_kv(x_m, kv_norm, w_kv, k_norm)
                k_p, v_p = _shared_kv(x_p, kv_norm, w_kv, k_norm)
                k_s, v_s = _shared_kv(x_s, kv_norm, w_kv, k_norm)
                k_p_all = jnp.concatenate([jnp.broadcast_to(k_m, (B,) + k_m.shape[1:]), k_p], axis=1)
                v_p_all = jnp.concatenate([jnp.broadcast_to(v_m, (B,) + v_m.shape[1:]), v_p], axis=1)
                k_s_all = jnp.concatenate([jnp.broadcast_to(k_m, (B_s,) + k_m.shape[1:]),
                                           cache_k.astype(k_s.dtype), k_s], axis=1)
                v_s_all = jnp.concatenate([jnp.broadcast_to(v_m, (B_s,) + v_m.shape[1:]),
                                           cache_v.astype(v_s.dtype), v_s], axis=1)
            x_p = diff_layer(x_p, l - N_A, k_p_all, v_p_all, kp_pos, kp_chunk, qp_pos, qp_chunk)
            x_s = diff_layer(x_s, l - N_A, k_s_all, v_s_all, ks_pos, ks_chunk, qs_pos, qs_chunk)

    new_conv_p = jnp.stack(conv_p)
    new_h_p = jnp.stack(h_p)
    new_conv_s = jnp.stack(conv_s)
    new_h_s = jnp.stack(h_s)
    return (x_p, x_s, k_p_all, v_p_all, new_conv_p, new_h_p, k_s, v_s, new_conv_s, new_h_s)
```

```cpp
#include <hip/hip_runtime.h>
#include <cstdio>
#include <cstdint>
namespace pg8 {
#define PG8_LAS __attribute__((address_space(3)))
typedef unsigned short bf16_t;
typedef short bf16x8 __attribute__((ext_vector_type(8)));
typedef float f32x4 __attribute__((ext_vector_type(4)));
typedef unsigned u32x4 __attribute__((ext_vector_type(4)));
constexpr int BM = 256, BK = 64, HALF = 128, HTB = HALF * BK * 2  , STAGE_BYTES = 8 * HTB, NXCD = 8, WGM = 8;

__host__ __device__ __forceinline__ int lds_byte(int r, int c) { const int st = (r >> 4) * 2 + (c >> 5), rr = r & 15, cc = c & 31, ob = rr * 64 + cc * 2; return st * 1024 + (ob ^ (((ob >> 9) & 1) << 5)); }
__host__ __device__ __forceinline__ void stage_rc(int b, int& R, int& C) { const int st = b / 1024, sb = b % 1024, swz = sb ^ (((sb >> 9) & 1) << 5); R = (st >> 1) * 16 + swz / 64; C = (st & 1) * 32 + (swz % 64) / 2; }
__host__ __device__ __forceinline__ int perm32(int rho) { const int n = rho >> 4, i = rho & 15; return 8 * (i >> 2) + 4 * n + (i & 3); }

struct Unit { int pm, pn, kt0, nt, nsplit, slab, cidx, half; };
struct Gemm { const bf16_t* A; const bf16_t* Bt; int M, N, K; };

struct StaticOrder {
    int nM, nN, nwg, G, c;
    __host__ __device__ void init(int M, int N, int G_, int c_) { nM = M / BM; nN = N / BM; nwg = nM * nN; G = G_; c = c_; }
    __host__ __device__ bool next(int i, Unit& u) const {
        const long L = (long)i * G + c; if (L >= nwg) return false;
        int wgid = (int)L; { const int q = nwg / NXCD, r = nwg % NXCD, xcd = wgid % NXCD, off = wgid / NXCD; wgid = (xcd < r ? xcd * (q + 1) : r * (q + 1) + (xcd - r) * q) + off; }
        const int nig = WGM * nN, gid = wgid / nig, fm = gid * WGM, gsz = (nM - fm) < WGM ? (nM - fm) : WGM;
        u.pm = 2 * (fm + ((wgid % nig) % gsz)); u.pn = (wgid % nig) / gsz; u.kt0 = 0; u.nt = 0; u.nsplit = 1; u.slab = 0; u.cidx = 0; u.half = 0; return true;
    }
    __device__ __forceinline__ void a_ready(const Unit&) const {}
    __device__ __forceinline__ void done(const Unit&) const {}
};

__device__ __forceinline__ unsigned cvt_pk_bf16(float lo, float hi) { unsigned r; asm volatile("v_cvt_pk_bf16_f32 %0, %1, %2" : "=v"(r) : "v"(lo), "v"(hi)); return r; }
constexpr float RMS_EPS = 1e-6f;
__device__ __forceinline__ float row_rstd(const float* ssq, int row) { return __builtin_amdgcn_rsqf(ssq[row] * (1.0f / 2048.0f) + RMS_EPS); }
__device__ __forceinline__ float fast_sigmoid(float x) { return __builtin_amdgcn_rcpf(1.0f + __builtin_amdgcn_exp2f(-1.4426950408889634f * x)); }
__device__ __forceinline__ u32x4 pack8(const f32x4 a, const f32x4 b) { u32x4 w; w.x = cvt_pk_bf16(a[0], a[1]); w.y = cvt_pk_bf16(a[2], a[3]); w.z = cvt_pk_bf16(b[0], b[1]); w.w = cvt_pk_bf16(b[2], b[3]); return w; }

struct EpiGU {
    static constexpr bool PERM = true, AFTER_DRAIN = false;
    bf16_t* H; const float* ssq;
    template <bool HF> __device__ __forceinline__ void run(const f32x4 (&acc)[2][2][4][2], const Unit& u, int wr, int wc, int fr, int fq) const {
        typedef float f2 __attribute__((ext_vector_type(2)));
        typedef __bf16 b2 __attribute__((ext_vector_type(2)));
        const int colh = u.pn * 128 + wc * 32 + 8 * fq;
        float rsv[8];
#pragma unroll
        for (int i = 0; i < (HF ? 4 : 8); ++i) rsv[i] = row_rstd(ssq, u.pm * HALF + (i >> 2) * HALF + wr * 64 + (i & 3) * 16 + fr);
#pragma unroll
        for (int ai = 0; ai < (HF ? 1 : 2); ++ai)
#pragma unroll
            for (int m = 0; m < 4; ++m) {
                const int row = u.pm * HALF + ai * HALF + wr * 64 + m * 16 + fr; const float rs = rsv[ai * 4 + m];
                const float nrs = -1.4426950408889634f * rs, rs2 = rs * rs;
                f2 g[4], up[4], t[4], r[4];
#pragma unroll
                for (int p = 0; p < 4; ++p) { g[p] = (f2){acc[ai][0][m][p >> 1][2 * (p & 1)], acc[ai][0][m][p >> 1][2 * (p & 1) + 1]}; up[p] = (f2){acc[ai][1][m][p >> 1][2 * (p & 1)], acc[ai][1][m][p >> 1][2 * (p & 1) + 1]}; }
#pragma unroll
                for (int p = 0; p < 4; ++p) t[p] = g[p] * (f2){nrs, nrs};
#pragma unroll
                for (int p = 0; p < 4; ++p) { t[p].x = __builtin_amdgcn_exp2f(t[p].x); t[p].y = __builtin_amdgcn_exp2f(t[p].y); }
#pragma unroll
                for (int p = 0; p < 4; ++p) { t[p] = t[p] + (f2){1.0f, 1.0f}; g[p] = g[p] * up[p]; }
#pragma unroll
                for (int p = 0; p < 4; ++p) { r[p].x = __builtin_amdgcn_rcpf(t[p].x); r[p].y = __builtin_amdgcn_rcpf(t[p].y); }
                u32x4 w;
#pragma unroll
                for (int p = 0; p < 4; ++p) { const f2 h = g[p] * (r[p] * (f2){rs2, rs2}); w[p] = __builtin_bit_cast(unsigned, __builtin_convertvector(h, b2)); }
                *(u32x4*)(H + (size_t)row * 5632 + colh) = w;
            }
    }
    __device__ __forceinline__ void operator()(const f32x4 (&acc)[2][2][4][2], const Unit& u, int wr, int wc, int fr, int fq) const { run<false>(acc, u, wr, wc, fr, fq); }
    __device__ __forceinline__ void half(const f32x4 (&acc)[2][2][4][2], const Unit& u, int wr, int wc, int fr, int fq) const { run<true>(acc, u, wr, wc, fr, fq); }
};
struct EpiRes {
    static constexpr bool PERM = true, AFTER_DRAIN = false;
    bf16_t* x16; float* ssq; float scale; int final_; float* yp; float* ys;
    template <bool HF> __device__ __forceinline__ void run(const f32x4 (&acc)[2][2][4][2], const Unit& u, int wr, int wc, int fr, int fq) const {
        const int col = u.pn * BM + wc * 64 + 8 * fq;
        u32x4 xw[HF ? 4 : 8][2];
#pragma unroll
        for (int i = 0; i < (HF ? 4 : 8); ++i) { const bf16_t* xq = x16 + (size_t)(u.pm * HALF + (i >> 2) * HALF + wr * 64 + (i & 3) * 16 + fr) * 2048 + col; xw[i][0] = *(const u32x4*)xq; xw[i][1] = *(const u32x4*)(xq + 32); }
#pragma unroll
        for (int ai = 0; ai < (HF ? 1 : 2); ++ai)
#pragma unroll
            for (int m = 0; m < 4; ++m) {
                const int row = u.pm * HALF + ai * HALF + wr * 64 + m * 16 + fr;
                bf16_t* xp = x16 + (size_t)row * 2048 + col; float sq = 0.f;
                float* op = nullptr;
                if (final_) { if (row >= 16 && row < 16400) op = yp + (size_t)(row - 16) * 2048 + col; else if (row >= 16400 && row < 16656) op = ys + (size_t)(row - 16400) * 2048 + col; }
                const u32x4 w0 = xw[ai * 4 + m][0], w1 = xw[ai * 4 + m][1];
#pragma unroll
                for (int bj = 0; bj < 2; ++bj) {
                    const u32x4 w = bj ? w1 : w0;
                    const f32x4 x0 = (f32x4){__uint_as_float(w.x << 16), __uint_as_float(w.x & 0xffff0000u), __uint_as_float(w.y << 16), __uint_as_float(w.y & 0xffff0000u)};
                    const f32x4 x1 = (f32x4){__uint_as_float(w.z << 16), __uint_as_float(w.z & 0xffff0000u), __uint_as_float(w.w << 16), __uint_as_float(w.w & 0xffff0000u)};
                    const f32x4 v0 = x0 + acc[ai][bj][m][0] * scale, v1 = x1 + acc[ai][bj][m][1] * scale;
                    if (final_) { if (op) { *(f32x4*)(op + 32 * bj) = v0; *(f32x4*)(op + 32 * bj + 4) = v1; } }
                    else { *(u32x4*)(xp + 32 * bj) = pack8(v0, v1);
                        sq += (v0[0] * v0[0] + v0[1] * v0[1]) + (v0[2] * v0[2] + v0[3] * v0[3]) + (v1[0] * v1[0] + v1[1] * v1[1]) + (v1[2] * v1[2] + v1[3] * v1[3]); }
                }
                if (!final_) { sq += __shfl_xor(sq, 16); sq += __shfl_xor(sq, 32); if (fq == 0) atomicAdd(ssq + row, sq); }
            }
    }
    __device__ __forceinline__ void operator()(const f32x4 (&acc)[2][2][4][2], const Unit& u, int wr, int wc, int fr, int fq) const { run<false>(acc, u, wr, wc, fr, fq); }
    __device__ __forceinline__ void half(const f32x4 (&acc)[2][2][4][2], const Unit& u, int wr, int wc, int fr, int fq) const { run<true>(acc, u, wr, wc, fr, fq); }
};
struct EpiWin {
    static constexpr bool PERM = true, AFTER_DRAIN = false;
    bf16_t* GG; float* XB; const float* ssq;
    template <bool HF> __device__ __forceinline__ void run(const f32x4 (&acc)[2][2][4][2], const Unit& u, int wr, int wc, int fr, int fq) const {
        const int col = (u.pn & 7) * BM + wc * 64 + 8 * fq; const bool isg = u.pn < 8;
        float rsv[HF ? 4 : 8];
#pragma unroll
        for (int i = 0; i < (HF ? 4 : 8); ++i) rsv[i] = row_rstd(ssq, u.pm * HALF + (i >> 2) * HALF + wr * 64 + (i & 3) * 16 + fr);
#pragma unroll
        for (int ai = 0; ai < (HF ? 1 : 2); ++ai)
#pragma unroll
            for (int m = 0; m < 4; ++m) {
                const int row = u.pm * HALF + ai * HALF + wr * 64 + m * 16 + fr; const float rs = rsv[ai * 4 + m];
#pragma unroll
                for (int bj = 0; bj < 2; ++bj) {
                    f32x4 v0 = acc[ai][bj][m][0] * rs, v1 = acc[ai][bj][m][1] * rs;
                    if (isg) {
#pragma unroll
                        for (int e = 0; e < 4; ++e) { const float a = v0[e], b = v1[e];
                            v0[e] = a * fast_sigmoid(1.5957691216057308f * (a + 0.044715f * a * a * a)); v1[e] = b * fast_sigmoid(1.5957691216057308f * (b + 0.044715f * b * b * b)); }
                        *(u32x4*)(GG + (size_t)row * 2048 + col + 32 * bj) = pack8(v0, v1);
                    } else { float* xp = XB + (size_t)row * 2048 + col + 32 * bj; *(f32x4*)xp = v0; *(f32x4*)(xp + 4) = v1; }
                }
            }
    }
    __device__ __forceinline__ void operator()(const f32x4 (&acc)[2][2][4][2], const Unit& u, int wr, int wc, int fr, int fq) const { run<false>(acc, u, wr, wc, fr, fq); }
    __device__ __forceinline__ void half(const f32x4 (&acc)[2][2][4][2], const Unit& u, int wr, int wc, int fr, int fq) const { run<true>(acc, u, wr, wc, fr, fq); }
};
__device__ __forceinline__ float group_rstd64(const f32x4 (&v)[2][2]) {
    float s = 0.f;
#pragma unroll
    for (int bj = 0; bj < 2; ++bj)
#pragma unroll
        for (int n = 0; n < 2; ++n) s += (v[bj][n][0] * v[bj][n][0] + v[bj][n][1] * v[bj][n][1]) + (v[bj][n][2] * v[bj][n][2] + v[bj][n][3] * v[bj][n][3]);
    s += __shfl_xor(s, 16); s += __shfl_xor(s, 32);
    return __builtin_amdgcn_rsqf(s * (1.0f / 64.0f) + RMS_EPS);
}
struct EpiKV {
    static constexpr bool PERM = true, AFTER_DRAIN = false;
    const float* ssq; const float* kg;
    float* okp; float* ovp; float* oks; float* ovs;
    bf16_t* KP; bf16_t* VP; bf16_t* KS; bf16_t* VS;
    template <bool HF> __device__ __forceinline__ void run(const f32x4 (&acc)[2][2][4][2], const Unit& u, int wr, int wc, int fr, int fq) const {
        const bool isk = u.pn < 8; const int col = (u.pn & 7) * BM + wc * 64 + 8 * fq;
        f32x4 g[2][2];
#pragma unroll
        for (int bj = 0; bj < 2; ++bj)
#pragma unroll
            for (int n = 0; n < 2; ++n) g[bj][n] = isk ? *(const f32x4*)(kg + 32 * bj + 8 * fq + 4 * n) : (f32x4){1.f, 1.f, 1.f, 1.f};
        float* o32p = isk ? okp : ovp; float* o32s = isk ? oks : ovs; bf16_t* b16p = isk ? KP : VP; bf16_t* b16s = isk ? KS : VS;
        float rsv[HF ? 4 : 8];
#pragma unroll
        for (int i = 0; i < (HF ? 4 : 8); ++i) rsv[i] = row_rstd(ssq, u.pm * HALF + (i >> 2) * HALF + wr * 64 + (i & 3) * 16 + fr);
#pragma unroll
        for (int ai = 0; ai < (HF ? 1 : 2); ++ai)
#pragma unroll
            for (int m = 0; m < 4; ++m) {
                const int row = u.pm * HALF + ai * HALF + wr * 64 + m * 16 + fr; const float rs = rsv[ai * 4 + m];
                f32x4 v[2][2];
#pragma unroll
                for (int bj = 0; bj < 2; ++bj)
#pragma unroll
                    for (int n = 0; n < 2; ++n) v[bj][n] = acc[ai][bj][m][n] * rs;
                if (isk) { const float gr = group_rstd64(v);
#pragma unroll
                    for (int bj = 0; bj < 2; ++bj)
#pragma unroll
                        for (int n = 0; n < 2; ++n) v[bj][n] = v[bj][n] * gr * g[bj][n]; }
                float* o32 = nullptr; bf16_t* b16 = nullptr;
                if (row < 16400) { o32 = o32p + (size_t)row * 2048; b16 = b16p + (size_t)row * 2048; }
                else if (row < 16656) { const int sr = row - 16400; o32 = o32s + (size_t)sr * 2048; b16 = b16s + ((size_t)(sr >> 4) * 2112 + 2064 + (sr & 15)) * 2048; }
                if (o32) {
#pragma unroll
                    for (int bj = 0; bj < 2; ++bj) { float* p = o32 + col + 32 * bj; *(f32x4*)p = v[bj][0]; *(f32x4*)(p + 4) = v[bj][1]; *(u32x4*)(b16 + col + 32 * bj) = pack8(v[bj][0], v[bj][1]); }
                    if (row < 16) {
                        for (int b = 0; b < 16; ++b) { bf16_t* q = b16s + ((size_t)b * 2112 + row) * 2048 + col;
#pragma unroll
                            for (int bj = 0; bj < 2; ++bj) *(u32x4*)(q + 32 * bj) = pack8(v[bj][0], v[bj][1]); }
                    }
                }
            }
    }
    __device__ __forceinline__ void operator()(const f32x4 (&acc)[2][2][4][2], const Unit& u, int wr, int wc, int fr, int fq) const { run<false>(acc, u, wr, wc, fr, fq); }
    __device__ __forceinline__ void half(const f32x4 (&acc)[2][2][4][2], const Unit& u, int wr, int wc, int fr, int fq) const { run<true>(acc, u, wr, wc, fr, fq); }
};
struct EpiQ {
    static constexpr bool PERM = true, AFTER_DRAIN = false;
    const float* ssq; const float* qg; bf16_t* Q; float c2;
    template <bool HF> __device__ __forceinline__ void run(const f32x4 (&acc)[2][2][4][2], const Unit& u, int wr, int wc, int fr, int fq) const {
        const int col = u.pn * BM + wc * 64 + 8 * fq;
        f32x4 g[2][2];
        float rsv[HF ? 4 : 8];
#pragma unroll
        for (int i = 0; i < (HF ? 4 : 8); ++i) rsv[i] = row_rstd(ssq, u.pm * HALF + (i >> 2) * HALF + wr * 64 + (i & 3) * 16 + fr);
#pragma unroll
        for (int bj = 0; bj < 2; ++bj)
#pragma unroll
            for (int n = 0; n < 2; ++n) g[bj][n] = *(const f32x4*)(qg + 32 * bj + 8 * fq + 4 * n) * c2;
#pragma unroll
        for (int ai = 0; ai < (HF ? 1 : 2); ++ai)
#pragma unroll
            for (int m = 0; m < 4; ++m) {
                const int row = u.pm * HALF + ai * HALF + wr * 64 + m * 16 + fr; const float rs = rsv[ai * 4 + m];
                f32x4 v[2][2];
#pragma unroll
                for (int bj = 0; bj < 2; ++bj)
#pragma unroll
                    for (int n = 0; n < 2; ++n) v[bj][n] = acc[ai][bj][m][n] * rs;
                const float gr = group_rstd64(v);
#pragma unroll
                for (int bj = 0; bj < 2; ++bj) *(u32x4*)(Q + (size_t)row * 2048 + col + 32 * bj) = pack8(v[bj][0] * gr * g[bj][0], v[bj][1] * gr * g[bj][1]);
            }
    }
    __device__ __forceinline__ void operator()(const f32x4 (&acc)[2][2][4][2], const Unit& u, int wr, int wc, int fr, int fq) const { run<false>(acc, u, wr, wc, fr, fq); }
    __device__ __forceinline__ void half(const f32x4 (&acc)[2][2][4][2], const Unit& u, int wr, int wc, int fr, int fq) const { run<true>(acc, u, wr, wc, fr, fq); }
};

struct SplitOrder {
    int nN, nwgP, G, c, nsplit, nsB, TA, npairs, cbase; long skipP; float* slabs; unsigned* cnt;
    __device__ __forceinline__ void init(int N, int K, int G_, int c_, int nsplit_, int cbase_, float* slabs_, unsigned* cnt_, int TA_ = 1 << 20, int nsB_ = 1) {
        nN = N / BM; nwgP = 64 * nN; G = G_; c = c_; nsplit = nsplit_; nsB = nsB_; TA = TA_ < 3 * nN ? TA_ : 3 * nN; npairs = K / (2 * BK); cbase = cbase_; slabs = slabs_; cnt = cnt_; skipP = 0; }
    __device__ __forceinline__ bool next(int i, Unit& u) const {
        const long L = (long)i * G + c + skipP;
        if (L < nwgP) { int wgid = (int)L; { const int q = nwgP / NXCD, r = nwgP % NXCD, xcd = wgid % NXCD, off = wgid / NXCD; wgid = (xcd < r ? xcd * (q + 1) : r * (q + 1) + (xcd - r) * q) + off; }
            const int nig = WGM * nN, gid = wgid / nig, fm = gid * WGM;
            u.pm = 2 * (fm + ((wgid % nig) % WGM)); u.pn = (wgid % nig) / WGM; u.kt0 = 0; u.nt = 2 * npairs; u.nsplit = 1; u.slab = 0; u.cidx = 0; u.half = 0; return true; }
        const int m = (int)(L - nwgP); int tau, j, ns = nsplit, mm = m, t0 = 0;
        const int MA = ((TA + 7) & ~7) * nsplit;
        if (m >= MA) { mm = m - MA; ns = nsB; t0 = TA; }
        if (G == 256) { if (m >= 256) return false; const int x = mm & 7, v = mm >> 3; tau = t0 + 8 * (v / ns) + x; j = v % ns; }
        else { tau = t0 + mm / ns; j = mm % ns; }
        if (tau >= 3 * nN || (t0 == 0 && tau >= TA)) return false;
        const int per = npairs / ns, rem = npairs - per * ns;
        u.pm = 128 + tau / nN; u.pn = tau % nN; u.kt0 = 2 * (j * per + (j < rem ? j : rem)); u.nt = 2 * (per + (j < rem ? 1 : 0)); u.nsplit = ns; u.slab = m; u.cidx = cbase + tau; u.half = 1; return true;
    }
    __device__ __forceinline__ void a_ready(const Unit&) const {}
    __device__ __forceinline__ void done(const Unit&) const {}
    __device__ __forceinline__ bool split_combine(f32x4 (&acc)[2][2][4][2], const Unit& u, int wid, int lane) const {
        const __amdgpu_buffer_rsrc_t rs = __builtin_amdgcn_make_buffer_rsrc(slabs, 0, 256 * 131072, 0x00020000);
        const unsigned voff = ((unsigned)u.slab * 32768u + (unsigned)wid * 4096u + (unsigned)lane * 4u) * 4u;
#pragma unroll
        for (int i = 0; i < 8; ++i) __builtin_amdgcn_raw_buffer_store_b128(pack8(acc[0][(i >> 2) & 1][i & 3][0], acc[0][(i >> 2) & 1][i & 3][1]), rs, (int)(voff + (unsigned)i * 1024u), 0,   16);
        asm volatile("s_waitcnt vmcnt(0)" ::: "memory");
        unsigned t = 0; if (lane == 0) t = __hip_atomic_fetch_add(cnt + (size_t)u.cidx * 8 + wid, 1u, __ATOMIC_RELAXED, __HIP_MEMORY_SCOPE_AGENT);
        t = (unsigned)__builtin_amdgcn_readfirstlane((int)t);
        if (t != (unsigned)(u.nsplit - 1)) return false;
        __builtin_amdgcn_fence(__ATOMIC_ACQUIRE, "agent"); asm volatile("s_waitcnt vmcnt(0)" ::: "memory");
#pragma unroll
        for (int i = 0; i < 8; ++i) { const u32x4 w = pack8(acc[0][(i >> 2) & 1][i & 3][0], acc[0][(i >> 2) & 1][i & 3][1]);
            acc[0][(i >> 2) & 1][i & 3][0] = (f32x4){__uint_as_float(w.x << 16), __uint_as_float(w.x & 0xffff0000u), __uint_as_float(w.y << 16), __uint_as_float(w.y & 0xffff0000u)};
            acc[0][(i >> 2) & 1][i & 3][1] = (f32x4){__uint_as_float(w.z << 16), __uint_as_float(w.z & 0xffff0000u), __uint_as_float(w.w << 16), __uint_as_float(w.w & 0xffff0000u)}; }
        const int MA_ = ((TA + 7) & ~7) * nsplit, rb = u.slab >= MA_ ? MA_ : 0, sr = u.slab - rb;
        const int xs = sr & 7, vs = sr >> 3, own = (G == 256) ? (vs % u.nsplit) : (sr % u.nsplit), base = rb + ((G == 256) ? xs + 8 * ((vs / u.nsplit) * u.nsplit) : sr - own), stride = (G == 256) ? 8 : 1;
        const float* p0 = slabs + (size_t)wid * 4096 + lane * 4;
        const int nq = u.nsplit - 1;
        u32x4 bA[8], bB[8];
#define SC_SLAB(q) (p0 + (size_t)(base + stride * ((q) < own ? (q) : (q) + 1)) * 32768)
#define SC_LOAD(dst, q) do { const float* p_ = SC_SLAB(q); _Pragma("unroll") for (int k = 0; k < 8; ++k) dst[k] = *(const u32x4*)(p_ + k * 256); } while (0)
#define SC_ADD(src) do { _Pragma("unroll") for (int k = 0; k < 8; ++k) { const u32x4 w = src[k]; \
            acc[0][(k >> 2) & 1][k & 3][0] += (f32x4){__uint_as_float(w.x << 16), __uint_as_float(w.x & 0xffff0000u), __uint_as_float(w.y << 16), __uint_as_float(w.y & 0xffff0000u)}; \
            acc[0][(k >> 2) & 1][k & 3][1] += (f32x4){__uint_as_float(w.z << 16), __uint_as_float(w.z & 0xffff0000u), __uint_as_float(w.w << 16), __uint_as_float(w.w & 0xffff0000u)}; } } while (0)
        SC_LOAD(bA, 0);
        for (int q = 0; q < nq; q += 2) {
            if (q + 1 < nq) { SC_LOAD(bB, q + 1); asm volatile("s_waitcnt vmcnt(8)" ::: "memory"); } else asm volatile("s_waitcnt vmcnt(0)" ::: "memory");
            SC_ADD(bA);
            if (q + 1 < nq) {
                if (q + 2 < nq) { SC_LOAD(bA, q + 2); asm volatile("s_waitcnt vmcnt(8)" ::: "memory"); } else asm volatile("s_waitcnt vmcnt(0)" ::: "memory");
                SC_ADD(bB);
            }
        }
#undef SC_SLAB
#undef SC_LOAD
#undef SC_ADD
        return true;
    }
};

template <class Epi, class Sched, bool ALIGN_EPI = false, bool SP2 = false>
__device__ __forceinline__ void gemm_phase(PG8_LAS unsigned char* lds, const Gemm g, const Sched& S, const Epi& E) {
    int tid_l = threadIdx.x; asm volatile("" : "+v"(tid_l));
    const int tid = tid_l, wid = __builtin_amdgcn_readfirstlane(tid >> 6), lane = tid & 63, wr = wid >> 2, wc = wid & 3, fr = lane & 15, fq = lane >> 4;
    const int K = g.K;
    unsigned voffA[2], voffB[2];
#pragma unroll
    for (int i = 0; i < 2; ++i) { int R, C; stage_rc(tid * 16 + i * 8192, R, C); const int Rb = Epi::PERM ? ((R & ~31) + perm32(R & 31)) : R;
        voffA[i] = (unsigned)(R * K + C) * 2u; voffB[i] = (unsigned)(Rb * K + C) * 2u; }
    const size_t kstep = (size_t)(BK * 2);
    const size_t hstep = (size_t)HALF * K * 2;
    const size_t tstep = 2 * hstep;
    const unsigned ldsw = (unsigned)wid * 1024u;
    const int aoff = lds_byte(wr * 64 + fr, fq * 8), boff = lds_byte(wc * 32 + fr, fq * 8);
#define PG8_SA(b, h) (((b) * 2 + (h)) * HTB)
#define PG8_SB(b, h) ((4 + (b) * 2 + (h)) * HTB)
#define PG8_STAGE(bufoff, gbase, voff) do { _Pragma("unroll") for (int _i = 0; _i < 2; ++_i) \
        __builtin_amdgcn_global_load_lds((const unsigned*)((const char*)(gbase) + (voff)[_i]), (PG8_LAS unsigned*)(lds + (bufoff) + ldsw + _i * 8192), 16, 0, 0); } while (0)
#define PG8_LDA(dst, b, h) do { _Pragma("unroll") for (int m = 0; m < 4; ++m) _Pragma("unroll") for (int k = 0; k < 2; ++k) dst[m][k] = *(const PG8_LAS bf16x8*)(lds + PG8_SA(b, h) + aoff + m * 2048 + k * 1024); } while (0)
#define PG8_LDB(dst, b, h) do { _Pragma("unroll") for (int n = 0; n < 2; ++n) _Pragma("unroll") for (int k = 0; k < 2; ++k) dst[n][k] = *(const PG8_LAS bf16x8*)(lds + PG8_SB(b, h) + boff + n * 2048 + k * 1024); } while (0)
#define PG8_MMA(ai, bj, At, Bt) do { __builtin_amdgcn_s_setprio(1); _Pragma("unroll") for (int m = 0; m < 4; ++m) _Pragma("unroll") for (int n = 0; n < 2; ++n) _Pragma("unroll") for (int k = 0; k < 2; ++k) \
        acc[ai][bj][m][n] = __builtin_amdgcn_mfma_f32_16x16x32_bf16(Bt[n][k], At[m][k], acc[ai][bj][m][n], 0, 0, 0); __builtin_amdgcn_s_setprio(0); } while (0)
#define PG8_WAIT_V(n) asm volatile("s_waitcnt vmcnt(" #n ")" ::: "memory")
#define PG8_WAIT_L(n) asm volatile("s_waitcnt lgkmcnt(" #n ")" ::: "memory")
#define PG8_BAR __builtin_amdgcn_s_barrier()
#define PG8_SCHED __builtin_amdgcn_sched_barrier(0)
    Unit cur, nxt; int ui = 0;
    if (!S.next(0, cur)) return;
    f32x4 acc[2][2][4][2];
#pragma unroll
    for (int a = 0; a < 2; ++a)
#pragma unroll
        for (int b = 0; b < 2; ++b)
#pragma unroll
            for (int m = 0; m < 4; ++m)
#pragma unroll
                for (int n = 0; n < 2; ++n) acc[a][b][m][n] = (f32x4){0.f, 0.f, 0.f, 0.f};
    bf16x8 At[4][2], B0[2][2], B1[2][2];
    const char* cA = (const char*)g.A + (size_t)cur.pm * hstep + (size_t)cur.kt0 * kstep; const char* cB = (const char*)g.Bt + (size_t)cur.pn * tstep + (size_t)cur.kt0 * kstep;
    S.a_ready(cur);
    if constexpr (SP2) {
        PG8_STAGE(PG8_SB(0, 0), cB, voffB); PG8_STAGE(PG8_SB(0, 1), cB + hstep, voffB); PG8_STAGE(PG8_SA(0, 0), cA, voffA); PG8_STAGE(PG8_SA(0, 1), cA + hstep, voffA);
        if (wr == 1) PG8_BAR;
        PG8_WAIT_V(2); PG8_BAR;
        PG8_STAGE(PG8_SB(1, 0), cB + kstep, voffB); PG8_STAGE(PG8_SA(1, 0), cA + kstep, voffA); PG8_STAGE(PG8_SB(1, 1), cB + hstep + kstep, voffB);
        PG8_WAIT_V(6); PG8_BAR;
    } else {
        PG8_STAGE(PG8_SB(0, 0), cB, voffB); PG8_STAGE(PG8_SA(0, 0), cA, voffA); PG8_STAGE(PG8_SB(0, 1), cB + hstep, voffB); PG8_STAGE(PG8_SA(0, 1), cA + hstep, voffA);
        if (wr == 1) PG8_BAR;
        PG8_WAIT_V(4); PG8_BAR;
        PG8_STAGE(PG8_SB(1, 0), cB + kstep, voffB); PG8_STAGE(PG8_SA(1, 0), cA + kstep, voffA); PG8_STAGE(PG8_SB(1, 1), cB + hstep + kstep, voffB);
        PG8_WAIT_V(6); PG8_BAR;
    }
    for (;;) {
        const bool has_next = S.next(ui + 1, nxt);
        const char* nA = has_next ? (const char*)g.A + (size_t)nxt.pm * hstep + (size_t)nxt.kt0 * kstep : cA; const char* nB = has_next ? (const char*)g.Bt + (size_t)nxt.pn * tstep + (size_t)nxt.kt0 * kstep : cB;
        const int nt = cur.nt;
        if (!cur.half) {
        for (int t = 0; t < nt; t += 2) {
            const bool last = (t == nt - 2);
            const char* a1 = cA + (size_t)(t + 1) * kstep;
            const char* a2 = last ? nA : cA + (size_t)(t + 2) * kstep; const char* b2 = last ? nB : cB + (size_t)(t + 2) * kstep;
            const char* a3 = a2 + kstep; const char* b3 = b2 + kstep;
            if (last && has_next) S.a_ready(nxt);
            if constexpr (SP2) {
            PG8_LDB(B0, 0, 0); PG8_LDB(B1, 0, 1); PG8_SCHED; PG8_LDA(At, 0, 0); PG8_STAGE(PG8_SA(1, 1), a1 + hstep, voffA);
            PG8_WAIT_V(8); PG8_WAIT_L(0); PG8_BAR; PG8_MMA(0, 0, At, B0); PG8_MMA(0, 1, At, B1); PG8_BAR; PG8_SCHED;
            PG8_LDA(At, 0, 1); PG8_STAGE(PG8_SB(0, 0), b2, voffB); PG8_STAGE(PG8_SB(0, 1), b2 + hstep, voffB); PG8_STAGE(PG8_SA(0, 0), a2, voffA);
            PG8_WAIT_V(8); PG8_WAIT_L(0); PG8_BAR; PG8_MMA(1, 0, At, B0); PG8_MMA(1, 1, At, B1); PG8_BAR; PG8_SCHED;
            PG8_LDB(B0, 1, 0); PG8_LDB(B1, 1, 1); PG8_SCHED; PG8_LDA(At, 1, 0); PG8_STAGE(PG8_SA(0, 1), a2 + hstep, voffA);
            PG8_WAIT_V(8); PG8_WAIT_L(0); PG8_BAR; PG8_MMA(0, 0, At, B0); PG8_MMA(0, 1, At, B1); PG8_BAR; PG8_SCHED;
            PG8_LDA(At, 1, 1); PG8_STAGE(PG8_SB(1, 0), b3, voffB); PG8_STAGE(PG8_SB(1, 1), b3 + hstep, voffB); PG8_STAGE(PG8_SA(1, 0), a3, voffA);
            PG8_WAIT_V(8); PG8_WAIT_L(0); PG8_BAR; PG8_MMA(1, 0, At, B0); PG8_MMA(1, 1, At, B1); PG8_BAR; PG8_SCHED;
            } else {
            PG8_LDB(B0, 0, 0); PG8_SCHED; PG8_LDA(At, 0, 0); PG8_STAGE(PG8_SA(1, 1), a1 + hstep, voffA);
            PG8_WAIT_L(8); PG8_BAR; PG8_WAIT_L(0); PG8_MMA(0, 0, At, B0); PG8_BAR; PG8_SCHED;
            PG8_LDB(B1, 0, 1); PG8_STAGE(PG8_SB(0, 0), b2, voffB);
            PG8_BAR; PG8_WAIT_L(0); PG8_MMA(0, 1, At, B1); PG8_BAR;
            PG8_LDA(At, 0, 1); PG8_STAGE(PG8_SA(0, 0), a2, voffA);
            PG8_BAR; PG8_WAIT_L(0); PG8_MMA(1, 0, At, B0); PG8_BAR; PG8_SCHED;
            PG8_STAGE(PG8_SB(0, 1), b2 + hstep, voffB);
            PG8_WAIT_V(6); PG8_BAR; PG8_MMA(1, 1, At, B1); PG8_BAR;
            PG8_LDB(B0, 1, 0); PG8_SCHED; PG8_LDA(At, 1, 0); PG8_STAGE(PG8_SA(0, 1), a2 + hstep, voffA);
            PG8_WAIT_L(8); PG8_BAR; PG8_WAIT_L(0); PG8_MMA(0, 0, At, B0); PG8_BAR; PG8_SCHED;
            PG8_LDB(B1, 1, 1); PG8_STAGE(PG8_SB(1, 0), b3, voffB);
            PG8_BAR; PG8_WAIT_L(0); PG8_MMA(0, 1, At, B1); PG8_BAR;
            PG8_LDA(At, 1, 1); PG8_STAGE(PG8_SA(1, 0), a3, voffA);
            PG8_BAR; PG8_WAIT_L(0); PG8_MMA(1, 0, At, B0); PG8_BAR; PG8_SCHED;
            PG8_STAGE(PG8_SB(1, 1), b3 + hstep, voffB);
            PG8_WAIT_V(6); PG8_BAR; PG8_MMA(1, 1, At, B1); PG8_BAR;
            }
        }
        if constexpr (ALIGN_EPI) { if (wr == 0) PG8_BAR; }
        E(acc, cur, wr, wc, fr, fq); S.done(cur);
        } else {
        for (int t = 0; t < nt; t += 2) {
            const bool last = (t == nt - 2);
            const char* a1 = cA + (size_t)(t + 1) * kstep;
            const char* a2 = last ? nA : cA + (size_t)(t + 2) * kstep; const char* b2 = last ? nB : cB + (size_t)(t + 2) * kstep;
            const char* a3 = a2 + kstep; const char* b3 = b2 + kstep;
            if (last && has_next) S.a_ready(nxt);
            if constexpr (SP2) {
            PG8_LDB(B0, 0, 0); PG8_LDB(B1, 0, 1); PG8_SCHED; PG8_LDA(At, 0, 0); PG8_STAGE(PG8_SA(1, 1), a1 + hstep, voffA);
            PG8_WAIT_V(8); PG8_WAIT_L(0); PG8_BAR; PG8_MMA(0, 0, At, B0); PG8_MMA(0, 1, At, B1); PG8_BAR; PG8_SCHED;
            PG8_STAGE(PG8_SB(0, 0), b2, voffB); PG8_STAGE(PG8_SB(0, 1), b2 + hstep, voffB); PG8_STAGE(PG8_SA(0, 0), a2, voffA);
            PG8_WAIT_V(8); PG8_WAIT_L(0); PG8_BAR; PG8_BAR; PG8_SCHED;
            PG8_LDB(B0, 1, 0); PG8_LDB(B1, 1, 1); PG8_SCHED; PG8_LDA(At, 1, 0); PG8_STAGE(PG8_SA(0, 1), a2 + hstep, voffA);
            PG8_WAIT_V(8); PG8_WAIT_L(0); PG8_BAR; PG8_MMA(0, 0, At, B0); PG8_MMA(0, 1, At, B1); PG8_BAR; PG8_SCHED;
            PG8_STAGE(PG8_SB(1, 0), b3, voffB); PG8_STAGE(PG8_SB(1, 1), b3 + hstep, voffB); PG8_STAGE(PG8_SA(1, 0), a3, voffA);
            PG8_WAIT_V(8); PG8_WAIT_L(0); PG8_BAR; PG8_BAR; PG8_SCHED;
            } else {
            PG8_LDB(B0, 0, 0); PG8_SCHED; PG8_LDA(At, 0, 0); PG8_STAGE(PG8_SA(1, 1), a1 + hstep, voffA);
            PG8_WAIT_L(8); PG8_BAR; PG8_WAIT_L(0); PG8_MMA(0, 0, At, B0); PG8_BAR; PG8_SCHED;
            PG8_LDB(B1, 0, 1); PG8_STAGE(PG8_SB(0, 0), b2, voffB);
            PG8_BAR; PG8_WAIT_L(0); PG8_MMA(0, 1, At, B1); PG8_BAR;
            PG8_STAGE(PG8_SA(0, 0), a2, voffA);
            PG8_BAR; PG8_WAIT_L(0); PG8_BAR; PG8_SCHED;
            PG8_STAGE(PG8_SB(0, 1), b2 + hstep, voffB);
            PG8_WAIT_V(6); PG8_BAR; PG8_BAR;
            PG8_LDB(B0, 1, 0); PG8_SCHED; PG8_LDA(At, 1, 0); PG8_STAGE(PG8_SA(0, 1), a2 + hstep, voffA);
            PG8_WAIT_L(8); PG8_BAR; PG8_WAIT_L(0); PG8_MMA(0, 0, At, B0); PG8_BAR; PG8_SCHED;
            PG8_LDB(B1, 1, 1); PG8_STAGE(PG8_SB(1, 0), b3, voffB);
            PG8_BAR; PG8_WAIT_L(0); PG8_MMA(0, 1, At, B1); PG8_BAR;
            PG8_STAGE(PG8_SA(1, 0), a3, voffA);
            PG8_BAR; PG8_WAIT_L(0); PG8_BAR; PG8_SCHED;
            PG8_STAGE(PG8_SB(1, 1), b3 + hstep, voffB);
            PG8_WAIT_V(6); PG8_BAR; PG8_BAR;
            }
        }
        if constexpr (ALIGN_EPI) { if (wr == 0) PG8_BAR; }
        { bool fin = true; if (cur.nsplit > 1) fin = S.split_combine(acc, cur, wid, lane); if (fin) E.half(acc, cur, wr, wc, fr, fq); S.done(cur); }
        }
        if (!has_next) break;
#pragma unroll
        for (int a = 0; a < 2; ++a)
#pragma unroll
            for (int b = 0; b < 2; ++b)
#pragma unroll
                for (int m = 0; m < 4; ++m)
#pragma unroll
                    for (int n = 0; n < 2; ++n) acc[a][b][m][n] = (f32x4){0.f, 0.f, 0.f, 0.f};
        cur = nxt; cA = nA; cB = nB; ++ui;
        if constexpr (ALIGN_EPI) { if (wr == 1) PG8_BAR; }
    }
    PG8_WAIT_V(0);
    if constexpr (!ALIGN_EPI) { if (wr == 0) PG8_BAR; }
    PG8_BAR;
    if constexpr (Epi::AFTER_DRAIN) { E.fused(acc, cur, wr, wc, fr, fq, lds, wid, lane); S.done(cur); }
#undef PG8_SA
#undef PG8_SB
#undef PG8_STAGE
#undef PG8_LDA
#undef PG8_LDB
#undef PG8_MMA
#undef PG8_WAIT_V
#undef PG8_WAIT_L
#undef PG8_BAR
#undef PG8_SCHED
}
}

#ifndef PG8_SP2
#define PG8_SP2 true
#endif
#ifndef PG8_ALIGN
#define PG8_ALIGN true
#endif
#ifndef MK_PER_PHASE
#define MK_PER_PHASE 0
#endif

#ifndef EN_P0
#define EN_P0 1
#endif
#ifndef EN_RG0
#define EN_RG0 1
#endif
#ifndef EN_RG1
#define EN_RG1 1
#endif
#ifndef EN_ATT
#define EN_ATT 1
#endif
#ifndef EN_GU
#define EN_GU 1
#endif
#ifndef EN_DN
#define EN_DN 1
#endif
#ifndef EN_WIN
#define EN_WIN 1
#endif
#ifndef EN_KV
#define EN_KV 1
#endif
#ifndef EN_Q
#define EN_Q 1
#endif
#ifndef EN_RES
#define EN_RES 1
#endif
constexpr int NWAVES = 8;
constexpr int DM = 2048, DFF = 5632, NHEAD = 16;
constexpr int MROWS = 16896;
constexpr int ROW_P0 = 16, ROW_S0 = 16400, ROWS_REAL = 16656;
constexpr int KS_ROWS = 2112;
constexpr float LAM_INIT = 0.3555090675909693f;
constexpr float LOG2E = 1.4426950408889634f;
constexpr int NPHASE = 17;
constexpr size_t O_YP = 0, O_YS = 33554432, O_KP = 34078720, O_VP = 67665920, O_CP = 101253120, O_HP = 101259264, O_KS = 101261312, O_VS = 101785600, O_CS = 102309888, O_HS = 102408192, O_END = 102440960;

constexpr size_t MiB = 1u << 20;
constexpr size_t WS_CTL = 0, CTL_ZERO_BYTES = 1 * MiB;
constexpr size_t WS_GW = 1 * MiB;
constexpr size_t WS_WGU = 2 * MiB;
constexpr size_t WS_WDN = 178 * MiB;
constexpr size_t WS_WIN = 266 * MiB, WS_WOUT = 282 * MiB, WS_WKV = 290 * MiB, WS_WQ = 306 * MiB, WS_WO = 314 * MiB;
constexpr size_t WS_X16 = 322 * MiB;
constexpr size_t WS_BIG = 388 * MiB;
constexpr size_t WS_ACT = 586 * MiB;
constexpr size_t WS_KP = 652 * MiB, WS_VP = 717 * MiB;
constexpr size_t WS_KS = 782 * MiB, WS_VS = 914 * MiB;
constexpr size_t WS_TS = 1046 * MiB;
constexpr size_t WS_SLAB = 1048 * MiB;
constexpr size_t WS_AB = 1112 * MiB;
constexpr size_t WS_END = 1244 * MiB;
constexpr int CW_TMO = 0, CW_ATTQ = 64, CW_SCONV = 256, CW_BAR = 4096;
constexpr size_t CTL_SSQ = 65536;
constexpr size_t CTL_SCNT = 524288;
static_assert(CTL_SSQ + 6 * (size_t)MROWS * 4 <= CTL_SCNT && CTL_SCNT + 17 * 128 * 8 * 4 <= CTL_ZERO_BYTES, "ctl");

constexpr int RING_OFF = 0, RING_BYTES = 131072;
constexpr int LDSCTL_OFF = RING_BYTES, MISC_OFF = LDSCTL_OFF + 320;
constexpr int LDS_BYTES = 147456;

#define GAS __attribute__((address_space(1)))
#define LAS __attribute__((address_space(3)))
typedef unsigned short bf16;
typedef unsigned v4u __attribute__((ext_vector_type(4)));
typedef unsigned v2u __attribute__((ext_vector_type(2)));
typedef float f32x4 __attribute__((ext_vector_type(4)));
typedef float f32x2 __attribute__((ext_vector_type(2)));
typedef float f32x16 __attribute__((ext_vector_type(16)));
typedef short bf16x8 __attribute__((ext_vector_type(8)));
typedef short s16x4 __attribute__((ext_vector_type(4)));
typedef GAS unsigned gu32;
#define RLX_AGENT __ATOMIC_RELAXED, __HIP_MEMORY_SCOPE_AGENT
#define LDS_WAIT() asm volatile("s_waitcnt lgkmcnt(0)" ::: "memory")
#define VM_WAIT() asm volatile("s_waitcnt vmcnt(0)" ::: "memory")
__device__ __forceinline__ unsigned pk2(float lo, float hi) { typedef __bf16 bf16x2_t __attribute__((ext_vector_type(2))); f32x2 v = {lo, hi}; bf16x2_t b = __builtin_convertvector(v, bf16x2_t); return __builtin_bit_cast(unsigned, b); }
__device__ __forceinline__ unsigned f2bf(float f) { return pk2(f, 0.f) & 0xffffu; }
__device__ __forceinline__ float bf2f(bf16 b) { return __builtin_bit_cast(float, ((unsigned)b) << 16); }
__device__ __forceinline__ float wave_sum(float v) {
#pragma unroll
    for (int o = 1; o < 64; o <<= 1) v += __shfl_xor(v, o);
    return v;
}

#define XB_TMO      128
#define XB_XCNT(j)  (256  + 64 * (j))
#define XB_XSUB(j)  (1280 + 64 * (j))
#define XB_XGEN(j)  (2304 + 64 * (j))
#define XB_TOP      3328
#define XB_TOPGEN   3392
#define XCD_BAR_WORDS 3456
#define XB_SPIN_CAP (1u << 18)

__device__ __forceinline__ unsigned xb_ld(unsigned* p)              { return __hip_atomic_load(p, __ATOMIC_RELAXED, __HIP_MEMORY_SCOPE_AGENT); }
__device__ __forceinline__ unsigned xb_add(unsigned* p, unsigned v) { return __hip_atomic_fetch_add(p, v, __ATOMIC_RELAXED, __HIP_MEMORY_SCOPE_AGENT); }
__device__ __forceinline__ unsigned xb_xcc_id() { return (unsigned)__builtin_amdgcn_s_getreg((3 << 11) | 20) & 0xFu; }
#define XB_SPIN(cond, bar) do { unsigned _sp = 0; while (cond) { __builtin_amdgcn_s_sleep(1); \
    if ((++_sp & 255u) == 0u) { if (xb_ld(&(bar)[XB_TMO])) break; if (_sp > XB_SPIN_CAP) { atomicAdd(&(bar)[XB_TMO], 1u); break; } } } } while (0)

struct XcdBarrier {
    unsigned* bar; unsigned x;
    volatile LAS unsigned* st;
};

__device__ __forceinline__ XcdBarrier xcd_barrier_post(unsigned* bar, volatile LAS unsigned* st) {
    XcdBarrier b; b.bar = bar; b.x = xb_xcc_id(); b.st = st;
    if (threadIdx.x == 0) (void)xb_add(&bar[XB_XCNT(b.x)], 1u);
    return b;
}
__device__ __forceinline__ void xcd_barrier_complete(unsigned* bar, unsigned x, unsigned& nloc, unsigned& nx) {
    const unsigned G = gridDim.x * gridDim.y * gridDim.z;
    unsigned sum, cnt, mine, sp = 0u;
    for (;;) {
        sum = 0u; cnt = 0u; mine = 0u;
#pragma unroll
        for (unsigned j = 0; j < 16; ++j) { const unsigned c = xb_ld(&bar[XB_XCNT(j)]); sum += c; cnt += (c > 0u) ? 1u : 0u; mine = (j == x) ? c : mine; }
        if (sum == G) break;
        __builtin_amdgcn_s_sleep(1);
        if ((++sp & 255u) == 0u) { if (xb_ld(&bar[XB_TMO])) break; if (sp > XB_SPIN_CAP) { atomicAdd(&bar[XB_TMO], 1u); break; } }
    }
    nloc = mine > 0u ? mine : 1u; nx = cnt > 0u ? cnt : 1u;
}

__device__ __forceinline__ void xcd_barrier(const XcdBarrier& b) {
    asm volatile("s_waitcnt vmcnt(0)" ::: "memory");
    __syncthreads();
    if (threadIdx.x == 0) {
        unsigned* bar = b.bar;
        __builtin_amdgcn_s_waitcnt(0);
        unsigned nloc = b.st[0], nx = b.st[1];
        if (nloc == 0u) { xcd_barrier_complete(bar, b.x, nloc, nx); b.st[0] = nloc; b.st[1] = nx; }
        const unsigned old = xb_add(&bar[XB_XSUB(b.x)], 1u);
        const unsigned gen = old / nloc;
        if (old + 1u == (gen + 1u) * nloc) {
            __builtin_amdgcn_fence(__ATOMIC_RELEASE, "agent");
            asm volatile("s_waitcnt vmcnt(0)" ::: "memory");
            const unsigned og = xb_add(&bar[XB_TOP], 1u);
            const unsigned tg = og / nx;
            if (og + 1u == (tg + 1u) * nx) xb_add(&bar[XB_TOPGEN], 1u);
            else XB_SPIN(xb_ld(&bar[XB_TOPGEN]) == tg, bar);
            __builtin_amdgcn_fence(__ATOMIC_ACQUIRE, "agent");
            xb_add(&bar[XB_XGEN(b.x)], 1u);
            asm volatile("s_waitcnt vmcnt(0)" ::: "memory");
        } else {
            XB_SPIN(xb_ld(&bar[XB_XGEN(b.x)]) == gen, bar);
            __builtin_amdgcn_fence(__ATOMIC_ACQUIRE, "agent");
            asm volatile("s_waitcnt vmcnt(0)" ::: "memory");
        }
    }
    __syncthreads();
}

struct Args { const float* in[28]; float* out; unsigned char* ws; int ph_lo, ph_hi; };
typedef const __attribute__((address_space(4))) Args CArgs;
__device__ __forceinline__ CArgs* largs() { CArgs* p = (CArgs*)__builtin_amdgcn_kernarg_segment_ptr(); asm volatile("" : "+s"(p)); return p; }
__device__ __forceinline__ int lbid() { int b = (int)blockIdx.x; asm volatile("" : "+s"(b)); return b; }
struct Frame {
    LAS unsigned char* lds;
    volatile LAS unsigned* MISC;
    int tid, lane, wave, G;
};
#define P_IN(i) (args.in[i])
#define P_WS(T, off) ((T*)(args.ws + (off)))
#define P_GW P_WS(bf16, WS_GW)
#define P_WGU P_WS(bf16, WS_WGU)
#define P_WDN P_WS(bf16, WS_WDN)
#define P_WIN P_WS(bf16, WS_WIN)
#define P_WOUT P_WS(bf16, WS_WOUT)
#define P_WKV P_WS(bf16, WS_WKV)
#define P_WQ P_WS(bf16, WS_WQ)
#define P_WO P_WS(bf16, WS_WO)
#define P_X16 P_WS(bf16, WS_X16)
#define P_HID P_WS(bf16, WS_BIG)
#define P_GG P_WS(bf16, WS_BIG)
#define P_XB P_WS(float, WS_BIG + 66 * MiB)
#define P_A3 P_WS(bf16, WS_BIG)
#define P_ACT P_WS(bf16, WS_ACT)
#define P_KP P_WS(bf16, WS_KP)
#define P_VP P_WS(bf16, WS_VP)
#define P_KS P_WS(bf16, WS_KS)
#define P_VS P_WS(bf16, WS_VS)
#define P_TS P_WS(float, WS_TS)
#define P_SSQ P_WS(float, CTL_SSQ)
#define P_CTL ((gu32*)(args.ws + WS_CTL))
#define P_SLAB P_WS(float, WS_SLAB)
#define P_SCNT ((unsigned*)(args.ws + CTL_SCNT))
#define P_OUT (args.out)
enum { I_XP = 0, I_XS, I_CK, I_CV, I_SCONV, I_SH, I_META, I_FNORM, I_WG, I_WU, I_WD, I_RGNORM, I_RGWIN, I_CONVW, I_CONVB, I_GATEW, I_GATEB, I_LAMBDA, I_RGWOUT, I_KVNORM, I_WKV, I_KNORM, I_ATTNNORM, I_WQ, I_QNORM, I_DLAM, I_SUBNORM, I_WOP };

__device__ __forceinline__ void cvt_item(const float* W, int ldw, int n0, int k0, const float* gain, bf16* dst, int K, LAS float* scr, int lane) {
    float wv[32];
#pragma unroll
    for (int i = 0; i < 32; ++i) wv[i] = W[(size_t)(k0 + 2 * i + (lane >> 5)) * ldw + n0 + (lane & 31)];
#pragma unroll
    for (int i = 0; i < 32; ++i) { const int kk = 2 * i + (lane >> 5); const float g = gain ? gain[k0 + kk] : 1.f; scr[kk * 33 + (lane & 31)] = wv[i] * g; }
    LDS_WAIT(); asm volatile("" ::: "memory");
    const int c = lane & 7;
#pragma unroll
    for (int j = 0; j < 4; ++j) { const int n = (lane >> 3) + 8 * j; const LAS float* s = scr + (8 * c) * 33 + n;
        v4u o; o.x = pk2(s[0 * 33], s[1 * 33]); o.y = pk2(s[2 * 33], s[3 * 33]); o.z = pk2(s[4 * 33], s[5 * 33]); o.w = pk2(s[6 * 33], s[7 * 33]);
        *(GAS v4u*)(dst + (size_t)n * K + 8 * c) = o; }
    LDS_WAIT(); asm volatile("" ::: "memory");
}
__device__ __forceinline__ int p64col(int beta) { return 256 * (beta >> 3) + 64 * (beta & 3) + 32 * ((beta >> 2) & 1); }
__device__ __forceinline__ void p0_prologue(const Frame& F, CArgs& args) {
    int tid_l = threadIdx.x; asm volatile("" : "+v"(tid_l));
    const int lane = tid_l & 63, wave = __builtin_amdgcn_readfirstlane(tid_l >> 6);
    LAS float* scr = (LAS float*)(F.lds + RING_OFF + wave * 16384);
    const int gw = lbid() * NWAVES + wave, NGW = F.G * NWAVES;
    constexpr int IT_GU = 32 * 352, IT_DN = 88 * 64, IT_44 = 32 * 128, IT_22 = 32 * 64, IT_GW = 32 * 8;
    constexpr int NIT = 4 * IT_GU + 4 * IT_DN + 2 * IT_44 + 3 * IT_22 + IT_GW;
    for (int it = gw; it < NIT; it += NGW) {
        int r = it;
        if (r < 4 * IT_GU) { const int f = r / IT_GU; r -= f * IT_GU; const int kb = r / 352, beta = r % 352, pn = beta >> 3, bj = (beta >> 2) & 1, jb = beta & 3;
            const float* src = (bj ? P_IN(I_WU) : P_IN(I_WG)) + (size_t)f * DM * DFF;
            cvt_item(src, DFF, 128 * pn + 32 * jb, 64 * kb, P_IN(I_FNORM) + f * DM, P_WGU + (size_t)f * 11264 * DM + (size_t)(32 * beta) * DM + 64 * kb, DM, scr, lane); continue; }
        r -= 4 * IT_GU;
        if (r < 4 * IT_DN) { const int f = r / IT_DN; r -= f * IT_DN; const int kb = r / 64, beta = r % 64;
            cvt_item(P_IN(I_WD) + (size_t)f * DFF * DM, DM, p64col(beta), 64 * kb, nullptr, P_WDN + (size_t)f * DM * DFF + (size_t)(32 * beta) * DFF + 64 * kb, DFF, scr, lane); continue; }
        r -= 4 * IT_DN;
        if (r < IT_44) { const int kb = r / 128, beta = r % 128; cvt_item(P_IN(I_RGWIN), 4096, p64col(beta), 64 * kb, P_IN(I_RGNORM), P_WIN + (size_t)(32 * beta) * DM + 64 * kb, DM, scr, lane); continue; }
        r -= IT_44;
        if (r < IT_44) { const int kb = r / 128, beta = r % 128; cvt_item(P_IN(I_WKV), 4096, p64col(beta), 64 * kb, P_IN(I_KVNORM), P_WKV + (size_t)(32 * beta) * DM + 64 * kb, DM, scr, lane); continue; }
        r -= IT_44;
        if (r < IT_22) { const int kb = r / 64, beta = r % 64; cvt_item(P_IN(I_RGWOUT), DM, p64col(beta), 64 * kb, nullptr, P_WOUT + (size_t)(32 * beta) * DM + 64 * kb, DM, scr, lane); continue; }
        r -= IT_22;
        if (r < IT_22) { const int kb = r / 64, beta = r % 64; cvt_item(P_IN(I_WQ), DM, p64col(beta), 64 * kb, P_IN(I_ATTNNORM), P_WQ + (size_t)(32 * beta) * DM + 64 * kb, DM, scr, lane); continue; }
        r -= IT_22;
        if (r < IT_22) { const int kb = r / 64, beta = r % 64; cvt_item(P_IN(I_WOP), DM, p64col(beta), 64 * kb, nullptr, P_WO + (size_t)(32 * beta) * DM + 64 * kb, DM, scr, lane); continue; }
        r -= IT_22;
        { const int mat = r >> 3, i8 = r & 7; cvt_item(P_IN(I_GATEW) + (size_t)mat * 16384, 128, 32 * (i8 & 3), 64 * (i8 >> 2), nullptr, P_GW + (size_t)mat * 16384 + (size_t)(32 * (i8 & 3)) * 128 + 64 * (i8 >> 2), 128, scr, lane); }
    }
    for (int m = gw; m < MROWS; m += NGW) {
        const float* src = m < ROW_P0 ? P_IN(I_META) + (size_t)m * DM : m < ROW_S0 ? P_IN(I_XP) + (size_t)(m - ROW_P0) * DM : m < ROWS_REAL ? P_IN(I_XS) + (size_t)(m - ROW_S0) * DM : nullptr;
        float s = 0.f;
#pragma unroll
        for (int j = 0; j < 4; ++j) {
            f32x4 a = (f32x4){0.f, 0.f, 0.f, 0.f}, b = a;
            if (src) { a = *(const GAS f32x4*)(src + 512 * j + 8 * lane); b = *(const GAS f32x4*)(src + 512 * j + 8 * lane + 4); }
            s += (a[0] * a[0] + a[1] * a[1]) + (a[2] * a[2] + a[3] * a[3]) + (b[0] * b[0] + b[1] * b[1]) + (b[2] * b[2] + b[3] * b[3]);
            v4u o; o.x = pk2(a[0], a[1]); o.y = pk2(a[2], a[3]); o.z = pk2(b[0], b[1]); o.w = pk2(b[2], b[3]);
            *(GAS v4u*)(P_X16 + (size_t)m * DM + 512 * j + 8 * lane) = o;
        }
        s = wave_sum(s);
        if (lane == 0) P_SSQ[m] = s;
    }
}

constexpr int RG_XC = 0, RG_G = 17408, RG_SQ = RG_G + 2 * 64 * 528, RG_XCS = 272, RG_GS = 528;
template <int MODE> __device__ __forceinline__ void rg_phase(const Frame& F, CArgs& args) {
    LAS unsigned char* L = F.lds + RING_OFF;
    int tid_l = threadIdx.x; asm volatile("" : "+v"(tid_l));
    const int tid = tid_l, lane = tid & 63, wave = __builtin_amdgcn_readfirstlane(tid >> 6);
    const int c = tid & 127, q = tid >> 7, fr = lane & 15, fq = lane >> 4, k2 = wave >> 2, dq = wave & 3;
    const float* XB = P_XB;
    unsigned* AB = (unsigned*)(args.ws + WS_AB);
    for (int uidx = lbid(); uidx < 81 * 16; uidx += F.G) {
        int tl, n;
        if (uidx < 1024) { tl = 1 + (uidx >> 4); n = uidx & 15; } else { const int v = uidx - 1024; n = v & 15; const int t2 = v >> 4; tl = t2 == 0 ? 0 : 64 + t2; }
        const bool smp = tl >= 65; const int b = tl - 65;
        const bool full = !smp && tl != 0;
        const int row0 = smp ? ROW_S0 + 16 * b : (tl == 0 ? 0 : 16 + 256 * (tl - 1));
        const int nsub = full ? 4 : 1, nmb = full ? 4 : 1, nq = full ? 4 : 1;
        const int ch = n * 128 + c;
        const bool act = q < nq;
        if (MODE == 0) {
            const float cw0 = P_IN(I_CONVW)[ch], cw1 = P_IN(I_CONVW)[2048 + ch], cw2 = P_IN(I_CONVW)[4096 + ch], cw3 = P_IN(I_CONVW)[6144 + ch], cb = P_IN(I_CONVB)[ch];
            const float lam = P_IN(I_LAMBDA)[ch];
            const float ls8 = -8.0f * LOG2E * log1pf(__expf(-lam));
            bf16x8 Bw[2][4]; f32x4 gb[2];
            { const bf16* gwp = P_GW + ((size_t)(k2 * 16 + n) * 128 + 32 * dq + fr) * 128 + 8 * fq;
#pragma unroll
              for (int nb = 0; nb < 2; ++nb) {
#pragma unroll
                  for (int ks = 0; ks < 4; ++ks) Bw[nb][ks] = *(const GAS bf16x8*)(gwp + (size_t)(16 * nb) * 128 + 32 * ks);
                  gb[nb] = *(const GAS f32x4*)(P_IN(I_GATEB) + k2 * 2048 + n * 128 + 32 * dq + 16 * nb + 4 * fq); } }
            float At = 1.f, Bt = 0.f;
            float vn[19];
#define RG_LOADV(dst, ss) do { _Pragma("unroll") for (int j = 0; j < 19; ++j) { const int T = 64 * (ss) + 16 * q - 3 + j; float x = 0.f; \
                if (act) { if (smp) x = T >= 0 ? XB[(size_t)(row0 + T) * DM + ch] : P_IN(I_SCONV)[((size_t)b * 3 + 3 + T) * DM + ch]; \
                           else { const int g = row0 + T; x = g >= 0 ? XB[(size_t)g * DM + ch] : 0.f; } } \
                dst[j] = x; } } while (0)
            RG_LOADV(vn, 0);
            for (int s = 0; s < nsub; ++s) {
                float xc[16], v[19];
                const int T0 = 64 * s + 16 * q;
#pragma unroll
                for (int j = 0; j < 19; ++j) v[j] = vn[j];
                if (s + 1 < nsub) RG_LOADV(vn, s + 1);
#pragma unroll
                for (int i = 0; i < 16; ++i) { xc[i] = cb + cw0 * v[i] + cw1 * v[i + 1] + cw2 * v[i + 2] + cw3 * v[i + 3];
                    if (act) *(LAS bf16*)(L + RG_XC + (16 * q + i) * RG_XCS + 2 * c) = (bf16)f2bf(xc[i]); }
                __syncthreads();
#pragma unroll
                for (int m = 0; m < 4; ++m) {
                    if (m < nmb) {
                        f32x4 acc0 = (f32x4){0.f, 0.f, 0.f, 0.f}, acc1 = acc0;
#pragma unroll
                        for (int ks = 0; ks < 4; ++ks) { const bf16x8 a = *(const LAS bf16x8*)(L + RG_XC + (16 * m + fr) * RG_XCS + 64 * ks + 16 * fq);
                            acc0 = __builtin_amdgcn_mfma_f32_16x16x32_bf16(Bw[0][ks], a, acc0, 0, 0, 0); acc1 = __builtin_amdgcn_mfma_f32_16x16x32_bf16(Bw[1][ks], a, acc1, 0, 0, 0); }
                        f32x4 g0, g1;
#pragma unroll
                        for (int e = 0; e < 4; ++e) { g0[e] = pg8::fast_sigmoid(acc0[e] + gb[0][e]); g1[e] = pg8::fast_sigmoid(acc1[e] + gb[1][e]); }
                        LAS unsigned char* gp = L + RG_G + k2 * (64 * RG_GS) + (16 * m + fr) * RG_GS + (32 * dq + 4 * fq) * 4;
                        *(LAS f32x4*)gp = g0; *(LAS f32x4*)(gp + 64) = g1;
                    }
                }
                __syncthreads();
                float A = 1.f, B = 0.f;
#pragma unroll
                for (int i = 0; i < 16; ++i) {
                    if (act) { const float r = *(const LAS float*)(L + RG_G + (16 * q + i) * RG_GS + 4 * c), ig = *(const LAS float*)(L + RG_G + 64 * RG_GS + (16 * q + i) * RG_GS + 4 * c);
                        const float a = __builtin_amdgcn_exp2f(r * ls8), bb = __builtin_sqrtf(fmaxf(1.f - a * a, 0.f)) * (ig * xc[i]);
                        const unsigned w = pk2(1.f - a, bb);
                        const int T = T0 + i; const size_t row = (size_t)(row0 + T);
                        AB[row * DM + ch] = w;
                        const float ar = 1.f - __uint_as_float(w << 16), br = __uint_as_float(w & 0xffff0000u);
                        A *= ar; B = ar * B + br;
                        if (smp) { if (T >= 13) P_OUT[O_CS + ((size_t)b * 3 + (T - 13)) * DM + ch] = v[i + 3]; }
                        else { if (row >= 16397) P_OUT[O_CP + (row - 16397) * DM + ch] = v[i + 3]; }
                    }
                }
                *(LAS f32x2*)(L + RG_SQ + (q * 128 + c) * 8) = (f32x2){A, B};
                __syncthreads();
                float As = 1.f, Bs = 0.f;
#pragma unroll
                for (int qq = 0; qq < 4; ++qq) { const f32x2 sq = *(const LAS f32x2*)(L + RG_SQ + (qq * 128 + c) * 8); Bs = sq.x * Bs + sq.y; As *= sq.x; }
                Bt = As * Bt + Bs; At = As * At;
            }
            if (q == 0 && !smp) *(GAS f32x2*)(P_TS + ((size_t)tl * 2048 + ch) * 2) = (f32x2){At, Bt};
#undef RG_LOADV
        } else {
            float hc = 0.f;
            if (smp) hc = P_IN(I_SH)[b * 2048 + ch];
            else {
                float As = 1.f, Bs = 0.f;
#pragma unroll
                for (int hb = 0; hb < 2; ++hb) { f32x2 ab[8];
#pragma unroll
                    for (int k = 0; k < 8; ++k) { const int i = 16 * q + 8 * hb + k; ab[k] = i < tl ? *(const GAS f32x2*)(P_TS + ((size_t)i * 2048 + ch) * 2) : (f32x2){1.f, 0.f}; }
#pragma unroll
                    for (int k = 0; k < 8; ++k) { Bs = ab[k].x * Bs + ab[k].y; As *= ab[k].x; } }
                *(LAS f32x2*)(L + RG_SQ + (q * 128 + c) * 8) = (f32x2){As, Bs};
                __syncthreads();
#pragma unroll
                for (int qq = 0; qq < 4; ++qq) { const f32x2 sg = *(const LAS f32x2*)(L + RG_SQ + (qq * 128 + c) * 8); hc = sg.x * hc + sg.y; }
                __syncthreads();
            }
            unsigned wa[4][16]; unsigned short ga[4][16];
#define RG_LOADAB(ss) do { _Pragma("unroll") for (int i = 0; i < 16; ++i) { const size_t row = (size_t)(row0 + 64 * (ss) + 16 * q + i); const bool on_ = act && (ss) < nsub; wa[ss][i] = on_ ? AB[row * DM + ch] : 0u; ga[ss][i] = on_ ? P_GG[row * DM + ch] : (unsigned short)0; } } while (0)
#pragma unroll
            for (int ss = 0; ss < 4; ++ss) RG_LOADAB(ss);
#pragma unroll
            for (int s = 0; s < 4; ++s) { if (s < nsub) {
                unsigned w[16]; unsigned short gg[16];
#pragma unroll
                for (int i = 0; i < 16; ++i) { w[i] = wa[s][i]; gg[i] = ga[s][i]; }
                const int T0 = 64 * s + 16 * q;
                float A = 1.f, B = 0.f;
#pragma unroll
                for (int i = 0; i < 16; ++i) { const float ar = 1.f - __uint_as_float(w[i] << 16), br = __uint_as_float(w[i] & 0xffff0000u); A *= ar; B = ar * B + br; }
                *(LAS f32x2*)(L + RG_SQ + (q * 128 + c) * 8) = (f32x2){A, B};
                __syncthreads();
                float h = hc, hn = hc;
#pragma unroll
                for (int qq = 0; qq < 4; ++qq) { const f32x2 sq = *(const LAS f32x2*)(L + RG_SQ + (qq * 128 + c) * 8); if (qq < q) h = sq.x * h + sq.y; hn = sq.x * hn + sq.y; }
                hc = hn;
                __syncthreads();
                if (act) {
#pragma unroll
                    for (int i = 0; i < 16; ++i) {
                        const float ar = 1.f - __uint_as_float(w[i] << 16), br = __uint_as_float(w[i] & 0xffff0000u);
                        h = ar * h + br;
                        const int T = T0 + i; const size_t row = (size_t)(row0 + T);
                        P_ACT[row * DM + ch] = (bf16)f2bf(bf2f(gg[i]) * h);
                        if (smp) { if (T == 15) P_OUT[O_HS + (size_t)b * DM + ch] = h; }
                        else { if (row == 16399) P_OUT[O_HP + ch] = h; }
                    }
                }
            } }
#undef RG_LOADAB
        }
    }
}

namespace att {
typedef __attribute__((address_space(3))) const char* lcp;
constexpr int KSLOT = 16384, VRING = 65536, STG_OFF = 65536, STG_ROW = 272;
__device__ __forceinline__ int crow(int r, int hi) { return (r & 3) + 8 * (r >> 2) + 4 * hi; }
__device__ __forceinline__ void glds16(const void* gsrc, unsigned lds_dst) { unsigned keep;
    asm volatile("s_mov_b32 %0, m0\n\ts_mov_b32 m0, %2\n\ts_nop 0\n\tglobal_load_lds_dwordx4 %1, off\n\ts_mov_b32 m0, %0" : "=&s"(keep) : "v"(gsrc), "s"(lds_dst) : "memory"); }
__device__ __forceinline__ s16x4 vtr(lcp p) { typedef short v4i16_t __attribute__((ext_vector_type(4))); return __builtin_bit_cast(s16x4, __builtin_amdgcn_ds_read_tr16_b64_v4i16((__attribute__((address_space(3))) v4i16_t*)p)); }
__device__ __forceinline__ unsigned cvtpk(float lo, float hi) { typedef __bf16 bf16x2_t __attribute__((ext_vector_type(2))); f32x2 v = {lo, hi}; bf16x2_t b = __builtin_convertvector(v, bf16x2_t); return __builtin_bit_cast(unsigned, b); }
#define ATT_WAIT_BAR(N) asm volatile("s_waitcnt vmcnt(" #N ") lgkmcnt(0)\n\ts_barrier" ::: "memory")
struct UnitDesc { const bf16* Kb; const bf16* Vb; int qrow0, kb0, NT, NTF, h, sample, nvalid, dyn; float mref; };

template <int THR> __device__ __forceinline__ void attn_unit_s(LAS unsigned char* lds, const bf16* Q, bf16* O, const UnitDesc U, const float slope2, const float lam, const float* subg) {
    int tid_l = threadIdx.x; asm volatile("" : "+v"(tid_l));
    const int tid = tid_l, lane = tid & 63, r32 = lane & 31, hi = lane >> 5; const int wid = __builtin_amdgcn_readfirstlane(tid >> 6), rg = wid & 3, cc = wid >> 2;
    const unsigned lds0 = (unsigned)(uintptr_t)lds;
    const lcp L3 = (lcp)lds;
    const int qrow = U.qrow0 + (U.sample ? 0 : 32 * rg) + r32;
    const int qpos = U.sample ? 2064 + r32 : qrow;
    const int t_first = U.sample ? 0 : 1 - (rg >> 1);
    const bool wactive = U.sample ? (rg == 0) : true;
    const int NT = U.NT;
    const int kkey0 = 8 * wid + (lane >> 4);
    const bf16* ksrc = U.Kb + (size_t)kkey0 * DM + U.h * 128 + (((lane & 15) ^ (kkey0 & 15)) * 8);
    const bf16* ksrc2 = U.Kb + (size_t)(kkey0 + 4) * DM + U.h * 128 + (((lane & 15) ^ ((kkey0 + 4) & 15)) * 8);
    const bf16* vsrc = U.Vb + (size_t)(32 * (wid & 1) + (lane >> 2)) * DM + U.h * 128 + (wid >> 1) * 32 + (lane & 3) * 8;
    const unsigned kdst = lds0 + 2048u * (unsigned)wid, vdst = lds0 + VRING + 2048u * (unsigned)wid;
#define ATT_DMA_K(t) do { int kb_ = U.kb0 - 64 * (t); kb_ = kb_ < 0 ? 0 : kb_; const size_t ro_ = (size_t)kb_ * DM; const unsigned so_ = (unsigned)(((t) & 3) * KSLOT); \
        glds16(ksrc + ro_, (unsigned)__builtin_amdgcn_readfirstlane(kdst + so_)); glds16(ksrc2 + ro_, (unsigned)__builtin_amdgcn_readfirstlane(kdst + so_ + 1024u)); } while (0)
#define ATT_DMA_V(t) do { int kb_ = U.kb0 - 64 * (t); kb_ = kb_ < 0 ? 0 : kb_; const size_t ro_ = (size_t)kb_ * DM; const unsigned so_ = (unsigned)(((t) & 3) * KSLOT); \
        glds16(vsrc + ro_, (unsigned)__builtin_amdgcn_readfirstlane(vdst + so_)); glds16(vsrc + ro_ + 16 * DM, (unsigned)__builtin_amdgcn_readfirstlane(vdst + so_ + 1024u)); } while (0)
    bf16x8 qf[4];
    { const bf16* qp = Q + (size_t)qrow * DM + U.h * 128 + cc * 64 + hi * 8;
#pragma unroll
      for (int d0 = 0; d0 < 4; ++d0) qf[d0] = *(const GAS bf16x8*)(qp + d0 * 16); }
    asm volatile("s_waitcnt vmcnt(0)" ::: "memory");
    ATT_DMA_K(0); ATT_DMA_V(0);
    if (NT > 1) { ATT_DMA_K(1); ATT_DMA_V(1); }
    if (NT > 2) ATT_DMA_K(2);
    const bool dyn = U.dyn != 0;
    float m = dyn ? 0.f : U.mref, l = 0.f; bool first = dyn;
    f32x16 o[4];
#pragma unroll
    for (int d = 0; d < 4; ++d)
#pragma unroll
        for (int r = 0; r < 16; ++r) o[d][r] = 0.f;
    f32x16 pA0, pA1; v4u pw[4];
#define ATT_QK(tt, P0, P1) do { int kb = U.kb0 - 64 * (tt); kb = kb < 0 ? 0 : kb; \
        const bool gen = ((tt) == t_first) || (!U.sample && (tt) == U.NTF - 1); \
        if (gen) { const int vhi = (!U.sample && (tt) == U.NTF - 1) ? 16 : (U.sample ? 2080 : (1 << 30)); \
            _Pragma("unroll") for (int r = 0; r < 16; ++r) { const int kp = kb + crow(r, hi); \
                P0[r] = kp < vhi ? -slope2 * __builtin_fabsf((float)(qpos - kp)) - m : -INFINITY; \
                P1[r] = kp + 32 < vhi ? -slope2 * __builtin_fabsf((float)(qpos - kp - 32)) - m : -INFINITY; } \
        } else { const float tb = slope2 * (float)(kb + 4 * hi - qpos) - m; \
            const float s8_ = 8.0f * slope2, s32_ = 32.0f * slope2; \
            _Pragma("unroll") for (int r = 0; r < 16; ++r) { P0[r] = (r == 0) ? tb : ((r & 3) == 0 ? P0[r - 4] + s8_ : P0[r - 1] + slope2); P1[r] = P0[r] + s32_; } } \
        const lcp kp_ = L3 + (unsigned)(((tt) & 3) * KSLOT) + r32 * 256; \
        _Pragma("unroll") for (int d0 = 0; d0 < 4; ++d0) { const int po_ = ((8 * cc + 2 * d0 + hi) ^ (r32 & 15)) * 16; const bf16x8 a0 = *(const LAS bf16x8*)(kp_ + po_), a1 = *(const LAS bf16x8*)(kp_ + po_ + 32 * 256); \
            P0 = __builtin_amdgcn_mfma_f32_32x32x16_bf16(a0, qf[d0], P0, 0, 0, 0); P1 = __builtin_amdgcn_mfma_f32_32x32x16_bf16(a1, qf[d0], P1, 0, 0, 0); } } while (0)
#define ATT_PV(tt) do { const lcp vp = L3 + VRING + (unsigned)(((tt) & 3) * KSLOT) + (4 * hi + ((lane & 15) >> 2)) * 64 + ((lane >> 4) & 1) * 32 + (lane & 3) * 8; \
        _Pragma("unroll") for (int db = 0; db < 4; ++db) { if (db == 2) __builtin_amdgcn_sched_barrier(0); \
            _Pragma("unroll") for (int ks = 0; ks < 4; ++ks) { const s16x4 lo = vtr(vp + (db * 4 + ks) * 1024), hh = vtr(vp + (db * 4 + ks) * 1024 + 512); \
                const bf16x8 a = (bf16x8){lo[0], lo[1], lo[2], lo[3], hh[0], hh[1], hh[2], hh[3]}; \
                o[db] = __builtin_amdgcn_mfma_f32_32x32x16_bf16(a, __builtin_bit_cast(bf16x8, pw[ks]), o[db], 0, 0, 0); } } \
        __builtin_amdgcn_sched_barrier(0); } while (0)
#define ATT_STEP(t, PC0, PC1) do { \
        { const int nw_ = (((t) + 2 < NT) ? 2 : 0) + (((t) + 1 < NT) ? 2 : 0); if (nw_ == 4) { ATT_WAIT_BAR(4); } else if (nw_ == 2) { ATT_WAIT_BAR(2); } else { ATT_WAIT_BAR(0); } } \
        if ((t) + 3 < NT) ATT_DMA_K((t) + 3); \
        if ((t) + 2 < NT) ATT_DMA_V((t) + 2); \
        if (pvpend) { ATT_PV((t) - 1); pvpend = false; } \
        if (wactive && (t) >= t_first) { \
            ATT_QK(t, PC0, PC1); \
            if (dyn) { \
                float mx = __builtin_fmaxf(PC0[0], PC1[0]); \
                _Pragma("unroll") for (int r = 1; r < 16; ++r) mx = __builtin_fmaxf(mx, __builtin_fmaxf(PC0[r], PC1[r])); \
                { auto rr = __builtin_amdgcn_permlane32_swap(__float_as_uint(mx), __float_as_uint(mx), false, false); mx = __builtin_fmaxf(__uint_as_float(rr[0]), __uint_as_float(rr[1])); } \
                if (first || __any(mx > (float)THR)) { \
                    const float dl = first ? mx : __builtin_fmaxf(mx, 0.f); m += dl; \
                    _Pragma("unroll") for (int r = 0; r < 16; ++r) { PC0[r] -= dl; PC1[r] -= dl; } \
                    if (!first) { const float f = __builtin_amdgcn_exp2f(-dl); l *= f; \
                        _Pragma("unroll") for (int d = 0; d < 4; ++d) _Pragma("unroll") for (int r = 0; r < 16; ++r) o[d][r] *= f; } \
                    first = false; } } \
            float sacc = 0.f; \
            _Pragma("unroll") for (int r = 0; r < 16; ++r) { PC0[r] = __builtin_amdgcn_exp2f(PC0[r]); PC1[r] = __builtin_amdgcn_exp2f(PC1[r]); sacc += PC0[r] + PC1[r]; } \
            l += sacc; \
            _Pragma("unroll") for (int j = 0; j < 4; ++j) { pw[0][j] = cvtpk(PC0[2 * j], PC0[2 * j + 1]); pw[1][j] = cvtpk(PC0[8 + 2 * j], PC0[8 + 2 * j + 1]); pw[2][j] = cvtpk(PC1[2 * j], PC1[2 * j + 1]); pw[3][j] = cvtpk(PC1[8 + 2 * j], PC1[8 + 2 * j + 1]); } \
            if (cc == 0) { ATT_PV(t); } else pvpend = true; \
        } } while (0)
    if (NT > 2) { ATT_WAIT_BAR(6); } else if (NT > 1) { ATT_WAIT_BAR(4); } else { ATT_WAIT_BAR(0); }
    bool pvpend = false;
    for (int t = 0; t < NT; ++t) ATT_STEP(t, pA0, pA1);
    if (pvpend) ATT_PV(NT - 1);
#undef ATT_QK
#undef ATT_PV
#undef ATT_STEP
    { auto rr = __builtin_amdgcn_permlane32_swap(__float_as_uint(l), __float_as_uint(l), false, false); l = __uint_as_float(rr[0]) + __uint_as_float(rr[1]); }
    ATT_WAIT_BAR(0);
    const float inv = 1.0f / l;
    if (wactive && cc == 1) { const float sc = inv * lam;
#pragma unroll
        for (int db = 0; db < 4; ++db)
#pragma unroll
            for (int r = 0; r < 16; ++r) *(LAS float*)(lds + rg * 16384 + ((db * 16 + r) * 64 + lane) * 4) = o[db][r] * sc; }
    ATT_WAIT_BAR(0);
    if (wactive && cc == 0) {
        float ss = 0.f;
#pragma unroll
        for (int db = 0; db < 4; ++db)
#pragma unroll
            for (int r = 0; r < 16; ++r) { const float x = *(const LAS float*)(lds + rg * 16384 + ((db * 16 + r) * 64 + lane) * 4); const float d = o[db][r] * inv - x; o[db][r] = d; ss += d * d; }
        { auto rr = __builtin_amdgcn_permlane32_swap(__float_as_uint(ss), __float_as_uint(ss), false, false); ss = __uint_as_float(rr[0]) + __uint_as_float(rr[1]); }
        const float rs = __builtin_amdgcn_rsqf(ss * (1.0f / 128.0f) + 1e-6f) * (1.0f - LAM_INIT);
        LAS unsigned char* stg = lds + STG_OFF + rg * (32 * STG_ROW);
#pragma unroll
        for (int db = 0; db < 4; ++db)
#pragma unroll
            for (int rq = 0; rq < 4; ++rq) { const int dv = 32 * db + 8 * rq + 4 * hi; const f32x4 g = *(const GAS f32x4*)(subg + dv);
                v2u w; w.x = cvtpk(o[db][4 * rq] * rs * g[0], o[db][4 * rq + 1] * rs * g[1]); w.y = cvtpk(o[db][4 * rq + 2] * rs * g[2], o[db][4 * rq + 3] * rs * g[3]);
                *(LAS v2u*)(stg + r32 * STG_ROW + dv * 2) = w; }
        asm volatile("s_waitcnt lgkmcnt(0)" ::: "memory");
        bf16* Ow = O + (size_t)(U.qrow0 + (U.sample ? 0 : 32 * rg)) * DM + U.h * 128;
#pragma unroll
        for (int it = 0; it < 8; ++it) { const int row = it * 4 + (lane >> 4), chk = lane & 15; const v4u vv = *(const LAS v4u*)(stg + row * STG_ROW + chk * 16);
            if (row < U.nvalid) *(GAS v4u*)(Ow + (size_t)row * DM + chk * 8) = vv; }
    }
    asm volatile("s_waitcnt vmcnt(0)" ::: "memory");
    ATT_WAIT_BAR(0);
#undef ATT_DMA_K
#undef ATT_DMA_V
}
__device__ __forceinline__ void attn_unit_p(LAS unsigned char* lds, const bf16* Q, bf16* O, const UnitDesc U, const float slope2, volatile LAS unsigned* lamp, const float* subg) {
    int tid_l = threadIdx.x; asm volatile("" : "+v"(tid_l));
    const int tid = tid_l, lane = tid & 63, r32 = lane & 31, hi = lane >> 5; const int wid = __builtin_amdgcn_readfirstlane(tid >> 6);
    const unsigned lds0 = (unsigned)(uintptr_t)lds;
    const lcp L3 = (lcp)lds;
    const int qpos = U.qrow0 + 32 * wid + r32;
    const int t_first = 3 - (wid >> 1);
    const int NT = U.NT;
    const int kkey0 = 8 * wid + (lane >> 4);
    const bf16* ksrc = U.Kb + (size_t)kkey0 * DM + U.h * 128 + (((lane & 15) ^ (kkey0 & 15)) * 8);
    const int kd2 = 4 * DM + (((((lane & 15) ^ (kkey0 & 15)) & 4) != 0) ? -32 : 32);
    const bf16* vsrc = U.Vb + (size_t)(32 * (wid & 1) + (lane >> 2)) * DM + U.h * 128 + (wid >> 1) * 32 + (lane & 3) * 8;
    const unsigned kxo = (unsigned)(r32 * 256 + ((hi ^ (r32 & 15)) * 16));
    const unsigned kdst = lds0 + 2048u * (unsigned)wid, vdst = lds0 + 32768u + 2048u * (unsigned)wid;
#define ATT_DMA2(t) do { int kb_ = U.kb0 - 64 * (t); kb_ = kb_ < 0 ? 0 : kb_; const size_t ro_ = (size_t)kb_ * DM; const unsigned so_ = (unsigned)(((t) & 1) * KSLOT); \
        glds16(ksrc + ro_, (unsigned)__builtin_amdgcn_readfirstlane(kdst + so_)); glds16(ksrc + ro_ + kd2, (unsigned)__builtin_amdgcn_readfirstlane(kdst + so_ + 1024u)); \
        glds16(vsrc + ro_, (unsigned)__builtin_amdgcn_readfirstlane(vdst + so_)); glds16(vsrc + ro_ + 16 * DM, (unsigned)__builtin_amdgcn_readfirstlane(vdst + so_ + 1024u)); } while (0)
    const lcp qb_ = L3 + 65536 + wid * 8192 + lane * 16;
    { const bf16* qp = Q + (size_t)qpos * DM + U.h * 128 + hi * 8;
      bf16x8 qv[8];
#pragma unroll
      for (int f = 0; f < 8; ++f) qv[f] = *(const GAS bf16x8*)(qp + (f >> 2) * 64 + (f & 3) * 16);
#pragma unroll
      for (int f = 0; f < 8; ++f) *(LAS bf16x8*)(lds + 65536 + wid * 8192 + f * 1024 + lane * 16) = qv[f]; }
    asm volatile("s_waitcnt vmcnt(0) lgkmcnt(0)" ::: "memory");
    ATT_DMA2(0);
    const float mref = U.mref < 60.0f ? U.mref : 60.0f;
    f32x2 l0v = (f32x2){0.f, 0.f}, l1v = l0v;
    f32x16 o[2][4];
#pragma unroll
    for (int c = 0; c < 2; ++c)
#pragma unroll
        for (int d = 0; d < 4; ++d)
#pragma unroll
            for (int r = 0; r < 16; ++r) o[c][d][r] = 0.f;
    ATT_WAIT_BAR(0);
    for (int t = 0; t < NT; ++t) {
        if (t + 1 < NT) ATT_DMA2(t + 1);
        if (t >= t_first) {
            int kb = U.kb0 - 64 * t; kb = kb < 0 ? 0 : kb;
            const bool gen = (t == t_first) || (t == U.NTF - 1);
            const int vhi = (t == U.NTF - 1) ? 16 : (1 << 30);
            unsigned kxt = kxo + (unsigned)((t & 1) * KSLOT); asm volatile("" : "+v"(kxt));
            const lcp vp = L3 + 32768 + (unsigned)((t & 1) * KSLOT) + (4 * hi + ((lane & 15) >> 2)) * 64 + ((lane >> 4) & 1) * 32 + (lane & 3) * 8;
#pragma unroll
            for (int hf = 0; hf < 2; ++hf) {
                v4u pw[2][2];
#pragma unroll
                for (int c = 0; c < 2; ++c) {
                    f32x16 pp;
                    { const float tb = slope2 * (float)(kb + 32 * hf + 4 * hi - qpos), s8_ = 8.0f * slope2;
                      if (gen) {
                          const int thr = vhi - kb - 32 * hf - 4 * hi; float x = tb;
#pragma unroll
                          for (int r = 0; r < 16; ++r) { const int cr = (r & 3) + 8 * (r >> 2); x = (r == 0) ? tb : ((r & 3) == 0 ? x + (s8_ - 3.0f * slope2) : x + slope2); pp[r] = cr < thr ? -__builtin_fabsf(x) - mref : -INFINITY; }
                      } else { const float tb2 = tb - mref;
                          f32x2 b01 = (f32x2){tb2, tb2 + slope2}, b23 = b01 + (f32x2){2.0f * slope2, 2.0f * slope2};
#pragma unroll
                          for (int q4 = 0; q4 < 4; ++q4) { pp[4 * q4] = b01.x; pp[4 * q4 + 1] = b01.y; pp[4 * q4 + 2] = b23.x; pp[4 * q4 + 3] = b23.y; if (q4 < 3) { b01 += (f32x2){s8_, s8_}; b23 += (f32x2){s8_, s8_}; } } } }
#pragma unroll
                    for (int d0 = 0; d0 < 4; ++d0) { const bf16x8 a0 = *(const LAS bf16x8*)(L3 + ((kxt ^ (unsigned)((8 * c + 2 * d0) * 16)) + (unsigned)(hf * 32 * 256))), qv = *(const LAS bf16x8*)(qb_ + (4 * c + d0) * 1024);
                        pp = __builtin_amdgcn_mfma_f32_32x32x16_bf16(a0, qv, pp, 0, 0, 0); }
#pragma unroll
                    for (int r = 0; r < 16; ++r) pp[r] = __builtin_amdgcn_exp2f(pp[r]);
#pragma unroll
                    for (int r = 0; r < 16; r += 2) { if (c == 0) l0v += (f32x2){pp[r], pp[r + 1]}; else l1v += (f32x2){pp[r], pp[r + 1]}; }
#pragma unroll
                    for (int j = 0; j < 4; ++j) { pw[c][0][j] = cvtpk(pp[2 * j], pp[2 * j + 1]); pw[c][1][j] = cvtpk(pp[8 + 2 * j], pp[8 + 2 * j + 1]); }
                }
#pragma unroll
                for (int db = 0; db < 4; ++db) { if (db == 2) __builtin_amdgcn_sched_barrier(0);
#pragma unroll
                    for (int k2 = 0; k2 < 2; ++k2) { const int ks = 2 * hf + k2; const s16x4 lo = vtr(vp + (db * 4 + ks) * 1024), hh = vtr(vp + (db * 4 + ks) * 1024 + 512);
                        const bf16x8 a = (bf16x8){lo[0], lo[1], lo[2], lo[3], hh[0], hh[1], hh[2], hh[3]};
                        o[0][db] = __builtin_amdgcn_mfma_f32_32x32x16_bf16(a, __builtin_bit_cast(bf16x8, pw[0][k2]), o[0][db], 0, 0, 0);
                        o[1][db] = __builtin_amdgcn_mfma_f32_32x32x16_bf16(a, __builtin_bit_cast(bf16x8, pw[1][k2]), o[1][db], 0, 0, 0); } }
                __builtin_amdgcn_sched_barrier(0);
            }
        }
        ATT_WAIT_BAR(0);
    }
    {
        float l0 = l0v.x + l0v.y, l1 = l1v.x + l1v.y;
        { auto rr = __builtin_amdgcn_permlane32_swap(__float_as_uint(l0), __float_as_uint(l0), false, false); l0 = __uint_as_float(rr[0]) + __uint_as_float(rr[1]); }
        { auto rr = __builtin_amdgcn_permlane32_swap(__float_as_uint(l1), __float_as_uint(l1), false, false); l1 = __uint_as_float(rr[0]) + __uint_as_float(rr[1]); }
        const float i0 = 1.0f / l0, i1 = __uint_as_float(lamp[0]) / l1;
        float ss = 0.f;
#pragma unroll
        for (int db = 0; db < 4; ++db)
#pragma unroll
            for (int r = 0; r < 16; ++r) { const float d = o[0][db][r] * i0 - o[1][db][r] * i1; o[0][db][r] = d; ss += d * d; }
        { auto rr = __builtin_amdgcn_permlane32_swap(__float_as_uint(ss), __float_as_uint(ss), false, false); ss = __uint_as_float(rr[0]) + __uint_as_float(rr[1]); }
        const float rs = __builtin_amdgcn_rsqf(ss * (1.0f / 128.0f) + 1e-6f) * (1.0f - LAM_INIT);
        LAS unsigned char* stg = lds + 65536 + wid * 8192;
        const float* sg_ = subg; asm volatile("" : "+s"(sg_));
#pragma unroll
        for (int db = 0; db < 4; ++db)
#pragma unroll
            for (int rq = 0; rq < 4; ++rq) { const int dv = 32 * db + 8 * rq + 4 * hi; const f32x4 g = *(const GAS f32x4*)(sg_ + dv);
                v2u w; w.x = cvtpk(o[0][db][4 * rq] * rs * g[0], o[0][db][4 * rq + 1] * rs * g[1]); w.y = cvtpk(o[0][db][4 * rq + 2] * rs * g[2], o[0][db][4 * rq + 3] * rs * g[3]);
                *(LAS v2u*)(stg + r32 * 256 + dv * 2) = w; }
        asm volatile("s_waitcnt lgkmcnt(0)" ::: "memory");
        bf16* Ow = O + (size_t)(U.qrow0 + 32 * wid) * DM + U.h * 128;
#pragma unroll
        for (int it = 0; it < 8; ++it) { const int row = it * 4 + (lane >> 4), chk = lane & 15; const v4u vv = *(const LAS v4u*)(stg + row * 256 + chk * 16);
            *(GAS v4u*)(Ow + (size_t)row * DM + chk * 8) = vv; }
    }
    asm volatile("s_waitcnt vmcnt(0) lgkmcnt(0)" ::: "memory");
    ATT_WAIT_BAR(0);
#undef ATT_DMA2
}
}


__device__ __forceinline__ void attn_conv_unit(CArgs& args, int cu) {
    int tid_l = threadIdx.x; asm volatile("" : "+v"(tid_l));
    const int lane = tid_l & 63, wave = __builtin_amdgcn_readfirstlane(tid_l >> 6);
    const __amdgpu_buffer_rsrc_t rs = __builtin_amdgcn_make_buffer_rsrc(P_KS, 0, (int)(264 * MiB), 0x00020000);
#pragma unroll 1
    for (int k = 0; k < 16; k += 2) {
        f32x4 va[2][8];
#pragma unroll
        for (int rr = 0; rr < 2; ++rr) { const int ri = 128 * cu + 16 * wave + k + rr, which = ri >> 15, idx = ri & 32767;
            const float* src = (which ? P_IN(I_CV) : P_IN(I_CK)) + (size_t)idx * DM;
#pragma unroll
            for (int j = 0; j < 4; ++j) { va[rr][2 * j] = *(const GAS f32x4*)(src + 512 * j + 8 * lane); va[rr][2 * j + 1] = *(const GAS f32x4*)(src + 512 * j + 8 * lane + 4); } }
#pragma unroll
        for (int rr = 0; rr < 2; ++rr) { const int ri = 128 * cu + 16 * wave + k + rr, which = ri >> 15, idx = ri & 32767, b = idx >> 11, p = idx & 2047;
            const unsigned off = (unsigned)(((size_t)which * 16 * KS_ROWS + (size_t)b * KS_ROWS + 16 + p) * DM * 2);
#pragma unroll
            for (int j = 0; j < 4; ++j) { const f32x4 a = va[rr][2 * j], bq = va[rr][2 * j + 1];
                v4u o; o.x = pk2(a[0], a[1]); o.y = pk2(a[2], a[3]); o.z = pk2(bq[0], bq[1]); o.w = pk2(bq[2], bq[3]);
                __builtin_amdgcn_raw_buffer_store_b128(o, rs, (int)(off + (unsigned)(512 * j + 8 * lane) * 2u), 0,   16); } }
    }
    asm volatile("s_waitcnt vmcnt(0)" ::: "memory");
    __syncthreads();
    if (threadIdx.x == 0) { const int b = ((128 * cu) & 32767) >> 11; __hip_atomic_fetch_add((unsigned*)(P_CTL + CW_SCONV) + 16 * b, 1u, __ATOMIC_RELAXED, __HIP_MEMORY_SCOPE_AGENT); }
}
__device__ __forceinline__ void attn_phase(const Frame& F, CArgs& args) {
    int ln = threadIdx.x & 63; asm volatile("" : "+v"(ln));
    float lam;
    { const float* dl = P_IN(I_DLAM); const float a = wave_sum(dl[ln] * dl[64 + ln]), b = wave_sum(dl[128 + ln] * dl[192 + ln]); lam = __expf(a) - __expf(b) + LAM_INIT; }
    float tcut, smax2;
    { float mq = __builtin_fabsf(P_IN(I_QNORM)[ln]), mk = __builtin_fabsf(P_IN(I_KNORM)[ln]);
#pragma unroll
      for (int o = 1; o < 64; o <<= 1) { mq = __builtin_fmaxf(mq, __shfl_xor(mq, o)); mk = __builtin_fmaxf(mk, __shfl_xor(mk, o)); }
      tcut = 2.0f * (8.0f * mq * mk * 1.02f) + 106.0f; smax2 = 8.0f * mq * mk * 1.02f * LOG2E; }
    if (threadIdx.x == 0) { F.MISC[20] = __float_as_uint(lam); F.MISC[21] = __float_as_uint(tcut); F.MISC[22] = __float_as_uint(smax2); }
    __syncthreads();
    const bf16* Q = P_ACT; bf16* O = P_A3;
    const int nun = 1024 + 512 + 256;
    unsigned* qctr = (unsigned*)(P_CTL + CW_ATTQ);
    for (;;) {
        if (threadIdx.x == 0) F.MISC[16] = atomicAdd(qctr, 1u);
        __syncthreads();
        const int idx = (int)F.MISC[16];
        if (idx >= nun) break;
        int uid, sunit = -1;
        if (idx < 256) uid = idx;
        else if (idx < 1280) { const int g = (idx - 256) >> 1; if (idx & 1) { attn_conv_unit(args, g); continue; } uid = 256 + g; }
        else { const int g = (idx - 1280) >> 1; if (idx & 1) sunit = g; uid = 768 + g; }
        const float tcut_u = __uint_as_float((unsigned)__builtin_amdgcn_readfirstlane((int)F.MISC[21])), smax2_u = __uint_as_float((unsigned)__builtin_amdgcn_readfirstlane((int)F.MISC[22]));
        att::UnitDesc U;
        if (sunit < 0) { const int jb = 63 - (uid >> 4); U.h = 15 - (uid & 15); U.Kb = P_KP; U.Vb = P_VP; U.qrow0 = 16 + 256 * jb; U.kb0 = 16 + 64 * (4 * jb + 3); U.NTF = 4 * jb + 5; U.sample = 0; U.nvalid = 32;
            const float slope = exp2f(-0.5f * (float)(U.h + 1));
            const float w = (tcut_u / slope + 255.0f) * (1.0f / 64.0f); const int wt = w > 1000.f ? 1000 : (int)w + 1;
            U.NT = wt < U.NTF ? wt : U.NTF; U.dyn = smax2_u < 40.0f ? 0 : 1; U.mref = smax2_u; }
        else {
            const int b = sunit >> 4;
            if (threadIdx.x == 0) { unsigned* cw = (unsigned*)(P_CTL + CW_SCONV) + 16 * b; unsigned sp = 0;
                while (__hip_atomic_load(cw, __ATOMIC_RELAXED, __HIP_MEMORY_SCOPE_AGENT) < 32u && ++sp < (1u << 22)) __builtin_amdgcn_s_sleep(2);
                __builtin_amdgcn_fence(__ATOMIC_ACQUIRE, "agent"); asm volatile("s_waitcnt vmcnt(0)" ::: "memory"); }
            __syncthreads();
            U.h = sunit & 15; U.Kb = P_KS + (size_t)b * KS_ROWS * DM; U.Vb = P_VS + (size_t)b * KS_ROWS * DM; U.qrow0 = ROW_S0 + 16 * b; U.kb0 = 2048; U.NT = 33; U.NTF = 33; U.sample = 1; U.nvalid = 16; U.dyn = 1; U.mref = 0.f; }
        const float slope2 = exp2f(-0.5f * (float)(U.h + 1)) * LOG2E;
        if (sunit < 0) att::attn_unit_p(F.lds + RING_OFF, Q, O, U, slope2, F.MISC + 20, P_IN(I_SUBNORM)); else att::attn_unit_s<8>(F.lds + RING_OFF, Q, O, U, slope2, __uint_as_float(F.MISC[20]), P_IN(I_SUBNORM));
    }
}

__global__ void __launch_bounds__(NWAVES * 64, 2) fwd_kernel(Args args_kv) {
    extern __shared__ __attribute__((aligned(16))) unsigned char lds[];
    Frame F;
    F.lds = (LAS unsigned char*)lds;
    F.MISC = (volatile LAS unsigned*)(F.lds + MISC_OFF);
    F.tid = threadIdx.x; F.lane = F.tid & 63; F.wave = __builtin_amdgcn_readfirstlane(F.tid >> 6); F.G = gridDim.x;
    for (int u = F.tid; u < (LDS_BYTES - LDSCTL_OFF) / 4; u += NWAVES * 64) ((LAS unsigned*)(F.lds + LDSCTL_OFF))[u] = 0u;
    __syncthreads();
    const Args& args = args_kv;
    const int lo = args.ph_lo, hi = args.ph_hi;
    XcdBarrier bar; bar.bar = (unsigned*)(P_CTL + CW_BAR); bar.x = 0; bar.st = nullptr;
    if (hi - lo > 1) bar = xcd_barrier_post((unsigned*)(P_CTL + CW_BAR), F.MISC + 8);
    int ph = 0;
#define RUN() (ph >= lo && ph < hi)
#define SEAM() do { if (ph >= lo && ph + 1 < hi) xcd_barrier(bar); ++ph; } while (0)
#define SEAM_NOBAR() do { if (MK_PER_PHASE) { SEAM(); } else { ++ph; } } while (0)

    if (RUN() && EN_P0) p0_prologue(F, *largs());
    SEAM();
    for (int ls = 0; ls < 4; ++ls) {
        if (RUN() && EN_GU) {
            CArgs& args = *largs();
            pg8::Gemm g{P_X16, P_WGU + (size_t)ls * 11264 * DM, MROWS, 11264, DM}; pg8::SplitOrder S; S.init(11264, DM, F.G, lbid(), 2, ph * 128, P_SLAB, P_SCNT, 120, 1);
            const int si = ls == 0 ? 0 : ls == 1 ? 2 : ls == 2 ? 3 : 5;
            pg8::EpiGU E{P_HID, P_SSQ + (size_t)si * MROWS};
            pg8::gemm_phase<pg8::EpiGU, pg8::SplitOrder, PG8_ALIGN, PG8_SP2>(F.lds + RING_OFF, g, S, E);
        }
        SEAM();
        if (RUN() && EN_DN) {
            CArgs& args = *largs();
            pg8::Gemm g{P_HID, P_WDN + (size_t)ls * DM * DFF, MROWS, DM, DFF}; pg8::SplitOrder S; S.init(DM, DFF, F.G, lbid(), 8, ph * 128, P_SLAB, P_SCNT);
            const int so = ls == 0 ? 1 : ls == 1 ? 3 : ls == 2 ? 4 : 0;
            pg8::EpiRes E{P_X16, P_SSQ + (size_t)so * MROWS, 0.5f, ls == 3 ? 1 : 0, P_OUT + O_YP, P_OUT + O_YS};
            pg8::gemm_phase<pg8::EpiRes, pg8::SplitOrder, PG8_ALIGN, PG8_SP2>(F.lds + RING_OFF, g, S, E);
        }
        SEAM();
        if (ls == 0) {
            if (RUN() && EN_WIN) {
            CArgs& args = *largs();
                pg8::Gemm g{P_X16, P_WIN, MROWS, 4096, DM}; pg8::SplitOrder S; S.init(4096, DM, F.G, lbid(), 4, ph * 128, P_SLAB, P_SCNT);
                pg8::EpiWin E{P_GG, P_XB, P_SSQ + (size_t)1 * MROWS};
                pg8::gemm_phase<pg8::EpiWin, pg8::SplitOrder, PG8_ALIGN, PG8_SP2>(F.lds + RING_OFF, g, S, E);
            }
            SEAM();
            if (RUN() && EN_RG0) rg_phase<0>(F, *largs());
            SEAM();
            if (RUN() && EN_RG1) rg_phase<1>(F, *largs());
            SEAM();
        } else if (ls == 1) {
            if (RUN() && EN_KV) {
            CArgs& args = *largs();
                pg8::Gemm g{P_X16, P_WKV, MROWS, 4096, DM}; pg8::SplitOrder S; S.init(4096, DM, F.G, lbid(), 4, ph * 128, P_SLAB + (size_t)256 * 32768, P_SCNT);
                pg8::EpiKV E{P_SSQ + (size_t)3 * MROWS, P_IN(I_KNORM), P_OUT + O_KP, P_OUT + O_VP, P_OUT + O_KS, P_OUT + O_VS, P_KP, P_VP, P_KS, P_VS};
                pg8::gemm_phase<pg8::EpiKV, pg8::SplitOrder, PG8_ALIGN, PG8_SP2>(F.lds + RING_OFF, g, S, E);
            }
            SEAM_NOBAR();
        } else if (ls == 2) {
            if (RUN() && EN_Q) {
            CArgs& args = *largs();
                pg8::Gemm g{P_X16, P_WQ, MROWS, DM, DM}; pg8::SplitOrder S; S.init(DM, DM, F.G, lbid(), 4, ph * 128, P_SLAB, P_SCNT);
                pg8::EpiQ E{P_SSQ + (size_t)4 * MROWS, P_IN(I_QNORM), P_ACT, 0.125f * LOG2E};
                pg8::gemm_phase<pg8::EpiQ, pg8::SplitOrder, PG8_ALIGN, PG8_SP2>(F.lds + RING_OFF, g, S, E);
            }
            SEAM();
            if (RUN() && EN_ATT) attn_phase(F, *largs());
            SEAM();
        }
        if (ls == 0 || ls == 2) {
            if (RUN() && EN_RES) {
            CArgs& args = *largs();
                pg8::Gemm g{ls == 0 ? P_ACT : P_A3, ls == 0 ? P_WOUT : P_WO, MROWS, DM, DM}; pg8::SplitOrder S; S.init(DM, DM, F.G, lbid(), 4, ph * 128, P_SLAB, P_SCNT);
                pg8::EpiRes E{P_X16, P_SSQ + (size_t)(ls == 0 ? 2 : 5) * MROWS, 1.0f, 0, P_OUT + O_YP, P_OUT + O_YS};
                pg8::gemm_phase<pg8::EpiRes, pg8::SplitOrder, PG8_ALIGN, PG8_SP2>(F.lds + RING_OFF, g, S, E);
            }
            SEAM();
        }
    }
#undef RUN
#undef SEAM
}

extern "C" void kernel_launch(void* const* d_in, const int* in_sizes, int n_in, void* d_out, int out_size, void* d_ws, size_t ws_size, hipStream_t stream) {
    static int grid = 0;
    if (grid == 0) {
        if (n_in != 28 || in_sizes[0] != 16384 * DM || (size_t)out_size != O_END || ws_size < WS_END) {
            fprintf(stderr, "kernel_launch: unexpected shapes: n_in %d, in0 %d, out %d, ws %zu (need %zu); nothing launched\n", n_in, n_in > 0 ? in_sizes[0] : -1, out_size, ws_size, (size_t)WS_END); grid = -1; return; }
        int dev = 0, cus = 0, per_cu = 0;
        if (hipGetDevice(&dev) != hipSuccess || hipDeviceGetAttribute(&cus, hipDeviceAttributeMultiprocessorCount, dev) != hipSuccess) { grid = -1; return; }
        if (hipFuncSetAttribute((const void*)fwd_kernel, hipFuncAttributeMaxDynamicSharedMemorySize, LDS_BYTES) != hipSuccess) { fprintf(stderr, "kernel_launch: hipFuncSetAttribute failed\n"); grid = -1; return; }
        if (hipOccupancyMaxActiveBlocksPerMultiprocessor(&per_cu, (const void*)fwd_kernel, NWAVES * 64, LDS_BYTES) != hipSuccess || per_cu < 1) { fprintf(stderr, "kernel_launch: occupancy query says %d blocks per CU\n", per_cu); }
        (void)hipGetLastError();
        grid = cus;
    }
    if (grid < 0) return;
    if (hipMemsetAsync((char*)d_ws + WS_CTL, 0, CTL_ZERO_BYTES, stream) != hipSuccess) return;
    Args a{};
    for (int i = 0; i < 28; ++i) a.in[i] = (const float*)d_in[i];
    a.out = (float*)d_out; a.ws = (unsigned char*)d_ws;
#if MK_PER_PHASE
    for (int p = 0; p < NPHASE; ++p) { a.ph_lo = p; a.ph_hi = p + 1; hipLaunchKernelGGL(fwd_kernel, dim3(grid), dim3(NWAVES * 64), LDS_BYTES, stream, a); }
#else
    a.ph_lo = 0; a.ph_hi = NPHASE;
    hipLaunchKernelGGL(fwd_kernel, dim3(grid), dim3(NWAVES * 64), LDS_BYTES, stream, a);
#endif
    const hipError_t le = hipPeekAtLastError();
    if (le != hipSuccess) fprintf(stderr, "kernel_launch: launch failed: %s\n", hipGetErrorName(le));
}
```

```cpp
#include <hip/hip_runtime.h>
#include <cstdio>
#include <cstdint>
namespace pg8 {
#define PG8_LAS __attribute__((address_space(3)))
typedef unsigned short bf16_t;
typedef short bf16x8 __attribute__((ext_vector_type(8)));
typedef float f32x4 __attribute__((ext_vector_type(4)));
typedef unsigned u32x4 __attribute__((ext_vector_type(4)));
constexpr int BM = 256, BK = 64, HALF = 128, HTB = HALF * BK * 2  , STAGE_BYTES = 8 * HTB, NXCD = 8, WGM = 8;

__host__ __device__ __forceinline__ int lds_byte(int r, int c) { const int st = (r >> 4) * 2 + (c >> 5), rr = r & 15, cc = c & 31, ob = rr * 64 + cc * 2; return st * 1024 + (ob ^ (((ob >> 9) & 1) << 5)); }
__host__ __device__ __forceinline__ void stage_rc(int b, int& R, int& C) { const int st = b / 1024, sb = b % 1024, swz = sb ^ (((sb >> 9) & 1) << 5); R = (st >> 1) * 16 + swz / 64; C = (st & 1) * 32 + (swz % 64) / 2; }
__host__ __device__ __forceinline__ int perm32(int rho) { const int n = rho >> 4, i = rho & 15; return 8 * (i >> 2) + 4 * n + (i & 3); }

struct Unit { int pm, pn, kt0, nt, nsplit, slab, cidx, half; };
struct Gemm { const bf16_t* A; const bf16_t* Bt; int M, N, K; };

struct StaticOrder {
    int nM, nN, nwg, G, c;
    __host__ __device__ void init(int M, int N, int G_, int c_) { nM = M / BM; nN = N / BM; nwg = nM * nN; G = G_; c = c_; }
    __host__ __device__ bool next(int i, Unit& u) const {
        const long L = (long)i * G + c; if (L >= nwg) return false;
        int wgid = (int)L; { const int q = nwg / NXCD, r = nwg % NXCD, xcd = wgid % NXCD, off = wgid / NXCD; wgid = (xcd < r ? xcd * (q + 1) : r * (q + 1) + (xcd - r) * q) + off; }
        const int nig = WGM * nN, gid = wgid / nig, fm = gid * WGM, gsz = (nM - fm) < WGM ? (nM - fm) : WGM;
        u.pm = 2 * (fm + ((wgid % nig) % gsz)); u.pn = (wgid % nig) / gsz; u.kt0 = 0; u.nt = 0; u.nsplit = 1; u.slab = 0; u.cidx = 0; u.half = 0; return true;
    }
    __device__ __forceinline__ void a_ready(const Unit&) const {}
    __device__ __forceinline__ void done(const Unit&) const {}
};

__device__ __forceinline__ unsigned cvt_pk_bf16(float lo, float hi) { unsigned r; asm volatile("v_cvt_pk_bf16_f32 %0, %1, %2" : "=v"(r) : "v"(lo), "v"(hi)); return r; }
constexpr float RMS_EPS = 1e-6f;
__device__ __forceinline__ float row_rstd(const float* ssq, int row) { return __builtin_amdgcn_rsqf(ssq[row] * (1.0f / 2048.0f) + RMS_EPS); }
__device__ __forceinline__ float fast_sigmoid(float x) { return __builtin_amdgcn_rcpf(1.0f + __builtin_amdgcn_exp2f(-1.4426950408889634f * x)); }
__device__ __forceinline__ u32x4 pack8(const f32x4 a, const f32x4 b) { u32x4 w; w.x = cvt_pk_bf16(a[0], a[1]); w.y = cvt_pk_bf16(a[2], a[3]); w.z = cvt_pk_bf16(b[0], b[1]); w.w = cvt_pk_bf16(b[2], b[3]); return w; }

struct EpiGU {
    static constexpr bool PERM = true, AFTER_DRAIN = false;
    bf16_t* H; const float* ssq;
    template <bool HF> __device__ __forceinline__ void run(const f32x4 (&acc)[2][2][4][2], const Unit& u, int wr, int wc, int fr, int fq) const {
        typedef float f2 __attribute__((ext_vector_type(2)));
        typedef __bf16 b2 __attribute__((ext_vector_type(2)));
        const int colh = u.pn * 128 + wc * 32 + 8 * fq;
        float rsv[8];
#pragma unroll
        for (int i = 0; i < (HF ? 4 : 8); ++i) rsv[i] = row_rstd(ssq, u.pm * HALF + (i >> 2) * HALF + wr * 64 + (i & 3) * 16 + fr);
#pragma unroll
        for (int ai = 0; ai < (HF ? 1 : 2); ++ai)
#pragma unroll
            for (int m = 0; m < 4; ++m) {
                const int row = u.pm * HALF + ai * HALF + wr * 64 + m * 16 + fr; const float rs = rsv[ai * 4 + m];
                const float nrs = -1.4426950408889634f * rs, rs2 = rs * rs;
                f2 g[4], up[4], t[4], r[4];
#pragma unroll
                for (int p = 0; p < 4; ++p) { g[p] = (f2){acc[ai][0][m][p >> 1][2 * (p & 1)], acc[ai][0][m][p >> 1][2 * (p & 1) + 1]}; up[p] = (f2){acc[ai][1][m][p >> 1][2 * (p & 1)], acc[ai][1][m][p >> 1][2 * (p & 1) + 1]}; }
#pragma unroll
                for (int p = 0; p < 4; ++p) t[p] = g[p] * (f2){nrs, nrs};
#pragma unroll
                for (int p = 0; p < 4; ++p) { t[p].x = __builtin_amdgcn_exp2f(t[p].x); t[p].y = __builtin_amdgcn_exp2f(t[p].y); }
#pragma unroll
                for (int p = 0; p < 4; ++p) { t[p] = t[p] + (f2){1.0f, 1.0f}; g[p] = g[p] * up[p]; }
#pragma unroll
                for (int p = 0; p < 4; ++p) { r[p].x = __builtin_amdgcn_rcpf(t[p].x); r[p].y = __builtin_amdgcn_rcpf(t[p].y); }
                u32x4 w;
#pragma unroll
                for (int p = 0; p < 4; ++p) { const f2 h = g[p] * (r[p] * (f2){rs2, rs2}); w[p] = __builtin_bit_cast(unsigned, __builtin_convertvector(h, b2)); }
                *(u32x4*)(H + (size_t)row * 5632 + colh) = w;
            }
    }
    __device__ __forceinline__ void operator()(const f32x4 (&acc)[2][2][4][2], const Unit& u, int wr, int wc, int fr, int fq) const { run<false>(acc, u, wr, wc, fr, fq); }
    __device__ __forceinline__ void half(const f32x4 (&acc)[2][2][4][2], const Unit& u, int wr, int wc, int fr, int fq) const { run<true>(acc, u, wr, wc, fr, fq); }
};
struct EpiRes {
    static constexpr bool PERM = true, AFTER_DRAIN = false;
    bf16_t* x16; float* ssq; float scale; int final_; float* yp; float* ys;
    template <bool HF> __device__ __forceinline__ void run(const f32x4 (&acc)[2][2][4][2], const Unit& u, int wr, int wc, int fr, int fq) const {
        const int col = u.pn * BM + wc * 64 + 8 * fq;
        u32x4 xw[HF ? 4 : 8][2];
#pragma unroll
        for (int i = 0; i < (HF ? 4 : 8); ++i) { const bf16_t* xq = x16 + (size_t)(u.pm * HALF + (i >> 2) * HALF + wr * 64 + (i & 3) * 16 + fr) * 2048 + col; xw[i][0] = *(const u32x4*)xq; xw[i][1] = *(const u32x4*)(xq + 32); }
#pragma unroll
        for (int ai = 0; ai < (HF ? 1 : 2); ++ai)
#pragma unroll
            for (int m = 0; m < 4; ++m) {
                const int row = u.pm * HALF + ai * HALF + wr * 64 + m * 16 + fr;
                bf16_t* xp = x16 + (size_t)row * 2048 + col; float sq = 0.f;
                float* op = nullptr;
                if (final_) { if (row >= 16 && row < 16400) op = yp + (size_t)(row - 16) * 2048 + col; else if (row >= 16400 && row < 16656) op = ys + (size_t)(row - 16400) * 2048 + col; }
                const u32x4 w0 = xw[ai * 4 + m][0], w1 = xw[ai * 4 + m][1];
#pragma unroll
                for (int bj = 0; bj < 2; ++bj) {
                    const u32x4 w = bj ? w1 : w0;
                    const f32x4 x0 = (f32x4){__uint_as_float(w.x << 16), __uint_as_float(w.x & 0xffff0000u), __uint_as_float(w.y << 16), __uint_as_float(w.y & 0xffff0000u)};
                    const f32x4 x1 = (f32x4){__uint_as_float(w.z << 16), __uint_as_float(w.z & 0xffff0000u), __uint_as_float(w.w << 16), __uint_as_float(w.w & 0xffff0000u)};
                    const f32x4 v0 = x0 + acc[ai][bj][m][0] * scale, v1 = x1 + acc[ai][bj][m][1] * scale;
                    if (final_) { if (op) { *(f32x4*)(op + 32 * bj) = v0; *(f32x4*)(op + 32 * bj + 4) = v1; } }
                    else { *(u32x4*)(xp + 32 * bj) = pack8(v0, v1);
                        sq += (v0[0] * v0[0] + v0[1] * v0[1]) + (v0[2] * v0[2] + v0[3] * v0[3]) + (v1[0] * v1[0] + v1[1] * v1[1]) + (v1[2] * v1[2] + v1[3] * v1[3]); }
                }
                if (!final_) { sq += __shfl_xor(sq, 16); sq += __shfl_xor(sq, 32); if (fq == 0) atomicAdd(ssq + row, sq); }
            }
    }
    __device__ __forceinline__ void operator()(const f32x4 (&acc)[2][2][4][2], const Unit& u, int wr, int wc, int fr, int fq) const { run<false>(acc, u, wr, wc, fr, fq); }
    __device__ __forceinline__ void half(const f32x4 (&acc)[2][2][4][2], const Unit& u, int wr, int wc, int fr, int fq) const { run<true>(acc, u, wr, wc, fr, fq); }
};
struct EpiWin {
    static constexpr bool PERM = true, AFTER_DRAIN = false;
    bf16_t* GG; float* XB; const float* ssq;
    template <bool HF> __device__ __forceinline__ void run(const f32x4 (&acc)[2][2][4][2], const Unit& u, int wr, int wc, int fr, int fq) const {
        const int col = (u.pn & 7) * BM + wc * 64 + 8 * fq; const bool isg = u.pn < 8;
        float rsv[HF ? 4 : 8];
#pragma unroll
        for (int i = 0; i < (HF ? 4 : 8); ++i) rsv[i] = row_rstd(ssq, u.pm * HALF + (i >> 2) * HALF + wr * 64 + (i & 3) * 16 + fr);
#pragma unroll
        for (int ai = 0; ai < (HF ? 1 : 2); ++ai)
#pragma unroll
            for (int m = 0; m < 4; ++m) {
                const int row = u.pm * HALF + ai * HALF + wr * 64 + m * 16 + fr; const float rs = rsv[ai * 4 + m];
#pragma unroll
                for (int bj = 0; bj < 2; ++bj) {
                    f32x4 v0 = acc[ai][bj][m][0] * rs, v1 = acc[ai][bj][m][1] * rs;
                    if (isg) {
#pragma unroll
                        for (int e = 0; e < 4; ++e) { const float a = v0[e], b = v1[e];
                            v0[e] = a * fast_sigmoid(1.5957691216057308f * (a + 0.044715f * a * a * a)); v1[e] = b * fast_sigmoid(1.5957691216057308f * (b + 0.044715f * b * b * b)); }
                        *(u32x4*)(GG + (size_t)row * 2048 + col + 32 * bj) = pack8(v0, v1);
                    } else { float* xp = XB + (size_t)row * 2048 + col + 32 * bj; *(f32x4*)xp = v0; *(f32x4*)(xp + 4) = v1; }
                }
            }
    }
    __device__ __forceinline__ void operator()(const f32x4 (&acc)[2][2][4][2], const Unit& u, int wr, int wc, int fr, int fq) const { run<false>(acc, u, wr, wc, fr, fq); }
    __device__ __forceinline__ void half(const f32x4 (&acc)[2][2][4][2], const Unit& u, int wr, int wc, int fr, int fq) const { run<true>(acc, u, wr, wc, fr, fq); }
};
__device__ __forceinline__ float group_rstd64(const f32x4 (&v)[2][2]) {
    float s = 0.f;
#pragma unroll
    for (int bj = 0; bj < 2; ++bj)
#pragma unroll
        for (int n = 0; n < 2; ++n) s += (v[bj][n][0] * v[bj][n][0] + v[bj][n][1] * v[bj][n][1]) + (v[bj][n][2] * v[bj][n][2] + v[bj][n][3] * v[bj][n][3]);
    s += __shfl_xor(s, 16); s += __shfl_xor(s, 32);
    return __builtin_amdgcn_rsqf(s * (1.0f / 64.0f) + RMS_EPS);
}
struct EpiKV {
    static constexpr bool PERM = true, AFTER_DRAIN = false;
    const float* ssq; const float* kg;
    float* okp; float* ovp; float* oks; float* ovs;
    bf16_t* KP; bf16_t* VP; bf16_t* KS; bf16_t* VS;
    template <bool HF> __device__ __forceinline__ void run(const f32x4 (&acc)[2][2][4][2], const Unit& u, int wr, int wc, int fr, int fq) const {
        const bool isk = u.pn < 8; const int col = (u.pn & 7) * BM + wc * 64 + 8 * fq;
        f32x4 g[2][2];
#pragma unroll
        for (int bj = 0; bj < 2; ++bj)
#pragma unroll
            for (int n = 0; n < 2; ++n) g[bj][n] = isk ? *(const f32x4*)(kg + 32 * bj + 8 * fq + 4 * n) : (f32x4){1.f, 1.f, 1.f, 1.f};
        float* o32p = isk ? okp : ovp; float* o32s = isk ? oks : ovs; bf16_t* b16p = isk ? KP : VP; bf16_t* b16s = isk ? KS : VS;
        float rsv[HF ? 4 : 8];
#pragma unroll
        for (int i = 0; i < (HF ? 4 : 8); ++i) rsv[i] = row_rstd(ssq, u.pm * HALF + (i >> 2) * HALF + wr * 64 + (i & 3) * 16 + fr);
#pragma unroll
        for (int ai = 0; ai < (HF ? 1 : 2); ++ai)
#pragma unroll
            for (int m = 0; m < 4; ++m) {
                const int row = u.pm * HALF + ai * HALF + wr * 64 + m * 16 + fr; const float rs = rsv[ai * 4 + m];
                f32x4 v[2][2];
#pragma unroll
                for (int bj = 0; bj < 2; ++bj)
#pragma unroll
                    for (int n = 0; n < 2; ++n) v[bj][n] = acc[ai][bj][m][n] * rs;
                if (isk) { const float gr = group_rstd64(v);
#pragma unroll
                    for (int bj = 0; bj < 2; ++bj)
#pragma unroll
                        for (int n = 0; n < 2; ++n) v[bj][n] = v[bj][n] * gr * g[bj][n]; }
                float* o32 = nullptr; bf16_t* b16 = nullptr;
                if (row < 16400) { o32 = o32p + (size_t)row * 2048; b16 = b16p + (size_t)row * 2048; }
                else if (row < 16656) { const int sr = row - 16400; o32 = o32s + (size_t)sr * 2048; b16 = b16s + ((size_t)(sr >> 4) * 2112 + 2064 + (sr & 15)) * 2048; }
                if (o32) {
#pragma unroll
                    for (int bj = 0; bj < 2; ++bj) { float* p = o32 + col + 32 * bj; *(f32x4*)p = v[bj][0]; *(f32x4*)(p + 4) = v[bj][1]; *(u32x4*)(b16 + col + 32 * bj) = pack8(v[bj][0], v[bj][1]); }
                    if (row < 16) {
                        for (int b = 0; b < 16; ++b) { bf16_t* q = b16s + ((size_t)b * 2112 + row) * 2048 + col;
#pragma unroll
                            for (int bj = 0; bj < 2; ++bj) *(u32x4*)(q + 32 * bj) = pack8(v[bj][0], v[bj][1]); }
                    }
                }
            }
    }
    __device__ __forceinline__ void operator()(const f32x4 (&acc)[2][2][4][2], const Unit& u, int wr, int wc, int fr, int fq) const { run<false>(acc, u, wr, wc, fr, fq); }
    __device__ __forceinline__ void half(const f32x4 (&acc)[2][2][4][2], const Unit& u, int wr, int wc, int fr, int fq) const { run<true>(acc, u, wr, wc, fr, fq); }
};
struct EpiQ {
    static constexpr bool PERM = true, AFTER_DRAIN = false;
    const float* ssq; const float* qg; bf16_t* Q; float c2;
    template <bool HF> __device__ __forceinline__ void run(const f32x4 (&acc)[2][2][4][2], const Unit& u, int wr, int wc, int fr, int fq) const {
        const int col = u.pn * BM + wc * 64 + 8 * fq;
        f32x4 g[2][2];
        float rsv[HF ? 4 : 8];
#pragma unroll
        for (int i = 0; i < (HF ? 4 : 8); ++i) rsv[i] = row_rstd(ssq, u.pm * HALF + (i >> 2) * HALF + wr * 64 + (i & 3) * 16 + fr);
#pragma unroll
        for (int bj = 0; bj < 2; ++bj)
#pragma unroll
            for (int n = 0; n < 2; ++n) g[bj][n] = *(const f32x4*)(qg + 32 * bj + 8 * fq + 4 * n) * c2;
#pragma unroll
        for (int ai = 0; ai < (HF ? 1 : 2); ++ai)
#pragma unroll
            for (int m = 0; m < 4; ++m) {
                const int row = u.pm * HALF + ai * HALF + wr * 64 + m * 16 + fr; const float rs = rsv[ai * 4 + m];
                f32x4 v[2][2];
#pragma unroll
                for (int bj = 0; bj < 2; ++bj)
#pragma unroll
                    for (int n = 0; n < 2; ++n) v[bj][n] = acc[ai][bj][m][n] * rs;
                const float gr = group_rstd64(v);
#pragma unroll
                for (int bj = 0; bj < 2; ++bj) *(u32x4*)(Q + (size_t)row * 2048 + col + 32 * bj) = pack8(v[bj][0] * gr * g[bj][0], v[bj][1] * gr * g[bj][1]);
            }
    }
    __device__ __forceinline__ void operator()(const f32x4 (&acc)[2][2][4][2], const Unit& u, int wr, int wc, int fr, int fq) const { run<false>(acc, u, wr, wc, fr, fq); }
    __device__ __forceinline__ void half(const f32x4 (&acc)[2][2][4][2], const Unit& u, int wr, int wc, int fr, int fq) const { run<true>(acc, u, wr, wc, fr, fq); }
};

struct SplitOrder {
    int nN, nwgP, G, c, nsplit, nsB, TA, npairs, cbase; long skipP; float* slabs; unsigned* cnt;
    __device__ __forceinline__ void init(int N, int K, int G_, int c_, int nsplit_, int cbase_, float* slabs_, unsigned* cnt_, int TA_ = 1 << 20, int nsB_ = 1) {
        nN = N / BM; nwgP = 64 * nN; G = G_; c = c_; nsplit = nsplit_; nsB = nsB_; TA = TA_ < 3 * nN ? TA_ : 3 * nN; npairs = K / (2 * BK); cbase = cbase_; slabs = slabs_; cnt = cnt_; skipP = 0; }
    __device__ __forceinline__ bool next(int i, Unit& u) const {
        const long L = (long)i * G + c + skipP;
        if (L < nwgP) { int wgid = (int)L; { const int q = nwgP / NXCD, r = nwgP % NXCD, xcd = wgid % NXCD, off = wgid / NXCD; wgid = (xcd < r ? xcd * (q + 1) : r * (q + 1) + (xcd - r) * q) + off; }
            const int nig = WGM * nN, gid = wgid / nig, fm = gid * WGM;
            u.pm = 2 * (fm + ((wgid % nig) % WGM)); u.pn = (wgid % nig) / WGM; u.kt0 = 0; u.nt = 2 * npairs; u.nsplit = 1; u.slab = 0; u.cidx = 0; u.half = 0; return true; }
        const int m = (int)(L - nwgP); int tau, j, ns = nsplit, mm = m, t0 = 0;
        const int MA = ((TA + 7) & ~7) * nsplit;
        if (m >= MA) { mm = m - MA; ns = nsB; t0 = TA; }
        if (G == 256) { if (m >= 256) return false; const int x = mm & 7, v = mm >> 3; tau = t0 + 8 * (v / ns) + x; j = v % ns; }
        else { tau = t0 + mm / ns; j = mm % ns; }
        if (tau >= 3 * nN || (t0 == 0 && tau >= TA)) return false;
        const int per = npairs / ns, rem = npairs - per * ns;
        u.pm = 128 + tau / nN; u.pn = tau % nN; u.kt0 = 2 * (j * per + (j < rem ? j : rem)); u.nt = 2 * (per + (j < rem ? 1 : 0)); u.nsplit = ns; u.slab = m; u.cidx = cbase + tau; u.half = 1; return true;
    }
    __device__ __forceinline__ void a_ready(const Unit&) const {}
    __device__ __forceinline__ void done(const Unit&) const {}
    __device__ __forceinline__ bool split_combine(f32x4 (&acc)[2][2][4][2], const Unit& u, int wid, int lane) const {
        const __amdgpu_buffer_rsrc_t rs = __builtin_amdgcn_make_buffer_rsrc(slabs, 0, 256 * 131072, 0x00020000);
        const unsigned voff = ((unsigned)u.slab * 32768u + (unsigned)wid * 4096u + (unsigned)lane * 4u) * 4u;
#pragma unroll
        for (int i = 0; i < 8; ++i) __builtin_amdgcn_raw_buffer_store_b128(pack8(acc[0][(i >> 2) & 1][i & 3][0], acc[0][(i >> 2) & 1][i & 3][1]), rs, (int)(voff + (unsigned)i * 1024u), 0,   16);
        asm volatile("s_waitcnt vmcnt(0)" ::: "memory");
        unsigned t = 0; if (lane == 0) t = __hip_atomic_fetch_add(cnt + (size_t)u.cidx * 8 + wid, 1u, __ATOMIC_RELAXED, __HIP_MEMORY_SCOPE_AGENT);
        t = (unsigned)__builtin_amdgcn_readfirstlane((int)t);
        if (t != (unsigned)(u.nsplit - 1)) return false;
        __builtin_amdgcn_fence(__ATOMIC_ACQUIRE, "agent"); asm volatile("s_waitcnt vmcnt(0)" ::: "memory");
#pragma unroll
        for (int i = 0; i < 8; ++i) { const u32x4 w = pack8(acc[0][(i >> 2) & 1][i & 3][0], acc[0][(i >> 2) & 1][i & 3][1]);
            acc[0][(i >> 2) & 1][i & 3][0] = (f32x4){__uint_as_float(w.x << 16), __uint_as_float(w.x & 0xffff0000u), __uint_as_float(w.y << 16), __uint_as_float(w.y & 0xffff0000u)};
            acc[0][(i >> 2) & 1][i & 3][1] = (f32x4){__uint_as_float(w.z << 16), __uint_as_float(w.z & 0xffff0000u), __uint_as_float(w.w << 16), __uint_as_float(w.w & 0xffff0000u)}; }
        const int MA_ = ((TA + 7) & ~7) * nsplit, rb = u.slab >= MA_ ? MA_ : 0, sr = u.slab - rb;
        const int xs = sr & 7, vs = sr >> 3, own = (G == 256) ? (vs % u.nsplit) : (sr % u.nsplit), base = rb + ((G == 256) ? xs + 8 * ((vs / u.nsplit) * u.nsplit) : sr - own), stride = (G == 256) ? 8 : 1;
        const float* p0 = slabs + (size_t)wid * 4096 + lane * 4;
        const int nq = u.nsplit - 1;
        u32x4 bA[8], bB[8];
#define SC_SLAB(q) (p0 + (size_t)(base + stride * ((q) < own ? (q) : (q) + 1)) * 32768)
#define SC_LOAD(dst, q) do { const float* p_ = SC_SLAB(q); _Pragma("unroll") for (int k = 0; k < 8; ++k) dst[k] = *(const u32x4*)(p_ + k * 256); } while (0)
#define SC_ADD(src) do { _Pragma("unroll") for (int k = 0; k < 8; ++k) { const u32x4 w = src[k]; \
            acc[0][(k >> 2) & 1][k & 3][0] += (f32x4){__uint_as_float(w.x << 16), __uint_as_float(w.x & 0xffff0000u), __uint_as_float(w.y << 16), __uint_as_float(w.y & 0xffff0000u)}; \
            acc[0][(k >> 2) & 1][k & 3][1] += (f32x4){__uint_as_float(w.z << 16), __uint_as_float(w.z & 0xffff0000u), __uint_as_float(w.w << 16), __uint_as_float(w.w & 0xffff0000u)}; } } while (0)
        SC_LOAD(bA, 0);
        for (int q = 0; q < nq; q += 2) {
            if (q + 1 < nq) { SC_LOAD(bB, q + 1); asm volatile("s_waitcnt vmcnt(8)" ::: "memory"); } else asm volatile("s_waitcnt vmcnt(0)" ::: "memory");
            SC_ADD(bA);
            if (q + 1 < nq) {
                if (q + 2 < nq) { SC_LOAD(bA, q + 2); asm volatile("s_waitcnt vmcnt(8)" ::: "memory"); } else asm volatile("s_waitcnt vmcnt(0)" ::: "memory");
                SC_ADD(bB);
            }
        }
#undef SC_SLAB
#undef SC_LOAD
#undef SC_ADD
        return true;
    }
};

template <class Epi, class Sched, bool ALIGN_EPI = false, bool SP2 = false>
__device__ __forceinline__ void gemm_phase(PG8_LAS unsigned char* lds, const Gemm g, const Sched& S, const Epi& E) {
    int tid_l = threadIdx.x; asm volatile("" : "+v"(tid_l));
    const int tid = tid_l, wid = __builtin_amdgcn_readfirstlane(tid >> 6), lane = tid & 63, wr = wid >> 2, wc = wid & 3, fr = lane & 15, fq = lane >> 4;
    const int K = g.K;
    unsigned voffA[2], voffB[2];
#pragma unroll
    for (int i = 0; i < 2; ++i) { int R, C; stage_rc(tid * 16 + i * 8192, R, C); const int Rb = Epi::PERM ? ((R & ~31) + perm32(R & 31)) : R;
        voffA[i] = (unsigned)(R * K + C) * 2u; voffB[i] = (unsigned)(Rb * K + C) * 2u; }
    const size_t kstep = (size_t)(BK * 2);
    const size_t hstep = (size_t)HALF * K * 2;
    const size_t tstep = 2 * hstep;
    const unsigned ldsw = (unsigned)wid * 1024u;
    const int aoff = lds_byte(wr * 64 + fr, fq * 8), boff = lds_byte(wc * 32 + fr, fq * 8);
#define PG8_SA(b, h) (((b) * 2 + (h)) * HTB)
#define PG8_SB(b, h) ((4 + (b) * 2 + (h)) * HTB)
#define PG8_STAGE(bufoff, gbase, voff) do { _Pragma("unroll") for (int _i = 0; _i < 2; ++_i) \
        __builtin_amdgcn_global_load_lds((const unsigned*)((const char*)(gbase) + (voff)[_i]), (PG8_LAS unsigned*)(lds + (bufoff) + ldsw + _i * 8192), 16, 0, 0); } while (0)
#define PG8_LDA(dst, b, h) do { _Pragma("unroll") for (int m = 0; m < 4; ++m) _Pragma("unroll") for (int k = 0; k < 2; ++k) dst[m][k] = *(const PG8_LAS bf16x8*)(lds + PG8_SA(b, h) + aoff + m * 2048 + k * 1024); } while (0)
#define PG8_LDB(dst, b, h) do { _Pragma("unroll") for (int n = 0; n < 2; ++n) _Pragma("unroll") for (int k = 0; k < 2; ++k) dst[n][k] = *(const PG8_LAS bf16x8*)(lds + PG8_SB(b, h) + boff + n * 2048 + k * 1024); } while (0)
#define PG8_MMA(ai, bj, At, Bt) do { __builtin_amdgcn_s_setprio(1); _Pragma("unroll") for (int m = 0; m < 4; ++m) _Pragma("unroll") for (int n = 0; n < 2; ++n) _Pragma("unroll") for (int k = 0; k < 2; ++k) \
        acc[ai][bj][m][n] = __builtin_amdgcn_mfma_f32_16x16x32_bf16(Bt[n][k], At[m][k], acc[ai][bj][m][n], 0, 0, 0); __builtin_amdgcn_s_setprio(0); } while (0)
#define PG8_WAIT_V(n) asm volatile("s_waitcnt vmcnt(" #n ")" ::: "memory")
#define PG8_WAIT_L(n) asm volatile("s_waitcnt lgkmcnt(" #n ")" ::: "memory")
#define PG8_BAR __builtin_amdgcn_s_barrier()
#define PG8_SCHED __builtin_amdgcn_sched_barrier(0)
    Unit cur, nxt; int ui = 0;
    if (!S.next(0, cur)) return;
    f32x4 acc[2][2][4][2];
#pragma unroll
    for (int a = 0; a < 2; ++a)
#pragma unroll
        for (int b = 0; b < 2; ++b)
#pragma unroll
            for (int m = 0; m < 4; ++m)
#pragma unroll
                for (int n = 0; n < 2; ++n) acc[a][b][m][n] = (f32x4){0.f, 0.f, 0.f, 0.f};
    bf16x8 At[4][2], B0[2][2], B1[2][2];
    const char* cA = (const char*)g.A + (size_t)cur.pm * hstep + (size_t)cur.kt0 * kstep; const char* cB = (const char*)g.Bt + (size_t)cur.pn * tstep + (size_t)cur.kt0 * kstep;
    S.a_ready(cur);
    if constexpr (SP2) {
        PG8_STAGE(PG8_SB(0, 0), cB, voffB); PG8_STAGE(PG8_SB(0, 1), cB + hstep, voffB); PG8_STAGE(PG8_SA(0, 0), cA, voffA); PG8_STAGE(PG8_SA(0, 1), cA + hstep, voffA);
        if (wr == 1) PG8_BAR;
        PG8_WAIT_V(2); PG8_BAR;
        PG8_STAGE(PG8_SB(1, 0), cB + kstep, voffB); PG8_STAGE(PG8_SA(1, 0), cA + kstep, voffA); PG8_STAGE(PG8_SB(1, 1), cB + hstep + kstep, voffB);
        PG8_WAIT_V(6); PG8_BAR;
    } else {
        PG8_STAGE(PG8_SB(0, 0), cB, voffB); PG8_STAGE(PG8_SA(0, 0), cA, voffA); PG8_STAGE(PG8_SB(0, 1), cB + hstep, voffB); PG8_STAGE(PG8_SA(0, 1), cA + hstep, voffA);
        if (wr == 1) PG8_BAR;
        PG8_WAIT_V(4); PG8_BAR;
        PG8_STAGE(PG8_SB(1, 0), cB + kstep, voffB); PG8_STAGE(PG8_SA(1, 0), cA + kstep, voffA); PG8_STAGE(PG8_SB(1, 1), cB + hstep + kstep, voffB);
        PG8_WAIT_V(6); PG8_BAR;
    }
    for (;;) {
        const bool has_next = S.next(ui + 1, nxt);
        const char* nA = has_next ? (const char*)g.A + (size_t)nxt.pm * hstep + (size_t)nxt.kt0 * kstep : cA; const char* nB = has_next ? (const char*)g.Bt + (size_t)nxt.pn * tstep + (size_t)nxt.kt0 * kstep : cB;
        const int nt = cur.nt;
        if (!cur.half) {
        for (int t = 0; t < nt; t += 2) {
            const bool last = (t == nt - 2);
            const char* a1 = cA + (size_t)(t + 1) * kstep;
            const char* a2 = last ? nA : cA + (size_t)(t + 2) * kstep; const char* b2 = last ? nB : cB + (size_t)(t + 2) * kstep;
            const char* a3 = a2 + kstep; const char* b3 = b2 + kstep;
            if (last && has_next) S.a_ready(nxt);
            if constexpr (SP2) {
            PG8_LDB(B0, 0, 0); PG8_LDB(B1, 0, 1); PG8_SCHED; PG8_LDA(At, 0, 0); PG8_STAGE(PG8_SA(1, 1), a1 + hstep, voffA);
            PG8_WAIT_V(8); PG8_WAIT_L(0); PG8_BAR; PG8_MMA(0, 0, At, B0); PG8_MMA(0, 1, At, B1); PG8_BAR; PG8_SCHED;
            PG8_LDA(At, 0, 1); PG8_STAGE(PG8_SB(0, 0), b2, voffB); PG8_STAGE(PG8_SB(0, 1), b2 + hstep, voffB); PG8_STAGE(PG8_SA(0, 0), a2, voffA);
            PG8_WAIT_V(8); PG8_WAIT_L(0); PG8_BAR; PG8_MMA(1, 0, At, B0); PG8_MMA(1, 1, At, B1); PG8_BAR; PG8_SCHED;
            PG8_LDB(B0, 1, 0); PG8_LDB(B1, 1, 1); PG8_SCHED; PG8_LDA(At, 1, 0); PG8_STAGE(PG8_SA(0, 1), a2 + hstep, voffA);
            PG8_WAIT_V(8); PG8_WAIT_L(0); PG8_BAR; PG8_MMA(0, 0, At, B0); PG8_MMA(0, 1, At, B1); PG8_BAR; PG8_SCHED;
            PG8_LDA(At, 1, 1); PG8_STAGE(PG8_SB(1, 0), b3, voffB); PG8_STAGE(PG8_SB(1, 1), b3 + hstep, voffB); PG8_STAGE(PG8_SA(1, 0), a3, voffA);
            PG8_WAIT_V(8); PG8_WAIT_L(0); PG8_BAR; PG8_MMA(1, 0, At, B0); PG8_MMA(1, 1, At, B1); PG8_BAR; PG8_SCHED;
            } else {
            PG8_LDB(B0, 0, 0); PG8_SCHED; PG8_LDA(At, 0, 0); PG8_STAGE(PG8_SA(1, 1), a1 + hstep, voffA);
            PG8_WAIT_L(8); PG8_BAR; PG8_WAIT_L(0); PG8_MMA(0, 0, At, B0); PG8_BAR; PG8_SCHED;
            PG8_LDB(B1, 0, 1); PG8_STAGE(PG8_SB(0, 0), b2, voffB);
            PG8_BAR; PG8_WAIT_L(0); PG8_MMA(0, 1, At, B1); PG8_BAR;
            PG8_LDA(At, 0, 1); PG8_STAGE(PG8_SA(0, 0), a2, voffA);
            PG8_BAR; PG8_WAIT_L(0); PG8_MMA(1, 0, At, B0); PG8_BAR; PG8_SCHED;
            PG8_STAGE(PG8_SB(0, 1), b2 + hstep, voffB);
            PG8_WAIT_V(6); PG8_BAR; PG8_MMA(1, 1, At, B1); PG8_BAR;
            PG8_LDB(B0, 1, 0); PG8_SCHED; PG8_LDA(At, 1, 0); PG8_STAGE(PG8_SA(0, 1), a2 + hstep, voffA);
            PG8_WAIT_L(8); PG8_BAR; PG8_WAIT_L(0); PG8_MMA(0, 0, At, B0); PG8_BAR; PG8_SCHED;
            PG8_LDB(B1, 1, 1); PG8_STAGE(PG8_SB(1, 0), b3, voffB);
            PG8_BAR; PG8_WAIT_L(0); PG8_MMA(0, 1, At, B1); PG8_BAR;
            PG8_LDA(At, 1, 1); PG8_STAGE(PG8_SA(1, 0), a3, voffA);
            PG8_BAR; PG8_WAIT_L(0); PG8_MMA(1, 0, At, B0); PG8_BAR; PG8_SCHED;
            PG8_STAGE(PG8_SB(1, 1), b3 + hstep, voffB);
            PG8_WAIT_V(6); PG8_BAR; PG8_MMA(1, 1, At, B1); PG8_BAR;
            }
        }
        if constexpr (ALIGN_EPI) { if (wr == 0) PG8_BAR; }
        E(acc, cur, wr, wc, fr, fq); S.done(cur);
        } else {
        for (int t = 0; t < nt; t += 2) {
            const bool last = (t == nt - 2);
            const char* a1 = cA + (size_t)(t + 1) * kstep;
            const char* a2 = last ? nA : cA + (size_t)(t + 2) * kstep; const char* b2 = last ? nB : cB + (size_t)(t + 2) * kstep;
            const char* a3 = a2 + kstep; const char* b3 = b2 + kstep;
            if (last && has_next) S.a_ready(nxt);
            if constexpr (SP2) {
            PG8_LDB(B0, 0, 0); PG8_LDB(B1, 0, 1); PG8_SCHED; PG8_LDA(At, 0, 0); PG8_STAGE(PG8_SA(1, 1), a1 + hstep, voffA);
            PG8_WAIT_V(8); PG8_WAIT_L(0); PG8_BAR; PG8_MMA(0, 0, At, B0); PG8_MMA(0, 1, At, B1); PG8_BAR; PG8_SCHED;
            PG8_STAGE(PG8_SB(0, 0), b2, voffB); PG8_STAGE(PG8_SB(0, 1), b2 + hstep, voffB); PG8_STAGE(PG8_SA(0, 0), a2, voffA);
            PG8_WAIT_V(8); PG8_WAIT_L(0); PG8_BAR; PG8_BAR; PG8_SCHED;
            PG8_LDB(B0, 1, 0); PG8_LDB(B1, 1, 1); PG8_SCHED; PG8_LDA(At, 1, 0); PG8_STAGE(PG8_SA(0, 1), a2 + hstep, voffA);
            PG8_WAIT_V(8); PG8_WAIT_L(0); PG8_BAR; PG8_MMA(0, 0, At, B0); PG8_MMA(0, 1, At, B1); PG8_BAR; PG8_SCHED;
            PG8_STAGE(PG8_SB(1, 0), b3, voffB); PG8_STAGE(PG8_SB(1, 1), b3 + hstep, voffB); PG8_STAGE(PG8_SA(1, 0), a3, voffA);
            PG8_WAIT_V(8); PG8_WAIT_L(0); PG8_BAR; PG8_BAR; PG8_SCHED;
            } else {
            PG8_LDB(B0, 0, 0); PG8_SCHED; PG8_LDA(At, 0, 0); PG8_STAGE(PG8_SA(1, 1), a1 + hstep, voffA);
            PG8_WAIT_L(8); PG8_BAR; PG8_WAIT_L(0); PG8_MMA(0, 0, At, B0); PG8_BAR; PG8_SCHED;
            PG8_LDB(B1, 0, 1); PG8_STAGE(PG8_SB(0, 0), b2, voffB);
            PG8_BAR; PG8_WAIT_L(0); PG8_MMA(0, 1, At, B1); PG8_BAR;
            PG8_STAGE(PG8_SA(0, 0), a2, voffA);
            PG8_BAR; PG8_WAIT_L(0); PG8_BAR; PG8_SCHED;
            PG8_STAGE(PG8_SB(0, 1), b2 + hstep, voffB);
            PG8_WAIT_V(6); PG8_BAR; PG8_BAR;
            PG8_LDB(B0, 1, 0); PG8_SCHED; PG8_LDA(At, 1, 0); PG8_STAGE(PG8_SA(0, 1), a2 + hstep, voffA);
            PG8_WAIT_L(8); PG8_BAR; PG8_WAIT_L(0); PG8_MMA(0, 0, At, B0); PG8_BAR; PG8_SCHED;
            PG8_LDB(B1, 1, 1); PG8_STAGE(PG8_SB(1, 0), b3, voffB);
            PG8_BAR; PG8_WAIT_L(0); PG8_MMA(0, 1, At, B1); PG8_BAR;
            PG8_STAGE(PG8_SA(1, 0), a3, voffA);
            PG8_BAR; PG8_WAIT_L(0); PG8_BAR; PG8_SCHED;
            PG8_STAGE(PG8_SB(1, 1), b3 + hstep, voffB);
            PG8_WAIT_V(6); PG8_BAR; PG8_BAR;
            }
        }
        if constexpr (ALIGN_EPI) { if (wr == 0) PG8_BAR; }
        { bool fin = true; if (cur.nsplit > 1) fin = S.split_combine(acc, cur, wid, lane); if (fin) E.half(acc, cur, wr, wc, fr, fq); S.done(cur); }
        }
        if (!has_next) break;
#pragma unroll
        for (int a = 0; a < 2; ++a)
#pragma unroll
            for (int b = 0; b < 2; ++b)
#pragma unroll
                for (int m = 0; m < 4; ++m)
#pragma unroll
                    for (int n = 0; n < 2; ++n) acc[a][b][m][n] = (f32x4){0.f, 0.f, 0.f, 0.f};
        cur = nxt; cA = nA; cB = nB; ++ui;
        if constexpr (ALIGN_EPI) { if (wr == 1) PG8_BAR; }
    }
    PG8_WAIT_V(0);
    if constexpr (!ALIGN_EPI) { if (wr == 0) PG8_BAR; }
    PG8_BAR;
    if constexpr (Epi::AFTER_DRAIN) { E.fused(acc, cur, wr, wc, fr, fq, lds, wid, lane); S.done(cur); }
#undef PG8_SA
#undef PG8_SB
#undef PG8_STAGE
#undef PG8_LDA
#undef PG8_LDB
#undef PG8_MMA
#undef PG8_WAIT_V
#undef PG8_WAIT_L
#undef PG8_BAR
#undef PG8_SCHED
}
}

#ifndef PG8_SP2
#define PG8_SP2 true
#endif
#ifndef PG8_ALIGN
#define PG8_ALIGN true
#endif
#ifndef MK_PER_PHASE
#define MK_PER_PHASE 0
#endif

#ifndef EN_P0
#define EN_P0 1
#endif
#ifndef EN_RG0
#define EN_RG0 1
#endif
#ifndef EN_RG1
#define EN_RG1 1
#endif
#ifndef EN_ATT
#define EN_ATT 1
#endif
#ifndef EN_GU
#define EN_GU 1
#endif
#ifndef EN_DN
#define EN_DN 1
#endif
#ifndef EN_WIN
#define EN_WIN 1
#endif
#ifndef EN_KV
#define EN_KV 1
#endif
#ifndef EN_Q
#define EN_Q 1
#endif
#ifndef EN_RES
#define EN_RES 1
#endif
constexpr int NWAVES = 8;
constexpr int DM = 2048, DFF = 5632, NHEAD = 16;
constexpr int MROWS = 16896;
constexpr int ROW_P0 = 16, ROW_S0 = 16400, ROWS_REAL = 16656;
constexpr int KS_ROWS = 2112;
constexpr float LAM_INIT = 0.3555090675909693f;
constexpr float LOG2E = 1.4426950408889634f;
constexpr int NPHASE = 17;
constexpr size_t O_YP = 0, O_YS = 33554432, O_KP = 34078720, O_VP = 67665920, O_CP = 101253120, O_HP = 101259264, O_KS = 101261312, O_VS = 101785600, O_CS = 102309888, O_HS = 102408192, O_END = 102440960;

constexpr size_t MiB = 1u << 20;
constexpr size_t WS_CTL = 0, CTL_ZERO_BYTES = 1 * MiB;
constexpr size_t WS_GW = 1 * MiB;
constexpr size_t WS_WGU = 2 * MiB;
constexpr size_t WS_WDN = 178 * MiB;
constexpr size_t WS_WIN = 266 * MiB, WS_WOUT = 282 * MiB, WS_WKV = 290 * MiB, WS_WQ = 306 * MiB, WS_WO = 314 * MiB;
constexpr size_t WS_X16 = 322 * MiB;
constexpr size_t WS_BIG = 388 * MiB;
constexpr size_t WS_ACT = 586 * MiB;
constexpr size_t WS_KP = 652 * MiB, WS_VP = 717 * MiB;
constexpr size_t WS_KS = 782 * MiB, WS_VS = 914 * MiB;
constexpr size_t WS_TS = 1046 * MiB;
constexpr size_t WS_SLAB = 1048 * MiB;
constexpr size_t WS_AB = 1112 * MiB;
constexpr size_t WS_END = 1244 * MiB;
constexpr int CW_TMO = 0, CW_ATTQ = 64, CW_SCONV = 256, CW_BAR = 4096;
constexpr size_t CTL_SSQ = 65536;
constexpr size_t CTL_SCNT = 524288;
static_assert(CTL_SSQ + 6 * (size_t)MROWS * 4 <= CTL_SCNT && CTL_SCNT + 17 * 128 * 8 * 4 <= CTL_ZERO_BYTES, "ctl");

constexpr int RING_OFF = 0, RING_BYTES = 131072;
constexpr int LDSCTL_OFF = RING_BYTES, MISC_OFF = LDSCTL_OFF + 320;
constexpr int LDS_BYTES = 147456;

#define GAS __attribute__((address_space(1)))
#define LAS __attribute__((address_space(3)))
typedef unsigned short bf16;
typedef unsigned v4u __attribute__((ext_vector_type(4)));
typedef unsigned v2u __attribute__((ext_vector_type(2)));
typedef float f32x4 __attribute__((ext_vector_type(4)));
typedef float f32x2 __attribute__((ext_vector_type(2)));
typedef float f32x16 __attribute__((ext_vector_type(16)));
typedef short bf16x8 __attribute__((ext_vector_type(8)));
typedef short s16x4 __attribute__((ext_vector_type(4)));
typedef GAS unsigned gu32;
#define RLX_AGENT __ATOMIC_RELAXED, __HIP_MEMORY_SCOPE_AGENT
#define LDS_WAIT() asm volatile("s_waitcnt lgkmcnt(0)" ::: "memory")
#define VM_WAIT() asm volatile("s_waitcnt vmcnt(0)" ::: "memory")
__device__ __forceinline__ unsigned pk2(float lo, float hi) { typedef __bf16 bf16x2_t __attribute__((ext_vector_type(2))); f32x2 v = {lo, hi}; bf16x2_t b = __builtin_convertvector(v, bf16x2_t); return __builtin_bit_cast(unsigned, b); }
__device__ __forceinline__ unsigned f2bf(float f) { return pk2(f, 0.f) & 0xffffu; }
__device__ __forceinline__ float bf2f(bf16 b) { return __builtin_bit_cast(float, ((unsigned)b) << 16); }
__device__ __forceinline__ float wave_sum(float v) {
#pragma unroll
    for (int o = 1; o < 64; o <<= 1) v += __shfl_xor(v, o);
    return v;
}

#define XB_TMO      128
#define XB_XCNT(j)  (256  + 64 * (j))
#define XB_XSUB(j)  (1280 + 64 * (j))
#define XB_XGEN(j)  (2304 + 64 * (j))
#define XB_TOP      3328
#define XB_TOPGEN   3392
#define XCD_BAR_WORDS 3456
#define XB_SPIN_CAP (1u << 18)

__device__ __forceinline__ unsigned xb_ld(unsigned* p)              { return __hip_atomic_load(p, __ATOMIC_RELAXED, __HIP_MEMORY_SCOPE_AGENT); }
__device__ __forceinline__ unsigned xb_add(unsigned* p, unsigned v) { return __hip_atomic_fetch_add(p, v, __ATOMIC_RELAXED, __HIP_MEMORY_SCOPE_AGENT); }
__device__ __forceinline__ unsigned xb_xcc_id() { return (unsigned)__builtin_amdgcn_s_getreg((3 << 11) | 20) & 0xFu; }
#define XB_SPIN(cond, bar) do { unsigned _sp = 0; while (cond) { __builtin_amdgcn_s_sleep(1); \
    if ((++_sp & 255u) == 0u) { if (xb_ld(&(bar)[XB_TMO])) break; if (_sp > XB_SPIN_CAP) { atomicAdd(&(bar)[XB_TMO], 1u); break; } } } } while (0)

struct XcdBarrier {
    unsigned* bar; unsigned x;
    volatile LAS unsigned* st;
};

__device__ __forceinline__ XcdBarrier xcd_barrier_post(unsigned* bar, volatile LAS unsigned* st) {
    XcdBarrier b; b.bar = bar; b.x = xb_xcc_id(); b.st = st;
    if (threadIdx.x == 0) (void)xb_add(&bar[XB_XCNT(b.x)], 1u);
    return b;
}
__device__ __forceinline__ void xcd_barrier_complete(unsigned* bar, unsigned x, unsigned& nloc, unsigned& nx) {
    const unsigned G = gridDim.x * gridDim.y * gridDim.z;
    unsigned sum, cnt, mine, sp = 0u;
    for (;;) {
        sum = 0u; cnt = 0u; mine = 0u;
#pragma unroll
        for (unsigned j = 0; j < 16; ++j) { const unsigned c = xb_ld(&bar[XB_XCNT(j)]); sum += c; cnt += (c > 0u) ? 1u : 0u; mine = (j == x) ? c : mine; }
        if (sum == G) break;
        __builtin_amdgcn_s_sleep(1);
        if ((++sp & 255u) == 0u) { if (xb_ld(&bar[XB_TMO])) break; if (sp > XB_SPIN_CAP) { atomicAdd(&bar[XB_TMO], 1u); break; } }
    }
    nloc = mine > 0u ? mine : 1u; nx = cnt > 0u ? cnt : 1u;
}

__device__ __forceinline__ void xcd_barrier(const XcdBarrier& b) {
    asm volatile("s_waitcnt vmcnt(0)" ::: "memory");
    __syncthreads();
    if (threadIdx.x == 0) {
        unsigned* bar = b.bar;
        __builtin_amdgcn_s_waitcnt(0);
        unsigned nloc = b.st[0], nx = b.st[1];
        if (nloc == 0u) { xcd_barrier_complete(bar, b.x, nloc, nx); b.st[0] = nloc; b.st[1] = nx; }
        const unsigned old = xb_add(&bar[XB_XSUB(b.x)], 1u);
        const unsigned gen = old / nloc;
        if (old + 1u == (gen + 1u) * nloc) {
            __builtin_amdgcn_fence(__ATOMIC_RELEASE, "agent");
            asm volatile("s_waitcnt vmcnt(0)" ::: "memory");
            const unsigned og = xb_add(&bar[XB_TOP], 1u);
            const unsigned tg = og / nx;
            if (og + 1u == (tg + 1u) * nx) xb_add(&bar[XB_TOPGEN], 1u);
            else XB_SPIN(xb_ld(&bar[XB_TOPGEN]) == tg, bar);
            __builtin_amdgcn_fence(__ATOMIC_ACQUIRE, "agent");
            xb_add(&bar[XB_XGEN(b.x)], 1u);
            asm volatile("s_waitcnt vmcnt(0)" ::: "memory");
        } else {
            XB_SPIN(xb_ld(&bar[XB_XGEN(b.x)]) == gen, bar);
            __builtin_amdgcn_fence(__ATOMIC_ACQUIRE, "agent");
            asm volatile("s_waitcnt vmcnt(0)" ::: "memory");
        }
    }
    __syncthreads();
}

struct Args { const float* in[28]; float* out; unsigned char* ws; int ph_lo, ph_hi; };
typedef const __attribute__((address_space(4))) Args CArgs;
__device__ __forceinline__ CArgs* largs() { CArgs* p = (CArgs*)__builtin_amdgcn_kernarg_segment_ptr(); asm volatile("" : "+s"(p)); return p; }
__device__ __forceinline__ int lbid() { int b = (int)blockIdx.x; asm volatile("" : "+s"(b)); return b; }
struct Frame {
    LAS unsigned char* lds;
    volatile LAS unsigned* MISC;
    int tid, lane, wave, G;
};
#define P_IN(i) (args.in[i])
#define P_WS(T, off) ((T*)(args.ws + (off)))
#define P_GW P_WS(bf16, WS_GW)
#define P_WGU P_WS(bf16, WS_WGU)
#define P_WDN P_WS(bf16, WS_WDN)
#define P_WIN P_WS(bf16, WS_WIN)
#define P_WOUT P_WS(bf16, WS_WOUT)
#define P_WKV P_WS(bf16, WS_WKV)
#define P_WQ P_WS(bf16, WS_WQ)
#define P_WO P_WS(bf16, WS_WO)
#define P_X16 P_WS(bf16, WS_X16)
#define P_HID P_WS(bf16, WS_BIG)
#define P_GG P_WS(bf16, WS_BIG)
#define P_XB P_WS(float, WS_BIG + 66 * MiB)
#define P_A3 P_WS(bf16, WS_BIG)
#define P_ACT P_WS(bf16, WS_ACT)
#define P_KP P_WS(bf16, WS_KP)
#define P_VP P_WS(bf16, WS_VP)
#define P_KS P_WS(bf16, WS_KS)
#define P_VS P_WS(bf16, WS_VS)
#define P_TS P_WS(float, WS_TS)
#define P_SSQ P_WS(float, CTL_SSQ)
#define P_CTL ((gu32*)(args.ws + WS_CTL))
#define P_SLAB P_WS(float, WS_SLAB)
#define P_SCNT ((unsigned*)(args.ws + CTL_SCNT))
#define P_OUT (args.out)
enum { I_XP = 0, I_XS, I_CK, I_CV, I_SCONV, I_SH, I_META, I_FNORM, I_WG, I_WU, I_WD, I_RGNORM, I_RGWIN, I_CONVW, I_CONVB, I_GATEW, I_GATEB, I_LAMBDA, I_RGWOUT, I_KVNORM, I_WKV, I_KNORM, I_ATTNNORM, I_WQ, I_QNORM, I_DLAM, I_SUBNORM, I_WOP };

__device__ __forceinline__ void cvt_item(const float* W, int ldw, int n0, int k0, const float* gain, bf16* dst, int K, LAS float* scr, int lane) {
    float wv[32];
#pragma unroll
    for (int i = 0; i < 32; ++i) wv[i] = W[(size_t)(k0 + 2 * i + (lane >> 5)) * ldw + n0 + (lane & 31)];
#pragma unroll
    for (int i = 0; i < 32; ++i) { const int kk = 2 * i + (lane >> 5); const float g = gain ? gain[k0 + kk] : 1.f; scr[kk * 33 + (lane & 31)] = wv[i] * g; }
    LDS_WAIT(); asm volatile("" ::: "memory");
    const int c = lane & 7;
#pragma unroll
    for (int j = 0; j < 4; ++j) { const int n = (lane >> 3) + 8 * j; const LAS float* s = scr + (8 * c) * 33 + n;
        v4u o; o.x = pk2(s[0 * 33], s[1 * 33]); o.y = pk2(s[2 * 33], s[3 * 33]); o.z = pk2(s[4 * 33], s[5 * 33]); o.w = pk2(s[6 * 33], s[7 * 33]);
        *(GAS v4u*)(dst + (size_t)n * K + 8 * c) = o; }
    LDS_WAIT(); asm volatile("" ::: "memory");
}
__device__ __forceinline__ int p64col(int beta) { return 256 * (beta >> 3) + 64 * (beta & 3) + 32 * ((beta >> 2) & 1); }
__device__ __forceinline__ void p0_prologue(const Frame& F, CArgs& args) {
    int tid_l = threadIdx.x; asm volatile("" : "+v"(tid_l));
    const int lane = tid_l & 63, wave = __builtin_amdgcn_readfirstlane(tid_l >> 6);
    LAS float* scr = (LAS float*)(F.lds + RING_OFF + wave * 16384);
    const int gw = lbid() * NWAVES + wave, NGW = F.G * NWAVES;
    constexpr int IT_GU = 32 * 352, IT_DN = 88 * 64, IT_44 = 32 * 128, IT_22 = 32 * 64, IT_GW = 32 * 8;
    constexpr int NIT = 4 * IT_GU + 4 * IT_DN + 2 * IT_44 + 3 * IT_22 + IT_GW;
    for (int it = gw; it < NIT; it += NGW) {
        int r = it;
        if (r < 4 * IT_GU) { const int f = r / IT_GU; r -= f * IT_GU; const int kb = r / 352, beta = r % 352, pn = beta >> 3, bj = (beta >> 2) & 1, jb = beta & 3;
            const float* src = (bj ? P_IN(I_WU) : P_IN(I_WG)) + (size_t)f * DM * DFF;
            cvt_item(src, DFF, 128 * pn + 32 * jb, 64 * kb, P_IN(I_FNORM) + f * DM, P_WGU + (size_t)f * 11264 * DM + (size_t)(32 * beta) * DM + 64 * kb, DM, scr, lane); continue; }
        r -= 4 * IT_GU;
        if (r < 4 * IT_DN) { const int f = r / IT_DN; r -= f * IT_DN; const int kb = r / 64, beta = r % 64;
            cvt_item(P_IN(I_WD) + (size_t)f * DFF * DM, DM, p64col(beta), 64 * kb, nullptr, P_WDN + (size_t)f * DM * DFF + (size_t)(32 * beta) * DFF + 64 * kb, DFF, scr, lane); continue; }
        r -= 4 * IT_DN;
        if (r < IT_44) { const int kb = r / 128, beta = r % 128; cvt_item(P_IN(I_RGWIN), 4096, p64col(beta), 64 * kb, P_IN(I_RGNORM), P_WIN + (size_t)(32 * beta) * DM + 64 * kb, DM, scr, lane); continue; }
        r -= IT_44;
        if (r < IT_44) { const int kb = r / 128, beta = r % 128; cvt_item(P_IN(I_WKV), 4096, p64col(beta), 64 * kb, P_IN(I_KVNORM), P_WKV + (size_t)(32 * beta) * DM + 64 * kb, DM, scr, lane); continue; }
        r -= IT_44;
        if (r < IT_22) { const int kb = r / 64, beta = r % 64; cvt_item(P_IN(I_RGWOUT), DM, p64col(beta), 64 * kb, nullptr, P_WOUT + (size_t)(32 * beta) * DM + 64 * kb, DM, scr, lane); continue; }
        r -= IT_22;
        if (r < IT_22) { const int kb = r / 64, beta = r % 64; cvt_item(P_IN(I_WQ), DM, p64col(beta), 64 * kb, P_IN(I_ATTNNORM), P_WQ + (size_t)(32 * beta) * DM + 64 * kb, DM, scr, lane); continue; }
        r -= IT_22;
        if (r < IT_22) { const int kb = r / 64, beta = r % 64; cvt_item(P_IN(I_WOP), DM, p64col(beta), 64 * kb, nullptr, P_WO + (size_t)(32 * beta) * DM + 64 * kb, DM, scr, lane); continue; }
        r -= IT_22;
        { const int mat = r >> 3, i8 = r & 7; cvt_item(P_IN(I_GATEW) + (size_t)mat * 16384, 128, 32 * (i8 & 3), 64 * (i8 >> 2), nullptr, P_GW + (size_t)mat * 16384 + (size_t)(32 * (i8 & 3)) * 128 + 64 * (i8 >> 2), 128, scr, lane); }
    }
    for (int m = gw; m < MROWS; m += NGW) {
        const float* src = m < ROW_P0 ? P_IN(I_META) + (size_t)m * DM : m < ROW_S0 ? P_IN(I_XP) + (size_t)(m - ROW_P0) * DM : m < ROWS_REAL ? P_IN(I_XS) + (size_t)(m - ROW_S0) * DM : nullptr;
        float s = 0.f;
#pragma unroll
        for (int j = 0; j < 4; ++j) {
            f32x4 a = (f32x4){0.f, 0.f, 0.f, 0.f}, b = a;
            if (src) { a = *(const GAS f32x4*)(src + 512 * j + 8 * lane); b = *(const GAS f32x4*)(src + 512 * j + 8 * lane + 4); }
            s += (a[0] * a[0] + a[1] * a[1]) + (a[2] * a[2] + a[3] * a[3]) + (b[0] * b[0] + b[1] * b[1]) + (b[2] * b[2] + b[3] * b[3]);
            v4u o; o.x = pk2(a[0], a[1]); o.y = pk2(a[2], a[3]); o.z = pk2(b[0], b[1]); o.w = pk2(b[2], b[3]);
            *(GAS v4u*)(P_X16 + (size_t)m * DM + 512 * j + 8 * lane) = o;
        }
        s = wave_sum(s);
        if (lane == 0) P_SSQ[m] = s;
    }
}

constexpr int RG_XC = 0, RG_G = 17408, RG_SQ = RG_G + 2 * 64 * 528, RG_XCS = 272, RG_GS = 528;
template <int MODE> __device__ __forceinline__ void rg_phase(const Frame& F, CArgs& args) {
    LAS unsigned char* L = F.lds + RING_OFF;
    int tid_l = threadIdx.x; asm volatile("" : "+v"(tid_l));
    const int tid = tid_l, lane = tid & 63, wave = __builtin_amdgcn_readfirstlane(tid >> 6);
    const int c = tid & 127, q = tid >> 7, fr = lane & 15, fq = lane >> 4, k2 = wave >> 2, dq = wave & 3;
    const float* XB = P_XB;
    unsigned* AB = (unsigned*)(args.ws + WS_AB);
    for (int uidx = lbid(); uidx < 81 * 16; uidx += F.G) {
        int tl, n;
        if (uidx < 1024) { tl = 1 + (uidx >> 4); n = uidx & 15; } else { const int v = uidx - 1024; n = v & 15; const int t2 = v >> 4; tl = t2 == 0 ? 0 : 64 + t2; }
        const bool smp = tl >= 65; const int b = tl - 65;
        const bool full = !smp && tl != 0;
        const int row0 = smp ? ROW_S0 + 16 * b : (tl == 0 ? 0 : 16 + 256 * (tl - 1));
        const int nsub = full ? 4 : 1, nmb = full ? 4 : 1, nq = full ? 4 : 1;
        const int ch = n * 128 + c;
        const bool act = q < nq;
        if (MODE == 0) {
            const float cw0 = P_IN(I_CONVW)[ch], cw1 = P_IN(I_CONVW)[2048 + ch], cw2 = P_IN(I_CONVW)[4096 + ch], cw3 = P_IN(I_CONVW)[6144 + ch], cb = P_IN(I_CONVB)[ch];
            const float lam = P_IN(I_LAMBDA)[ch];
            const float ls8 = -8.0f * LOG2E * log1pf(__expf(-lam));
            bf16x8 Bw[2][4]; f32x4 gb[2];
            { const bf16* gwp = P_GW + ((size_t)(k2 * 16 + n) * 128 + 32 * dq + fr) * 128 + 8 * fq;
#pragma unroll
              for (int nb = 0; nb < 2; ++nb) {
#pragma unroll
                  for (int ks = 0; ks < 4; ++ks) Bw[nb][ks] = *(const GAS bf16x8*)(gwp + (size_t)(16 * nb) * 128 + 32 * ks);
                  gb[nb] = *(const GAS f32x4*)(P_IN(I_GATEB) + k2 * 2048 + n * 128 + 32 * dq + 16 * nb + 4 * fq); } }
            float At = 1.f, Bt = 0.f;
            float vn[19];
#define RG_LOADV(dst, ss) do { _Pragma("unroll") for (int j = 0; j < 19; ++j) { const int T = 64 * (ss) + 16 * q - 3 + j; float x = 0.f; \
                if (act) { if (smp) x = T >= 0 ? XB[(size_t)(row0 + T) * DM + ch] : P_IN(I_SCONV)[((size_t)b * 3 + 3 + T) * DM + ch]; \
                           else { const int g = row0 + T; x = g >= 0 ? XB[(size_t)g * DM + ch] : 0.f; } } \
                dst[j] = x; } } while (0)
            RG_LOADV(vn, 0);
            for (int s = 0; s < nsub; ++s) {
                float xc[16], v[19];
                const int T0 = 64 * s + 16 * q;
#pragma unroll
                for (int j = 0; j < 19; ++j) v[j] = vn[j];
                if (s + 1 < nsub) RG_LOADV(vn, s + 1);
#pragma unroll
                for (int i = 0; i < 16; ++i) { xc[i] = cb + cw0 * v[i] + cw1 * v[i + 1] + cw2 * v[i + 2] + cw3 * v[i + 3];
                    if (act) *(LAS bf16*)(L + RG_XC + (16 * q + i) * RG_XCS + 2 * c) = (bf16)f2bf(xc[i]); }
                __syncthreads();
#pragma unroll
                for (int m = 0; m < 4; ++m) {
                    if (m < nmb) {
                        f32x4 acc0 = (f32x4){0.f, 0.f, 0.f, 0.f}, acc1 = acc0;
#pragma unroll
                        for (int ks = 0; ks < 4; ++ks) { const bf16x8 a = *(const LAS bf16x8*)(L + RG_XC + (16 * m + fr) * RG_XCS + 64 * ks + 16 * fq);
                            acc0 = __builtin_amdgcn_mfma_f32_16x16x32_bf16(Bw[0][ks], a, acc0, 0, 0, 0); acc1 = __builtin_amdgcn_mfma_f32_16x16x32_bf16(Bw[1][ks], a, acc1, 0, 0, 0); }
                        f32x4 g0, g1;
#pragma unroll
                        for (int e = 0; e < 4; ++e) { g0[e] = pg8::fast_sigmoid(acc0[e] + gb[0][e]); g1[e] = pg8::fast_sigmoid(acc1[e] + gb[1][e]); }
                        LAS unsigned char* gp = L + RG_G + k2 * (64 * RG_GS) + (16 * m + fr) * RG_GS + (32 * dq + 4 * fq) * 4;
                        *(LAS f32x4*)gp = g0; *(LAS f32x4*)(gp + 64) = g1;
                    }
                }
                __syncthreads();
                float A = 1.f, B = 0.f;
#pragma unroll
                for (int i = 0; i < 16; ++i) {
                    if (act) { const float r = *(const LAS float*)(L + RG_G + (16 * q + i) * RG_GS + 4 * c), ig = *(const LAS float*)(L + RG_G + 64 * RG_GS + (16 * q + i) * RG_GS + 4 * c);
                        const float a = __builtin_amdgcn_exp2f(r * ls8), bb = __builtin_sqrtf(fmaxf(1.f - a * a, 0.f)) * (ig * xc[i]);
                        const unsigned w = pk2(1.f - a, bb);
                        const int T = T0 + i; const size_t row = (size_t)(row0 + T);
                        AB[row * DM + ch] = w;
                        const float ar = 1.f - __uint_as_float(w << 16), br = __uint_as_float(w & 0xffff0000u);
                        A *= ar; B = ar * B + br;
                        if (smp) { if (T >= 13) P_OUT[O_CS + ((size_t)b * 3 + (T - 13)) * DM + ch] = v[i + 3]; }
                        else { if (row >= 16397) P_OUT[O_CP + (row - 16397) * DM + ch] = v[i + 3]; }
                    }
                }
                *(LAS f32x2*)(L + RG_SQ + (q * 128 + c) * 8) = (f32x2){A, B};
                __syncthreads();
                float As = 1.f, Bs = 0.f;
#pragma unroll
                for (int qq = 0; qq < 4; ++qq) { const f32x2 sq = *(const LAS f32x2*)(L + RG_SQ + (qq * 128 + c) * 8); Bs = sq.x * Bs + sq.y; As *= sq.x; }
                Bt = As * Bt + Bs; At = As * At;
            }
            if (q == 0 && !smp) *(GAS f32x2*)(P_TS + ((size_t)tl * 2048 + ch) * 2) = (f32x2){At, Bt};
#undef RG_LOADV
        } else {
            float hc = 0.f;
            if (smp) hc = P_IN(I_SH)[b * 2048 + ch];
            else {
                float As = 1.f, Bs = 0.f;
#pragma unroll
                for (int hb = 0; hb < 2; ++hb) { f32x2 ab[8];
#pragma unroll
                    for (int k = 0; k < 8; ++k) { const int i = 16 * q + 8 * hb + k; ab[k] = i < tl ? *(const GAS f32x2*)(P_TS + ((size_t)i * 2048 + ch) * 2) : (f32x2){1.f, 0.f}; }
#pragma unroll
                    for (int k = 0; k < 8; ++k) { Bs = ab[k].x * Bs + ab[k].y; As *= ab[k].x; } }
                *(LAS f32x2*)(L + RG_SQ + (q * 128 + c) * 8) = (f32x2){As, Bs};
                __syncthreads();
#pragma unroll
                for (int qq = 0; qq < 4; ++qq) { const f32x2 sg = *(const LAS f32x2*)(L + RG_SQ + (qq * 128 + c) * 8); hc = sg.x * hc + sg.y; }
                __syncthreads();
            }
            unsigned wn[16]; unsigned short gn[16];
#define RG_LOADAB(ss) do { _Pragma("unroll") for (int i = 0; i < 16; ++i) { const size_t row = (size_t)(row0 + 64 * (ss) + 16 * q + i); wn[i] = act ? AB[row * DM + ch] : 0u; gn[i] = act ? P_GG[row * DM + ch] : (unsigned short)0; } } while (0)
            RG_LOADAB(0);
            for (int s = 0; s < nsub; ++s) {
                unsigned w[16]; unsigned short gg[16];
#pragma unroll
                for (int i = 0; i < 16; ++i) { w[i] = wn[i]; gg[i] = gn[i]; }
                if (s + 1 < nsub) RG_LOADAB(s + 1);
                const int T0 = 64 * s + 16 * q;
                float A = 1.f, B = 0.f;
#pragma unroll
                for (int i = 0; i < 16; ++i) { const float ar = 1.f - __uint_as_float(w[i] << 16), br = __uint_as_float(w[i] & 0xffff0000u); A *= ar; B = ar * B + br; }
                *(LAS f32x2*)(L + RG_SQ + (q * 128 + c) * 8) = (f32x2){A, B};
                __syncthreads();
                float h = hc, hn = hc;
#pragma unroll
                for (int qq = 0; qq < 4; ++qq) { const f32x2 sq = *(const LAS f32x2*)(L + RG_SQ + (qq * 128 + c) * 8); if (qq < q) h = sq.x * h + sq.y; hn = sq.x * hn + sq.y; }
                hc = hn;
                __syncthreads();
                if (act) {
#pragma unroll
                    for (int i = 0; i < 16; ++i) {
                        const float ar = 1.f - __uint_as_float(w[i] << 16), br = __uint_as_float(w[i] & 0xffff0000u);
                        h = ar * h + br;
                        const int T = T0 + i; const size_t row = (size_t)(row0 + T);
                        P_ACT[row * DM + ch] = (bf16)f2bf(bf2f(gg[i]) * h);
                        if (smp) { if (T == 15) P_OUT[O_HS + (size_t)b * DM + ch] = h; }
                        else { if (row == 16399) P_OUT[O_HP + ch] = h; }
                    }
                }
            }
#undef RG_LOADAB
        }
    }
}

namespace att {
typedef __attribute__((address_space(3))) const char* lcp;
constexpr int KSLOT = 16384, VRING = 65536, STG_OFF = 65536, STG_ROW = 272;
__device__ __forceinline__ int crow(int r, int hi) { return (r & 3) + 8 * (r >> 2) + 4 * hi; }
__device__ __forceinline__ void glds16(const void* gsrc, unsigned lds_dst) { unsigned keep;
    asm volatile("s_mov_b32 %0, m0\n\ts_mov_b32 m0, %2\n\ts_nop 0\n\tglobal_load_lds_dwordx4 %1, off\n\ts_mov_b32 m0, %0" : "=&s"(keep) : "v"(gsrc), "s"(lds_dst) : "memory"); }
__device__ __forceinline__ s16x4 vtr(lcp p) { typedef short v4i16_t __attribute__((ext_vector_type(4))); return __builtin_bit_cast(s16x4, __builtin_amdgcn_ds_read_tr16_b64_v4i16((__attribute__((address_space(3))) v4i16_t*)p)); }
__device__ __forceinline__ unsigned cvtpk(float lo, float hi) { typedef __bf16 bf16x2_t __attribute__((ext_vector_type(2))); f32x2 v = {lo, hi}; bf16x2_t b = __builtin_convertvector(v, bf16x2_t); return __builtin_bit_cast(unsigned, b); }
#define ATT_WAIT_BAR(N) asm volatile("s_waitcnt vmcnt(" #N ") lgkmcnt(0)\n\ts_barrier" ::: "memory")
struct UnitDesc { const bf16* Kb; const bf16* Vb; int qrow0, kb0, NT, NTF, h, sample, nvalid, dyn; float mref; };

template <int THR> __device__ __forceinline__ void attn_unit_s(LAS unsigned char* lds, const bf16* Q, bf16* O, const UnitDesc U, const float slope2, const float lam, const float* subg) {
    int tid_l = threadIdx.x; asm volatile("" : "+v"(tid_l));
    const int tid = tid_l, lane = tid & 63, r32 = lane & 31, hi = lane >> 5; const int wid = __builtin_amdgcn_readfirstlane(tid >> 6), rg = wid & 3, cc = wid >> 2;
    const unsigned lds0 = (unsigned)(uintptr_t)lds;
    const lcp L3 = (lcp)lds;
    const int qrow = U.qrow0 + (U.sample ? 0 : 32 * rg) + r32;
    const int qpos = U.sample ? 2064 + r32 : qrow;
    const int t_first = U.sample ? 0 : 1 - (rg >> 1);
    const bool wactive = U.sample ? (rg == 0) : true;
    const int NT = U.NT;
    const int kkey0 = 8 * wid + (lane >> 4);
    const bf16* ksrc = U.Kb + (size_t)kkey0 * DM + U.h * 128 + (((lane & 15) ^ (kkey0 & 15)) * 8);
    const bf16* ksrc2 = U.Kb + (size_t)(kkey0 + 4) * DM + U.h * 128 + (((lane & 15) ^ ((kkey0 + 4) & 15)) * 8);
    const bf16* vsrc = U.Vb + (size_t)(32 * (wid & 1) + (lane >> 2)) * DM + U.h * 128 + (wid >> 1) * 32 + (lane & 3) * 8;
    const unsigned kdst = lds0 + 2048u * (unsigned)wid, vdst = lds0 + VRING + 2048u * (unsigned)wid;
#define ATT_DMA_K(t) do { int kb_ = U.kb0 - 64 * (t); kb_ = kb_ < 0 ? 0 : kb_; const size_t ro_ = (size_t)kb_ * DM; const unsigned so_ = (unsigned)(((t) & 3) * KSLOT); \
        glds16(ksrc + ro_, (unsigned)__builtin_amdgcn_readfirstlane(kdst + so_)); glds16(ksrc2 + ro_, (unsigned)__builtin_amdgcn_readfirstlane(kdst + so_ + 1024u)); } while (0)
#define ATT_DMA_V(t) do { int kb_ = U.kb0 - 64 * (t); kb_ = kb_ < 0 ? 0 : kb_; const size_t ro_ = (size_t)kb_ * DM; const unsigned so_ = (unsigned)(((t) & 3) * KSLOT); \
        glds16(vsrc + ro_, (unsigned)__builtin_amdgcn_readfirstlane(vdst + so_)); glds16(vsrc + ro_ + 16 * DM, (unsigned)__builtin_amdgcn_readfirstlane(vdst + so_ + 1024u)); } while (0)
    bf16x8 qf[4];
    { const bf16* qp = Q + (size_t)qrow * DM + U.h * 128 + cc * 64 + hi * 8;
#pragma unroll
      for (int d0 = 0; d0 < 4; ++d0) qf[d0] = *(const GAS bf16x8*)(qp + d0 * 16); }
    asm volatile("s_waitcnt vmcnt(0)" ::: "memory");
    ATT_DMA_K(0); ATT_DMA_V(0);
    if (NT > 1) { ATT_DMA_K(1); ATT_DMA_V(1); }
    if (NT > 2) ATT_DMA_K(2);
    const bool dyn = U.dyn != 0;
    float m = dyn ? 0.f : U.mref, l = 0.f; bool first = dyn;
    f32x16 o[4];
#pragma unroll
    for (int d = 0; d < 4; ++d)
#pragma unroll
        for (int r = 0; r < 16; ++r) o[d][r] = 0.f;
    f32x16 pA0, pA1; v4u pw[4];
#define ATT_QK(tt, P0, P1) do { int kb = U.kb0 - 64 * (tt); kb = kb < 0 ? 0 : kb; \
        const bool gen = ((tt) == t_first) || (!U.sample && (tt) == U.NTF - 1); \
        if (gen) { const int vhi = (!U.sample && (tt) == U.NTF - 1) ? 16 : (U.sample ? 2080 : (1 << 30)); \
            _Pragma("unroll") for (int r = 0; r < 16; ++r) { const int kp = kb + crow(r, hi); \
                P0[r] = kp < vhi ? -slope2 * __builtin_fabsf((float)(qpos - kp)) - m : -INFINITY; \
                P1[r] = kp + 32 < vhi ? -slope2 * __builtin_fabsf((float)(qpos - kp - 32)) - m : -INFINITY; } \
        } else { const float tb = slope2 * (float)(kb + 4 * hi - qpos) - m; \
            const float s8_ = 8.0f * slope2, s32_ = 32.0f * slope2; \
            _Pragma("unroll") for (int r = 0; r < 16; ++r) { P0[r] = (r == 0) ? tb : ((r & 3) == 0 ? P0[r - 4] + s8_ : P0[r - 1] + slope2); P1[r] = P0[r] + s32_; } } \
        const lcp kp_ = L3 + (unsigned)(((tt) & 3) * KSLOT) + r32 * 256; \
        _Pragma("unroll") for (int d0 = 0; d0 < 4; ++d0) { const int po_ = ((8 * cc + 2 * d0 + hi) ^ (r32 & 15)) * 16; const bf16x8 a0 = *(const LAS bf16x8*)(kp_ + po_), a1 = *(const LAS bf16x8*)(kp_ + po_ + 32 * 256); \
            P0 = __builtin_amdgcn_mfma_f32_32x32x16_bf16(a0, qf[d0], P0, 0, 0, 0); P1 = __builtin_amdgcn_mfma_f32_32x32x16_bf16(a1, qf[d0], P1, 0, 0, 0); } } while (0)
#define ATT_PV(tt) do { const lcp vp = L3 + VRING + (unsigned)(((tt) & 3) * KSLOT) + (4 * hi + ((lane & 15) >> 2)) * 64 + ((lane >> 4) & 1) * 32 + (lane & 3) * 8; \
        _Pragma("unroll") for (int db = 0; db < 4; ++db) { if (db == 2) __builtin_amdgcn_sched_barrier(0); \
            _Pragma("unroll") for (int ks = 0; ks < 4; ++ks) { const s16x4 lo = vtr(vp + (db * 4 + ks) * 1024), hh = vtr(vp + (db * 4 + ks) * 1024 + 512); \
                const bf16x8 a = (bf16x8){lo[0], lo[1], lo[2], lo[3], hh[0], hh[1], hh[2], hh[3]}; \
                o[db] = __builtin_amdgcn_mfma_f32_32x32x16_bf16(a, __builtin_bit_cast(bf16x8, pw[ks]), o[db], 0, 0, 0); } } \
        __builtin_amdgcn_sched_barrier(0); } while (0)
#define ATT_STEP(t, PC0, PC1) do { \
        { const int nw_ = (((t) + 2 < NT) ? 2 : 0) + (((t) + 1 < NT) ? 2 : 0); if (nw_ == 4) { ATT_WAIT_BAR(4); } else if (nw_ == 2) { ATT_WAIT_BAR(2); } else { ATT_WAIT_BAR(0); } } \
        if ((t) + 3 < NT) ATT_DMA_K((t) + 3); \
        if ((t) + 2 < NT) ATT_DMA_V((t) + 2); \
        if (pvpend) { ATT_PV((t) - 1); pvpend = false; } \
        if (wactive && (t) >= t_first) { \
            ATT_QK(t, PC0, PC1); \
            if (dyn) { \
                float mx = __builtin_fmaxf(PC0[0], PC1[0]); \
                _Pragma("unroll") for (int r = 1; r < 16; ++r) mx = __builtin_fmaxf(mx, __builtin_fmaxf(PC0[r], PC1[r])); \
                { auto rr = __builtin_amdgcn_permlane32_swap(__float_as_uint(mx), __float_as_uint(mx), false, false); mx = __builtin_fmaxf(__uint_as_float(rr[0]), __uint_as_float(rr[1])); } \
                if (first || __any(mx > (float)THR)) { \
                    const float dl = first ? mx : __builtin_fmaxf(mx, 0.f); m += dl; \
                    _Pragma("unroll") for (int r = 0; r < 16; ++r) { PC0[r] -= dl; PC1[r] -= dl; } \
                    if (!first) { const float f = __builtin_amdgcn_exp2f(-dl); l *= f; \
                        _Pragma("unroll") for (int d = 0; d < 4; ++d) _Pragma("unroll") for (int r = 0; r < 16; ++r) o[d][r] *= f; } \
                    first = false; } } \
            float sacc = 0.f; \
            _Pragma("unroll") for (int r = 0; r < 16; ++r) { PC0[r] = __builtin_amdgcn_exp2f(PC0[r]); PC1[r] = __builtin_amdgcn_exp2f(PC1[r]); sacc += PC0[r] + PC1[r]; } \
            l += sacc; \
            _Pragma("unroll") for (int j = 0; j < 4; ++j) { pw[0][j] = cvtpk(PC0[2 * j], PC0[2 * j + 1]); pw[1][j] = cvtpk(PC0[8 + 2 * j], PC0[8 + 2 * j + 1]); pw[2][j] = cvtpk(PC1[2 * j], PC1[2 * j + 1]); pw[3][j] = cvtpk(PC1[8 + 2 * j], PC1[8 + 2 * j + 1]); } \
            if (cc == 0) { ATT_PV(t); } else pvpend = true; \
        } } while (0)
    if (NT > 2) { ATT_WAIT_BAR(6); } else if (NT > 1) { ATT_WAIT_BAR(4); } else { ATT_WAIT_BAR(0); }
    bool pvpend = false;
    for (int t = 0; t < NT; ++t) ATT_STEP(t, pA0, pA1);
    if (pvpend) ATT_PV(NT - 1);
#undef ATT_QK
#undef ATT_PV
#undef ATT_STEP
    { auto rr = __builtin_amdgcn_permlane32_swap(__float_as_uint(l), __float_as_uint(l), false, false); l = __uint_as_float(rr[0]) + __uint_as_float(rr[1]); }
    ATT_WAIT_BAR(0);
    const float inv = 1.0f / l;
    if (wactive && cc == 1) { const float sc = inv * lam;
#pragma unroll
        for (int db = 0; db < 4; ++db)
#pragma unroll
            for (int r = 0; r < 16; ++r) *(LAS float*)(lds + rg * 16384 + ((db * 16 + r) * 64 + lane) * 4) = o[db][r] * sc; }
    ATT_WAIT_BAR(0);
    if (wactive && cc == 0) {
        float ss = 0.f;
#pragma unroll
        for (int db = 0; db < 4; ++db)
#pragma unroll
            for (int r = 0; r < 16; ++r) { const float x = *(const LAS float*)(lds + rg * 16384 + ((db * 16 + r) * 64 + lane) * 4); const float d = o[db][r] * inv - x; o[db][r] = d; ss += d * d; }
        { auto rr = __builtin_amdgcn_permlane32_swap(__float_as_uint(ss), __float_as_uint(ss), false, false); ss = __uint_as_float(rr[0]) + __uint_as_float(rr[1]); }
        const float rs = __builtin_amdgcn_rsqf(ss * (1.0f / 128.0f) + 1e-6f) * (1.0f - LAM_INIT);
        LAS unsigned char* stg = lds + STG_OFF + rg * (32 * STG_ROW);
#pragma unroll
        for (int db = 0; db < 4; ++db)
#pragma unroll
            for (int rq = 0; rq < 4; ++rq) { const int dv = 32 * db + 8 * rq + 4 * hi; const f32x4 g = *(const GAS f32x4*)(subg + dv);
                v2u w; w.x = cvtpk(o[db][4 * rq] * rs * g[0], o[db][4 * rq + 1] * rs * g[1]); w.y = cvtpk(o[db][4 * rq + 2] * rs * g[2], o[db][4 * rq + 3] * rs * g[3]);
                *(LAS v2u*)(stg + r32 * STG_ROW + dv * 2) = w; }
        asm volatile("s_waitcnt lgkmcnt(0)" ::: "memory");
        bf16* Ow = O + (size_t)(U.qrow0 + (U.sample ? 0 : 32 * rg)) * DM + U.h * 128;
#pragma unroll
        for (int it = 0; it < 8; ++it) { const int row = it * 4 + (lane >> 4), chk = lane & 15; const v4u vv = *(const LAS v4u*)(stg + row * STG_ROW + chk * 16);
            if (row < U.nvalid) *(GAS v4u*)(Ow + (size_t)row * DM + chk * 8) = vv; }
    }
    asm volatile("s_waitcnt vmcnt(0)" ::: "memory");
    ATT_WAIT_BAR(0);
#undef ATT_DMA_K
#undef ATT_DMA_V
}
__device__ __forceinline__ void attn_unit_p(LAS unsigned char* lds, const bf16* Q, bf16* O, const UnitDesc U, const float slope2, volatile LAS unsigned* lamp, const float* subg) {
    int tid_l = threadIdx.x; asm volatile("" : "+v"(tid_l));
    const int tid = tid_l, lane = tid & 63, r32 = lane & 31, hi = lane >> 5; const int wid = __builtin_amdgcn_readfirstlane(tid >> 6);
    const unsigned lds0 = (unsigned)(uintptr_t)lds;
    const lcp L3 = (lcp)lds;
    const int qpos = U.qrow0 + 32 * wid + r32;
    const int t_first = 3 - (wid >> 1);
    const int NT = U.NT;
    const int kkey0 = 8 * wid + (lane >> 4);
    const bf16* ksrc = U.Kb + (size_t)kkey0 * DM + U.h * 128 + (((lane & 15) ^ (kkey0 & 15)) * 8);
    const int kd2 = 4 * DM + (((((lane & 15) ^ (kkey0 & 15)) & 4) != 0) ? -32 : 32);
    const bf16* vsrc = U.Vb + (size_t)(32 * (wid & 1) + (lane >> 2)) * DM + U.h * 128 + (wid >> 1) * 32 + (lane & 3) * 8;
    const unsigned kxo = (unsigned)(r32 * 256 + ((hi ^ (r32 & 15)) * 16));
    const unsigned kdst = lds0 + 2048u * (unsigned)wid, vdst = lds0 + 32768u + 2048u * (unsigned)wid;
#define ATT_DMA2(t) do { int kb_ = U.kb0 - 64 * (t); kb_ = kb_ < 0 ? 0 : kb_; const size_t ro_ = (size_t)kb_ * DM; const unsigned so_ = (unsigned)(((t) & 1) * KSLOT); \
        glds16(ksrc + ro_, (unsigned)__builtin_amdgcn_readfirstlane(kdst + so_)); glds16(ksrc + ro_ + kd2, (unsigned)__builtin_amdgcn_readfirstlane(kdst + so_ + 1024u)); \
        glds16(vsrc + ro_, (unsigned)__builtin_amdgcn_readfirstlane(vdst + so_)); glds16(vsrc + ro_ + 16 * DM, (unsigned)__builtin_amdgcn_readfirstlane(vdst + so_ + 1024u)); } while (0)
    const lcp qb_ = L3 + 65536 + wid * 8192 + lane * 16;
    { const bf16* qp = Q + (size_t)qpos * DM + U.h * 128 + hi * 8;
      bf16x8 qv[8];
#pragma unroll
      for (int f = 0; f < 8; ++f) qv[f] = *(const GAS bf16x8*)(qp + (f >> 2) * 64 + (f & 3) * 16);
#pragma unroll
      for (int f = 0; f < 8; ++f) *(LAS bf16x8*)(lds + 65536 + wid * 8192 + f * 1024 + lane * 16) = qv[f]; }
    asm volatile("s_waitcnt vmcnt(0) lgkmcnt(0)" ::: "memory");
    ATT_DMA2(0);
    const float mref = U.mref < 60.0f ? U.mref : 60.0f;
    f32x2 l0v = (f32x2){0.f, 0.f}, l1v = l0v;
    f32x16 o[2][4];
#pragma unroll
    for (int c = 0; c < 2; ++c)
#pragma unroll
        for (int d = 0; d < 4; ++d)
#pragma unroll
            for (int r = 0; r < 16; ++r) o[c][d][r] = 0.f;
    ATT_WAIT_BAR(0);
    for (int t = 0; t < NT; ++t) {
        if (t + 1 < NT) ATT_DMA2(t + 1);
        if (t >= t_first) {
            int kb = U.kb0 - 64 * t; kb = kb < 0 ? 0 : kb;
            const bool gen = (t == t_first) || (t == U.NTF - 1);
            const int vhi = (t == U.NTF - 1) ? 16 : (1 << 30);
            unsigned kxt = kxo + (unsigned)((t & 1) * KSLOT); asm volatile("" : "+v"(kxt));
            const lcp vp = L3 + 32768 + (unsigned)((t & 1) * KSLOT) + (4 * hi + ((lane & 15) >> 2)) * 64 + ((lane >> 4) & 1) * 32 + (lane & 3) * 8;
#pragma unroll
            for (int hf = 0; hf < 2; ++hf) {
                v4u pw[2][2];
#pragma unroll
                for (int c = 0; c < 2; ++c) {
                    f32x16 pp;
                    { const float tb = slope2 * (float)(kb + 32 * hf + 4 * hi - qpos), s8_ = 8.0f * slope2;
                      if (gen) {
                          const int thr = vhi - kb - 32 * hf - 4 * hi; float x = tb;
#pragma unroll
                          for (int r = 0; r < 16; ++r) { const int cr = (r & 3) + 8 * (r >> 2); x = (r == 0) ? tb : ((r & 3) == 0 ? x + (s8_ - 3.0f * slope2) : x + slope2); pp[r] = cr < thr ? -__builtin_fabsf(x) - mref : -INFINITY; }
                      } else { const float tb2 = tb - mref;
                          f32x2 b01 = (f32x2){tb2, tb2 + slope2}, b23 = b01 + (f32x2){2.0f * slope2, 2.0f * slope2};
#pragma unroll
                          for (int q4 = 0; q4 < 4; ++q4) { pp[4 * q4] = b01.x; pp[4 * q4 + 1] = b01.y; pp[4 * q4 + 2] = b23.x; pp[4 * q4 + 3] = b23.y; if (q4 < 3) { b01 += (f32x2){s8_, s8_}; b23 += (f32x2){s8_, s8_}; } } } }
                    {
                        bf16x8 ka[2], qa[2];
                        ka[0] = *(const LAS bf16x8*)(L3 + ((kxt ^ (unsigned)((8 * c) * 16)) + (unsigned)(hf * 32 * 256))); qa[0] = *(const LAS bf16x8*)(qb_ + (4 * c) * 1024);
#pragma unroll
                        for (int d0 = 0; d0 < 4; ++d0) {
                            if (d0 + 1 < 4) { ka[(d0 + 1) & 1] = *(const LAS bf16x8*)(L3 + ((kxt ^ (unsigned)((8 * c + 2 * (d0 + 1)) * 16)) + (unsigned)(hf * 32 * 256))); qa[(d0 + 1) & 1] = *(const LAS bf16x8*)(qb_ + (4 * c + d0 + 1) * 1024); }
                            pp = __builtin_amdgcn_mfma_f32_32x32x16_bf16(ka[d0 & 1], qa[d0 & 1], pp, 0, 0, 0); } }
#pragma unroll
                    for (int r = 0; r < 16; ++r) pp[r] = __builtin_amdgcn_exp2f(pp[r]);
#pragma unroll
                    for (int r = 0; r < 16; r += 2) { if (c == 0) l0v += (f32x2){pp[r], pp[r + 1]}; else l1v += (f32x2){pp[r], pp[r + 1]}; }
#pragma unroll
                    for (int j = 0; j < 4; ++j) { pw[c][0][j] = cvtpk(pp[2 * j], pp[2 * j + 1]); pw[c][1][j] = cvtpk(pp[8 + 2 * j], pp[8 + 2 * j + 1]); }
                }
                {
                    s16x4 vlo[2], vhh[2];
                    vlo[0] = vtr(vp + (2 * hf) * 1024); vhh[0] = vtr(vp + (2 * hf) * 1024 + 512);
#pragma unroll
                    for (int i8 = 0; i8 < 8; ++i8) { const int db = i8 >> 1, k2 = i8 & 1;
                        if (i8 + 1 < 8) { const int dn = (i8 + 1) >> 1, kn = 2 * hf + ((i8 + 1) & 1); vlo[(i8 + 1) & 1] = vtr(vp + (dn * 4 + kn) * 1024); vhh[(i8 + 1) & 1] = vtr(vp + (dn * 4 + kn) * 1024 + 512); }
                        const s16x4 lo = vlo[i8 & 1], hh = vhh[i8 & 1];
                        const bf16x8 a = (bf16x8){lo[0], lo[1], lo[2], lo[3], hh[0], hh[1], hh[2], hh[3]};
                        o[0][db] = __builtin_amdgcn_mfma_f32_32x32x16_bf16(a, __builtin_bit_cast(bf16x8, pw[0][k2]), o[0][db], 0, 0, 0);
                        o[1][db] = __builtin_amdgcn_mfma_f32_32x32x16_bf16(a, __builtin_bit_cast(bf16x8, pw[1][k2]), o[1][db], 0, 0, 0); } }
                __builtin_amdgcn_sched_barrier(0);
            }
        }
        ATT_WAIT_BAR(0);
    }
    {
        float l0 = l0v.x + l0v.y, l1 = l1v.x + l1v.y;
        { auto rr = __builtin_amdgcn_permlane32_swap(__float_as_uint(l0), __float_as_uint(l0), false, false); l0 = __uint_as_float(rr[0]) + __uint_as_float(rr[1]); }
        { auto rr = __builtin_amdgcn_permlane32_swap(__float_as_uint(l1), __float_as_uint(l1), false, false); l1 = __uint_as_float(rr[0]) + __uint_as_float(rr[1]); }
        const float i0 = 1.0f / l0, i1 = __uint_as_float(lamp[0]) / l1;
        float ss = 0.f;
#pragma unroll
        for (int db = 0; db < 4; ++db)
#pragma unroll
            for (int r = 0; r < 16; ++r) { const float d = o[0][db][r] * i0 - o[1][db][r] * i1; o[0][db][r] = d; ss += d * d; }
        { auto rr = __builtin_amdgcn_permlane32_swap(__float_as_uint(ss), __float_as_uint(ss), false, false); ss = __uint_as_float(rr[0]) + __uint_as_float(rr[1]); }
        const float rs = __builtin_amdgcn_rsqf(ss * (1.0f / 128.0f) + 1e-6f) * (1.0f - LAM_INIT);
        LAS unsigned char* stg = lds + 65536 + wid * 8192;
        const float* sg_ = subg; asm volatile("" : "+s"(sg_));
#pragma unroll
        for (int db = 0; db < 4; ++db)
#pragma unroll
            for (int rq = 0; rq < 4; ++rq) { const int dv = 32 * db + 8 * rq + 4 * hi; const f32x4 g = *(const GAS f32x4*)(sg_ + dv);
                v2u w; w.x = cvtpk(o[0][db][4 * rq] * rs * g[0], o[0][db][4 * rq + 1] * rs * g[1]); w.y = cvtpk(o[0][db][4 * rq + 2] * rs * g[2], o[0][db][4 * rq + 3] * rs * g[3]);
                *(LAS v2u*)(stg + r32 * 256 + dv * 2) = w; }
        asm volatile("s_waitcnt lgkmcnt(0)" ::: "memory");
        bf16* Ow = O + (size_t)(U.qrow0 + 32 * wid) * DM + U.h * 128;
#pragma unroll
        for (int it = 0; it < 8; ++it) { const int row = it * 4 + (lane >> 4), chk = lane & 15; const v4u vv = *(const LAS v4u*)(stg + row * 256 + chk * 16);
            *(GAS v4u*)(Ow + (size_t)row * DM + chk * 8) = vv; }
    }
    asm volatile("s_waitcnt vmcnt(0) lgkmcnt(0)" ::: "memory");
    ATT_WAIT_BAR(0);
#undef ATT_DMA2
}
}


__device__ __forceinline__ void attn_conv_unit(CArgs& args, int cu) {
    int tid_l = threadIdx.x; asm volatile("" : "+v"(tid_l));
    const int lane = tid_l & 63, wave = __builtin_amdgcn_readfirstlane(tid_l >> 6);
    const __amdgpu_buffer_rsrc_t rs = __builtin_amdgcn_make_buffer_rsrc(P_KS, 0, (int)(264 * MiB), 0x00020000);
#pragma unroll 1
    for (int k = 0; k < 16; k += 2) {
        f32x4 va[2][8];
#pragma unroll
        for (int rr = 0; rr < 2; ++rr) { const int ri = 128 * cu + 16 * wave + k + rr, which = ri >> 15, idx = ri & 32767;
            const float* src = (which ? P_IN(I_CV) : P_IN(I_CK)) + (size_t)idx * DM;
#pragma unroll
            for (int j = 0; j < 4; ++j) { va[rr][2 * j] = *(const GAS f32x4*)(src + 512 * j + 8 * lane); va[rr][2 * j + 1] = *(const GAS f32x4*)(src + 512 * j + 8 * lane + 4); } }
#pragma unroll
        for (int rr = 0; rr < 2; ++rr) { const int ri = 128 * cu + 16 * wave + k + rr, which = ri >> 15, idx = ri & 32767, b = idx >> 11, p = idx & 2047;
            const unsigned off = (unsigned)(((size_t)which * 16 * KS_ROWS + (size_t)b * KS_ROWS + 16 + p) * DM * 2);
#pragma unroll
            for (int j = 0; j < 4; ++j) { const f32x4 a = va[rr][2 * j], bq = va[rr][2 * j + 1];
                v4u o; o.x = pk2(a[0], a[1]); o.y = pk2(a[2], a[3]); o.z = pk2(bq[0], bq[1]); o.w = pk2(bq[2], bq[3]);
                __builtin_amdgcn_raw_buffer_store_b128(o, rs, (int)(off + (unsigned)(512 * j + 8 * lane) * 2u), 0,   16); } }
    }
    asm volatile("s_waitcnt vmcnt(0)" ::: "memory");
    __syncthreads();
    if (threadIdx.x == 0) { const int b = ((128 * cu) & 32767) >> 11; __hip_atomic_fetch_add((unsigned*)(P_CTL + CW_SCONV) + 16 * b, 1u, __ATOMIC_RELAXED, __HIP_MEMORY_SCOPE_AGENT); }
}
__device__ __forceinline__ void attn_phase(const Frame& F, CArgs& args) {
    int ln = threadIdx.x & 63; asm volatile("" : "+v"(ln));
    float lam;
    { const float* dl = P_IN(I_DLAM); const float a = wave_sum(dl[ln] * dl[64 + ln]), b = wave_sum(dl[128 + ln] * dl[192 + ln]); lam = __expf(a) - __expf(b) + LAM_INIT; }
    float tcut, smax2;
    { float mq = __builtin_fabsf(P_IN(I_QNORM)[ln]), mk = __builtin_fabsf(P_IN(I_KNORM)[ln]);
#pragma unroll
      for (int o = 1; o < 64; o <<= 1) { mq = __builtin_fmaxf(mq, __shfl_xor(mq, o)); mk = __builtin_fmaxf(mk, __shfl_xor(mk, o)); }
      tcut = 2.0f * (8.0f * mq * mk * 1.02f) + 106.0f; smax2 = 8.0f * mq * mk * 1.02f * LOG2E; }
    if (threadIdx.x == 0) { F.MISC[20] = __float_as_uint(lam); F.MISC[21] = __float_as_uint(tcut); F.MISC[22] = __float_as_uint(smax2); }
    __syncthreads();
    const bf16* Q = P_ACT; bf16* O = P_A3;
    const int nun = 1024 + 512 + 256;
    unsigned* qctr = (unsigned*)(P_CTL + CW_ATTQ);
    for (;;) {
        if (threadIdx.x == 0) F.MISC[16] = atomicAdd(qctr, 1u);
        __syncthreads();
        const int idx = (int)F.MISC[16];
        if (idx >= nun) break;
        int uid, sunit = -1;
        if (idx < 256) uid = idx;
        else if (idx < 1280) { const int g = (idx - 256) >> 1; if (idx & 1) { attn_conv_unit(args, g); continue; } uid = 256 + g; }
        else { const int g = (idx - 1280) >> 1; if (idx & 1) sunit = g; uid = 768 + g; }
        const float tcut_u = __uint_as_float((unsigned)__builtin_amdgcn_readfirstlane((int)F.MISC[21])), smax2_u = __uint_as_float((unsigned)__builtin_amdgcn_readfirstlane((int)F.MISC[22]));
        att::UnitDesc U;
        if (sunit < 0) { const int jb = 63 - (uid >> 4); U.h = 15 - (uid & 15); U.Kb = P_KP; U.Vb = P_VP; U.qrow0 = 16 + 256 * jb; U.kb0 = 16 + 64 * (4 * jb + 3); U.NTF = 4 * jb + 5; U.sample = 0; U.nvalid = 32;
            const float slope = exp2f(-0.5f * (float)(U.h + 1));
            const float w = (tcut_u / slope + 255.0f) * (1.0f / 64.0f); const int wt = w > 1000.f ? 1000 : (int)w + 1;
            U.NT = wt < U.NTF ? wt : U.NTF; U.dyn = smax2_u < 40.0f ? 0 : 1; U.mref = smax2_u; }
        else {
            const int b = sunit >> 4;
            if (threadIdx.x == 0) { unsigned* cw = (unsigned*)(P_CTL + CW_SCONV) + 16 * b; unsigned sp = 0;
                while (__hip_atomic_load(cw, __ATOMIC_RELAXED, __HIP_MEMORY_SCOPE_AGENT) < 32u && ++sp < (1u << 22)) __builtin_amdgcn_s_sleep(2);
                __builtin_amdgcn_fence(__ATOMIC_ACQUIRE, "agent"); asm volatile("s_waitcnt vmcnt(0)" ::: "memory"); }
            __syncthreads();
            U.h = sunit & 15; U.Kb = P_KS + (size_t)b * KS_ROWS * DM; U.Vb = P_VS + (size_t)b * KS_ROWS * DM; U.qrow0 = ROW_S0 + 16 * b; U.kb0 = 2048; U.NT = 33; U.NTF = 33; U.sample = 1; U.nvalid = 16; U.dyn = 1; U.mref = 0.f; }
        const float slope2 = exp2f(-0.5f * (float)(U.h + 1)) * LOG2E;
        if (sunit < 0) att::attn_unit_p(F.lds + RING_OFF, Q, O, U, slope2, F.MISC + 20, P_IN(I_SUBNORM)); else att::attn_unit_s<8>(F.lds + RING_OFF, Q, O, U, slope2, __uint_as_float(F.MISC[20]), P_IN(I_SUBNORM));
    }
}

__global__ void __launch_bounds__(NWAVES * 64, 2) fwd_kernel(Args args_kv) {
    extern __shared__ __attribute__((aligned(16))) unsigned char lds[];
    Frame F;
    F.lds = (LAS unsigned char*)lds;
    F.MISC = (volatile LAS unsigned*)(F.lds + MISC_OFF);
    F.tid = threadIdx.x; F.lane = F.tid & 63; F.wave = __builtin_amdgcn_readfirstlane(F.tid >> 6); F.G = gridDim.x;
    for (int u = F.tid; u < (LDS_BYTES - LDSCTL_OFF) / 4; u += NWAVES * 64) ((LAS unsigned*)(F.lds + LDSCTL_OFF))[u] = 0u;
    __syncthreads();
    const Args& args = args_kv;
    const int lo = args.ph_lo, hi = args.ph_hi;
    XcdBarrier bar; bar.bar = (unsigned*)(P_CTL + CW_BAR); bar.x = 0; bar.st = nullptr;
    if (hi - lo > 1) bar = xcd_barrier_post((unsigned*)(P_CTL + CW_BAR), F.MISC + 8);
    int ph = 0;
#define RUN() (ph >= lo && ph < hi)
#define SEAM() do { if (ph >= lo && ph + 1 < hi) xcd_barrier(bar); ++ph; } while (0)
#define SEAM_NOBAR() do { if (MK_PER_PHASE) { SEAM(); } else { ++ph; } } while (0)

    if (RUN() && EN_P0) p0_prologue(F, *largs());
    SEAM();
    for (int ls = 0; ls < 4; ++ls) {
        if (RUN() && EN_GU) {
            CArgs& args = *largs();
            pg8::Gemm g{P_X16, P_WGU + (size_t)ls * 11264 * DM, MROWS, 11264, DM}; pg8::SplitOrder S; S.init(11264, DM, F.G, lbid(), 2, ph * 128, P_SLAB, P_SCNT, 120, 1);
            const int si = ls == 0 ? 0 : ls == 1 ? 2 : ls == 2 ? 3 : 5;
            pg8::EpiGU E{P_HID, P_SSQ + (size_t)si * MROWS};
            pg8::gemm_phase<pg8::EpiGU, pg8::SplitOrder, PG8_ALIGN, PG8_SP2>(F.lds + RING_OFF, g, S, E);
        }
        SEAM();
        if (RUN() && EN_DN) {
            CArgs& args = *largs();
            pg8::Gemm g{P_HID, P_WDN + (size_t)ls * DM * DFF, MROWS, DM, DFF}; pg8::SplitOrder S; S.init(DM, DFF, F.G, lbid(), 8, ph * 128, P_SLAB, P_SCNT);
            const int so = ls == 0 ? 1 : ls == 1 ? 3 : ls == 2 ? 4 : 0;
            pg8::EpiRes E{P_X16, P_SSQ + (size_t)so * MROWS, 0.5f, ls == 3 ? 1 : 0, P_OUT + O_YP, P_OUT + O_YS};
            pg8::gemm_phase<pg8::EpiRes, pg8::SplitOrder, PG8_ALIGN, PG8_SP2>(F.lds + RING_OFF, g, S, E);
        }
        SEAM();
        if (ls == 0) {
            if (RUN() && EN_WIN) {
            CArgs& args = *largs();
                pg8::Gemm g{P_X16, P_WIN, MROWS, 4096, DM}; pg8::SplitOrder S; S.init(4096, DM, F.G, lbid(), 4, ph * 128, P_SLAB, P_SCNT);
                pg8::EpiWin E{P_GG, P_XB, P_SSQ + (size_t)1 * MROWS};
                pg8::gemm_phase<pg8::EpiWin, pg8::SplitOrder, PG8_ALIGN, PG8_SP2>(F.lds + RING_OFF, g, S, E);
            }
            SEAM();
            if (RUN() && EN_RG0) rg_phase<0>(F, *largs());
            SEAM();
            if (RUN() && EN_RG1) rg_phase<1>(F, *largs());
            SEAM();
        } else if (ls == 1) {
            if (RUN() && EN_KV) {
            CArgs& args = *largs();
                pg8::Gemm g{P_X16, P_WKV, MROWS, 4096, DM}; pg8::SplitOrder S; S.init(4096, DM, F.G, lbid(), 4, ph * 128, P_SLAB + (size_t)256 * 32768, P_SCNT);
                pg8::EpiKV E{P_SSQ + (size_t)3 * MROWS, P_IN(I_KNORM), P_OUT + O_KP, P_OUT + O_VP, P_OUT + O_KS, P_OUT + O_VS, P_KP, P_VP, P_KS, P_VS};
                pg8::gemm_phase<pg8::EpiKV, pg8::SplitOrder, PG8_ALIGN, PG8_SP2>(F.lds + RING_OFF, g, S, E);
            }
            SEAM_NOBAR();
        } else if (ls == 2) {
            if (RUN() && EN_Q) {
            CArgs& args = *largs();
                pg8::Gemm g{P_X16, P_WQ, MROWS, DM, DM}; pg8::SplitOrder S; S.init(DM, DM, F.G, lbid(), 4, ph * 128, P_SLAB, P_SCNT);
                pg8::EpiQ E{P_SSQ + (size_t)4 * MROWS, P_IN(I_QNORM), P_ACT, 0.125f * LOG2E};
                pg8::gemm_phase<pg8::EpiQ, pg8::SplitOrder, PG8_ALIGN, PG8_SP2>(F.lds + RING_OFF, g, S, E);
            }
            SEAM();
            if (RUN() && EN_ATT) attn_phase(F, *largs());
            SEAM();
        }
        if (ls == 0 || ls == 2) {
            if (RUN() && EN_RES) {
            CArgs& args = *largs();
                pg8::Gemm g{ls == 0 ? P_ACT : P_A3, ls == 0 ? P_WOUT : P_WO, MROWS, DM, DM}; pg8::SplitOrder S; S.init(DM, DM, F.G, lbid(), 4, ph * 128, P_SLAB, P_SCNT);
                pg8::EpiRes E{P_X16, P_SSQ + (size_t)(ls == 0 ? 2 : 5) * MROWS, 1.0f, 0, P_OUT + O_YP, P_OUT + O_YS};
                pg8::gemm_phase<pg8::EpiRes, pg8::SplitOrder, PG8_ALIGN, PG8_SP2>(F.lds + RING_OFF, g, S, E);
            }
            SEAM();
        }
    }
#undef RUN
#undef SEAM
}

extern "C" void kernel_launch(void* const* d_in, const int* in_sizes, int n_in, void* d_out, int out_size, void* d_ws, size_t ws_size, hipStream_t stream) {
    static int grid = 0;
    if (grid == 0) {
        if (n_in != 28 || in_sizes[0] != 16384 * DM || (size_t)out_size != O_END || ws_size < WS_END) {
            fprintf(stderr, "kernel_launch: unexpected shapes: n_in %d, in0 %d, out %d, ws %zu (need %zu); nothing launched\n", n_in, n_in > 0 ? in_sizes[0] : -1, out_size, ws_size, (size_t)WS_END); grid = -1; return; }
        int dev = 0, cus = 0, per_cu = 0;
        if (hipGetDevice(&dev) != hipSuccess || hipDeviceGetAttribute(&cus, hipDeviceAttributeMultiprocessorCount, dev) != hipSuccess) { grid = -1; return; }
        if (hipFuncSetAttribute((const void*)fwd_kernel, hipFuncAttributeMaxDynamicSharedMemorySize, LDS_BYTES) != hipSuccess) { fprintf(stderr, "kernel_launch: hipFuncSetAttribute failed\n"); grid = -1; return; }
        if (hipOccupancyMaxActiveBlocksPerMultiprocessor(&per_cu, (const void*)fwd_kernel, NWAVES * 64, LDS_BYTES) != hipSuccess || per_cu < 1) { fprintf(stderr, "kernel_launch: occupancy query says %d blocks per CU\n", per_cu); }
        (void)hipGetLastError();
        grid = cus;
    }
    if (grid < 0) return;
    if (hipMemsetAsync((char*)d_ws + WS_CTL, 0, CTL_ZERO_BYTES, stream) != hipSuccess) return;
    Args a{};
    for (int i = 0; i < 28; ++i) a.in[i] = (const float*)d_in[i];
    a.out = (float*)d_out; a.ws = (unsigned char*)d_ws;
#if MK_PER_PHASE
    for (int p = 0; p < NPHASE; ++p) { a.ph_lo = p; a.ph_hi = p + 1; hipLaunchKernelGGL(fwd_kernel, dim3(grid), dim3(NWAVES * 64), LDS_BYTES, stream, a); }
#else
    a.ph_lo = 0; a.ph_hi = NPHASE;
    hipLaunchKernelGGL(fwd_kernel, dim3(grid), dim3(NWAVES * 64), LDS_BYTES, stream, a);
#endif
    const hipError_t le = hipPeekAtLastError();
    if (le != hipSuccess) fprintf(stderr, "kernel_launch: launch failed: %s\n", hipGetErrorName(le));
}
```

```cpp
#include <hip/hip_runtime.h>
#include <cstdio>
#include <cstdint>
namespace pg8 {
#define PG8_LAS __attribute__((address_space(3)))
typedef unsigned short bf16_t;
typedef short bf16x8 __attribute__((ext_vector_type(8)));
typedef float f32x4 __attribute__((ext_vector_type(4)));
typedef unsigned u32x4 __attribute__((ext_vector_type(4)));
constexpr int BM = 256, BK = 64, HALF = 128, HTB = HALF * BK * 2  , STAGE_BYTES = 8 * HTB, NXCD = 8, WGM = 8;

__host__ __device__ __forceinline__ int lds_byte(int r, int c) { const int st = (r >> 4) * 2 + (c >> 5), rr = r & 15, cc = c & 31, ob = rr * 64 + cc * 2; return st * 1024 + (ob ^ (((ob >> 9) & 1) << 5)); }
__host__ __device__ __forceinline__ void stage_rc(int b, int& R, int& C) { const int st = b / 1024, sb = b % 1024, swz = sb ^ (((sb >> 9) & 1) << 5); R = (st >> 1) * 16 + swz / 64; C = (st & 1) * 32 + (swz % 64) / 2; }
__host__ __device__ __forceinline__ int perm32(int rho) { const int n = rho >> 4, i = rho & 15; return 8 * (i >> 2) + 4 * n + (i & 3); }

struct Unit { int pm, pn, kt0, nt, nsplit, slab, cidx, half; };
struct Gemm { const bf16_t* A; const bf16_t* Bt; int M, N, K; };

struct StaticOrder {
    int nM, nN, nwg, G, c;
    __host__ __device__ void init(int M, int N, int G_, int c_) { nM = M / BM; nN = N / BM; nwg = nM * nN; G = G_; c = c_; }
    __host__ __device__ bool next(int i, Unit& u) const {
        const long L = (long)i * G + c; if (L >= nwg) return false;
        int wgid = (int)L; { const int q = nwg / NXCD, r = nwg % NXCD, xcd = wgid % NXCD, off = wgid / NXCD; wgid = (xcd < r ? xcd * (q + 1) : r * (q + 1) + (xcd - r) * q) + off; }
        const int nig = WGM * nN, gid = wgid / nig, fm = gid * WGM, gsz = (nM - fm) < WGM ? (nM - fm) : WGM;
        u.pm = 2 * (fm + ((wgid % nig) % gsz)); u.pn = (wgid % nig) / gsz; u.kt0 = 0; u.nt = 0; u.nsplit = 1; u.slab = 0; u.cidx = 0; u.half = 0; return true;
    }
    __device__ __forceinline__ void a_ready(const Unit&) const {}
    __device__ __forceinline__ void done(const Unit&) const {}
};

__device__ __forceinline__ unsigned cvt_pk_bf16(float lo, float hi) { unsigned r; asm volatile("v_cvt_pk_bf16_f32 %0, %1, %2" : "=v"(r) : "v"(lo), "v"(hi)); return r; }
constexpr float RMS_EPS = 1e-6f;
__device__ __forceinline__ float row_rstd(const float* ssq, int row) { return __builtin_amdgcn_rsqf(ssq[row] * (1.0f / 2048.0f) + RMS_EPS); }
__device__ __forceinline__ float fast_sigmoid(float x) { return __builtin_amdgcn_rcpf(1.0f + __builtin_amdgcn_exp2f(-1.4426950408889634f * x)); }
__device__ __forceinline__ u32x4 pack8(const f32x4 a, const f32x4 b) { u32x4 w; w.x = cvt_pk_bf16(a[0], a[1]); w.y = cvt_pk_bf16(a[2], a[3]); w.z = cvt_pk_bf16(b[0], b[1]); w.w = cvt_pk_bf16(b[2], b[3]); return w; }

struct EpiGU {
    static constexpr bool PERM = true, AFTER_DRAIN = false;
    bf16_t* H; const float* ssq;
    template <bool HF> __device__ __forceinline__ void run(const f32x4 (&acc)[2][2][4][2], const Unit& u, int wr, int wc, int fr, int fq) const {
        typedef float f2 __attribute__((ext_vector_type(2)));
        typedef __bf16 b2 __attribute__((ext_vector_type(2)));
        const int colh = u.pn * 128 + wc * 32 + 8 * fq;
        float rsv[8];
#pragma unroll
        for (int i = 0; i < (HF ? 4 : 8); ++i) rsv[i] = row_rstd(ssq, u.pm * HALF + (i >> 2) * HALF + wr * 64 + (i & 3) * 16 + fr);
#pragma unroll
        for (int ai = 0; ai < (HF ? 1 : 2); ++ai)
#pragma unroll
            for (int m = 0; m < 4; ++m) {
                const int row = u.pm * HALF + ai * HALF + wr * 64 + m * 16 + fr; const float rs = rsv[ai * 4 + m];
                const float nrs = -1.4426950408889634f * rs, rs2 = rs * rs;
                f2 g[4], up[4], t[4], r[4];
#pragma unroll
                for (int p = 0; p < 4; ++p) { g[p] = (f2){acc[ai][0][m][p >> 1][2 * (p & 1)], acc[ai][0][m][p >> 1][2 * (p & 1) + 1]}; up[p] = (f2){acc[ai][1][m][p >> 1][2 * (p & 1)], acc[ai][1][m][p >> 1][2 * (p & 1) + 1]}; }
#pragma unroll
                for (int p = 0; p < 4; ++p) t[p] = g[p] * (f2){nrs, nrs};
#pragma unroll
                for (int p = 0; p < 4; ++p) { t[p].x = __builtin_amdgcn_exp2f(t[p].x); t[p].y = __builtin_amdgcn_exp2f(t[p].y); }
#pragma unroll
                for (int p = 0; p < 4; ++p) { t[p] = t[p] + (f2){1.0f, 1.0f}; g[p] = g[p] * up[p]; }
#pragma unroll
                for (int p = 0; p < 4; ++p) { r[p].x = __builtin_amdgcn_rcpf(t[p].x); r[p].y = __builtin_amdgcn_rcpf(t[p].y); }
                u32x4 w;
#pragma unroll
                for (int p = 0; p < 4; ++p) { const f2 h = g[p] * (r[p] * (f2){rs2, rs2}); w[p] = __builtin_bit_cast(unsigned, __builtin_convertvector(h, b2)); }
                *(u32x4*)(H + (size_t)row * 5632 + colh) = w;
            }
    }
    __device__ __forceinline__ void operator()(const f32x4 (&acc)[2][2][4][2], const Unit& u, int wr, int wc, int fr, int fq) const { run<false>(acc, u, wr, wc, fr, fq); }
    __device__ __forceinline__ void half(const f32x4 (&acc)[2][2][4][2], const Unit& u, int wr, int wc, int fr, int fq) const { run<true>(acc, u, wr, wc, fr, fq); }
};
struct EpiRes {
    static constexpr bool PERM = true, AFTER_DRAIN = false;
    bf16_t* x16; float* ssq; float scale; int final_; float* yp; float* ys;
    template <bool HF> __device__ __forceinline__ void run(const f32x4 (&acc)[2][2][4][2], const Unit& u, int wr, int wc, int fr, int fq) const {
        const int col = u.pn * BM + wc * 64 + 8 * fq;
        u32x4 xw[HF ? 4 : 8][2];
#pragma unroll
        for (int i = 0; i < (HF ? 4 : 8); ++i) { const bf16_t* xq = x16 + (size_t)(u.pm * HALF + (i >> 2) * HALF + wr * 64 + (i & 3) * 16 + fr) * 2048 + col; xw[i][0] = *(const u32x4*)xq; xw[i][1] = *(const u32x4*)(xq + 32); }
#pragma unroll
        for (int ai = 0; ai < (HF ? 1 : 2); ++ai)
#pragma unroll
            for (int m = 0; m < 4; ++m) {
                const int row = u.pm * HALF + ai * HALF + wr * 64 + m * 16 + fr;
                bf16_t* xp = x16 + (size_t)row * 2048 + col; float sq = 0.f;
                float* op = nullptr;
                if (final_) { if (row >= 16 && row < 16400) op = yp + (size_t)(row - 16) * 2048 + col; else if (row >= 16400 && row < 16656) op = ys + (size_t)(row - 16400) * 2048 + col; }
                const u32x4 w0 = xw[ai * 4 + m][0], w1 = xw[ai * 4 + m][1];
#pragma unroll
                for (int bj = 0; bj < 2; ++bj) {
                    const u32x4 w = bj ? w1 : w0;
                    const f32x4 x0 = (f32x4){__uint_as_float(w.x << 16), __uint_as_float(w.x & 0xffff0000u), __uint_as_float(w.y << 16), __uint_as_float(w.y & 0xffff0000u)};
                    const f32x4 x1 = (f32x4){__uint_as_float(w.z << 16), __uint_as_float(w.z & 0xffff0000u), __uint_as_float(w.w << 16), __uint_as_float(w.w & 0xffff0000u)};
                    const f32x4 v0 = x0 + acc[ai][bj][m][0] * scale, v1 = x1 + acc[ai][bj][m][1] * scale;
                    if (final_) { if (op) { *(f32x4*)(op + 32 * bj) = v0; *(f32x4*)(op + 32 * bj + 4) = v1; } }
                    else { *(u32x4*)(xp + 32 * bj) = pack8(v0, v1);
                        sq += (v0[0] * v0[0] + v0[1] * v0[1]) + (v0[2] * v0[2] + v0[3] * v0[3]) + (v1[0] * v1[0] + v1[1] * v1[1]) + (v1[2] * v1[2] + v1[3] * v1[3]); }
                }
                if (!final_) { sq += __shfl_xor(sq, 16); sq += __shfl_xor(sq, 32); if (fq == 0) atomicAdd(ssq + row, sq); }
            }
    }
    __device__ __forceinline__ void operator()(const f32x4 (&acc)[2][2][4][2], const Unit& u, int wr, int wc, int fr, int fq) const { run<false>(acc, u, wr, wc, fr, fq); }
    __device__ __forceinline__ void half(const f32x4 (&acc)[2][2][4][2], const Unit& u, int wr, int wc, int fr, int fq) const { run<true>(acc, u, wr, wc, fr, fq); }
};
struct EpiWin {
    static constexpr bool PERM = true, AFTER_DRAIN = false;
    bf16_t* GG; float* XB; const float* ssq;
    template <bool HF> __device__ __forceinline__ void run(const f32x4 (&acc)[2][2][4][2], const Unit& u, int wr, int wc, int fr, int fq) const {
        const int col = (u.pn & 7) * BM + wc * 64 + 8 * fq; const bool isg = u.pn < 8;
        float rsv[HF ? 4 : 8];
#pragma unroll
        for (int i = 0; i < (HF ? 4 : 8); ++i) rsv[i] = row_rstd(ssq, u.pm * HALF + (i >> 2) * HALF + wr * 64 + (i & 3) * 16 + fr);
#pragma unroll
        for (int ai = 0; ai < (HF ? 1 : 2); ++ai)
#pragma unroll
            for (int m = 0; m < 4; ++m) {
                const int row = u.pm * HALF + ai * HALF + wr * 64 + m * 16 + fr; const float rs = rsv[ai * 4 + m];
#pragma unroll
                for (int bj = 0; bj < 2; ++bj) {
                    f32x4 v0 = acc[ai][bj][m][0] * rs, v1 = acc[ai][bj][m][1] * rs;
                    if (isg) {
#pragma unroll
                        for (int e = 0; e < 4; ++e) { const float a = v0[e], b = v1[e];
                            v0[e] = a * fast_sigmoid(1.5957691216057308f * (a + 0.044715f * a * a * a)); v1[e] = b * fast_sigmoid(1.5957691216057308f * (b + 0.044715f * b * b * b)); }
                        *(u32x4*)(GG + (size_t)row * 2048 + col + 32 * bj) = pack8(v0, v1);
                    } else { float* xp = XB + (size_t)row * 2048 + col + 32 * bj; *(f32x4*)xp = v0; *(f32x4*)(xp + 4) = v1; }
                }
            }
    }
    __device__ __forceinline__ void operator()(const f32x4 (&acc)[2][2][4][2], const Unit& u, int wr, int wc, int fr, int fq) const { run<false>(acc, u, wr, wc, fr, fq); }
    __device__ __forceinline__ void half(const f32x4 (&acc)[2][2][4][2], const Unit& u, int wr, int wc, int fr, int fq) const { run<true>(acc, u, wr, wc, fr, fq); }
};
__device__ __forceinline__ float group_rstd64(const f32x4 (&v)[2][2]) {
    float s = 0.f;
#pragma unroll
    for (int bj = 0; bj < 2; ++bj)
#pragma unroll
        for (int n = 0; n < 2; ++n) s += (v[bj][n][0] * v[bj][n][0] + v[bj][n][1] * v[bj][n][1]) + (v[bj][n][2] * v[bj][n][2] + v[bj][n][3] * v[bj][n][3]);
    s += __shfl_xor(s, 16); s += __shfl_xor(s, 32);
    return __builtin_amdgcn_rsqf(s * (1.0f / 64.0f) + RMS_EPS);
}
struct EpiKV {
    static constexpr bool PERM = true, AFTER_DRAIN = false;
    const float* ssq; const float* kg;
    float* okp; float* ovp; float* oks; float* ovs;
    bf16_t* KP; bf16_t* VP; bf16_t* KS; bf16_t* VS;
    template <bool HF> __device__ __forceinline__ void run(const f32x4 (&acc)[2][2][4][2], const Unit& u, int wr, int wc, int fr, int fq) const {
        const bool isk = u.pn < 8; const int col = (u.pn & 7) * BM + wc * 64 + 8 * fq;
        f32x4 g[2][2];
#pragma unroll
        for (int bj = 0; bj < 2; ++bj)
#pragma unroll
            for (int n = 0; n < 2; ++n) g[bj][n] = isk ? *(const f32x4*)(kg + 32 * bj + 8 * fq + 4 * n) : (f32x4){1.f, 1.f, 1.f, 1.f};
        float* o32p = isk ? okp : ovp; float* o32s = isk ? oks : ovs; bf16_t* b16p = isk ? KP : VP; bf16_t* b16s = isk ? KS : VS;
        float rsv[HF ? 4 : 8];
#pragma unroll
        for (int i = 0; i < (HF ? 4 : 8); ++i) rsv[i] = row_rstd(ssq, u.pm * HALF + (i >> 2) * HALF + wr * 64 + (i & 3) * 16 + fr);
#pragma unroll
        for (int ai = 0; ai < (HF ? 1 : 2); ++ai)
#pragma unroll
            for (int m = 0; m < 4; ++m) {
                const int row = u.pm * HALF + ai * HALF + wr * 64 + m * 16 + fr; const float rs = rsv[ai * 4 + m];
                f32x4 v[2][2];
#pragma unroll
                for (int bj = 0; bj < 2; ++bj)
#pragma unroll
                    for (int n = 0; n < 2; ++n) v[bj][n] = acc[ai][bj][m][n] * rs;
                if (isk) { const float gr = group_rstd64(v);
#pragma unroll
                    for (int bj = 0; bj < 2; ++bj)
#pragma unroll
                        for (int n = 0; n < 2; ++n) v[bj][n] = v[bj][n] * gr * g[bj][n]; }
                float* o32 = nullptr; bf16_t* b16 = nullptr;
                if (row < 16400) { o32 = o32p + (size_t)row * 2048; b16 = b16p + (size_t)row * 2048; }
                else if (row < 16656) { const int sr = row - 16400; o32 = o32s + (size_t)sr * 2048; b16 = b16s + ((size_t)(sr >> 4) * 2112 + 2064 + (sr & 15)) * 2048; }
                if (o32) {
#pragma unroll
                    for (int bj = 0; bj < 2; ++bj) { float* p = o32 + col + 32 * bj; *(f32x4*)p = v[bj][0]; *(f32x4*)(p + 4) = v[bj][1]; *(u32x4*)(b16 + col + 32 * bj) = pack8(v[bj][0], v[bj][1]); }
                    if (row < 16) {
                        for (int b = 0; b < 16; ++b) { bf16_t* q = b16s + ((size_t)b * 2112 + row) * 2048 + col;
#pragma unroll
                            for (int bj = 0; bj < 2; ++bj) *(u32x4*)(q + 32 * bj) = pack8(v[bj][0], v[bj][1]); }
                    }
                }
            }
    }
    __device__ __forceinline__ void operator()(const f32x4 (&acc)[2][2][4][2], const Unit& u, int wr, int wc, int fr, int fq) const { run<false>(acc, u, wr, wc, fr, fq); }
    __device__ __forceinline__ void half(const f32x4 (&acc)[2][2][4][2], const Unit& u, int wr, int wc, int fr, int fq) const { run<true>(acc, u, wr, wc, fr, fq); }
};
struct EpiQ {
    static constexpr bool PERM = true, AFTER_DRAIN = false;
    const float* ssq; const float* qg; bf16_t* Q; float c2;
    template <bool HF> __device__ __forceinline__ void run(const f32x4 (&acc)[2][2][4][2], const Unit& u, int wr, int wc, int fr, int fq) const {
        const int col = u.pn * BM + wc * 64 + 8 * fq;
        f32x4 g[2][2];
        float rsv[HF ? 4 : 8];
#pragma unroll
        for (int i = 0; i < (HF ? 4 : 8); ++i) rsv[i] = row_rstd(ssq, u.pm * HALF + (i >> 2) * HALF + wr * 64 + (i & 3) * 16 + fr);
#pragma unroll
        for (int bj = 0; bj < 2; ++bj)
#pragma unroll
            for (int n = 0; n < 2; ++n) g[bj][n] = *(const f32x4*)(qg + 32 * bj + 8 * fq + 4 * n) * c2;
#pragma unroll
        for (int ai = 0; ai < (HF ? 1 : 2); ++ai)
#pragma unroll
            for (int m = 0; m < 4; ++m) {
                const int row = u.pm * HALF + ai * HALF + wr * 64 + m * 16 + fr; const float rs = rsv[ai * 4 + m];
                f32x4 v[2][2];
#pragma unroll
                for (int bj = 0; bj < 2; ++bj)
#pragma unroll
                    for (int n = 0; n < 2; ++n) v[bj][n] = acc[ai][bj][m][n] * rs;
                const float gr = group_rstd64(v);
#pragma unroll
                for (int bj = 0; bj < 2; ++bj) *(u32x4*)(Q + (size_t)row * 2048 + col + 32 * bj) = pack8(v[bj][0] * gr * g[bj][0], v[bj][1] * gr * g[bj][1]);
            }
    }
    __device__ __forceinline__ void operator()(const f32x4 (&acc)[2][2][4][2], const Unit& u, int wr, int wc, int fr, int fq) const { run<false>(acc, u, wr, wc, fr, fq); }
    __device__ __forceinline__ void half(const f32x4 (&acc)[2][2][4][2], const Unit& u, int wr, int wc, int fr, int fq) const { run<true>(acc, u, wr, wc, fr, fq); }
};

struct SplitOrder {
    int nN, nwgP, G, c, nsplit, nsB, TA, npairs, cbase; long skipP; float* slabs; unsigned* cnt;
    __device__ __forceinline__ void init(int N, int K, int G_, int c_, int nsplit_, int cbase_, float* slabs_, unsigned* cnt_, int TA_ = 1 << 20, int nsB_ = 1) {
        nN = N / BM; nwgP = 64 * nN; G = G_; c = c_; nsplit = nsplit_; nsB = nsB_; TA = TA_ < 3 * nN ? TA_ : 3 * nN; npairs = K / (2 * BK); cbase = cbase_; slabs = slabs_; cnt = cnt_; skipP = 0; }
    __device__ __forceinline__ bool next(int i, Unit& u) const {
        const long L = (long)i * G + c + skipP;
        if (L < nwgP) { int wgid = (int)L; { const int q = nwgP / NXCD, r = nwgP % NXCD, xcd = wgid % NXCD, off = wgid / NXCD; wgid = (xcd < r ? xcd * (q + 1) : r * (q + 1) + (xcd - r) * q) + off; }
            const int nig = WGM * nN, gid = wgid / nig, fm = gid * WGM;
            u.pm = 2 * (fm + ((wgid % nig) % WGM)); u.pn = (wgid % nig) / WGM; u.kt0 = 0; u.nt = 2 * npairs; u.nsplit = 1; u.slab = 0; u.cidx = 0; u.half = 0; return true; }
        const int m = (int)(L - nwgP); int tau, j, ns = nsplit, mm = m, t0 = 0;
        const int MA = ((TA + 7) & ~7) * nsplit;
        if (m >= MA) { mm = m - MA; ns = nsB; t0 = TA; }
        if (G == 256) { if (m >= 256) return false; const int x = mm & 7, v = mm >> 3; tau = t0 + 8 * (v / ns) + x; j = v % ns; }
        else { tau = t0 + mm / ns; j = mm % ns; }
        if (tau >= 3 * nN || (t0 == 0 && tau >= TA)) return false;
        const int per = npairs / ns, rem = npairs - per * ns;
        u.pm = 128 + tau / nN; u.pn = tau % nN; u.kt0 = 2 * (j * per + (j < rem ? j : rem)); u.nt = 2 * (per + (j < rem ? 1 : 0)); u.nsplit = ns; u.slab = m; u.cidx = cbase + tau; u.half = 1; return true;
    }
    __device__ __forceinline__ void a_ready(const Unit&) const {}
    __device__ __forceinline__ void done(const Unit&) const {}
    __device__ __forceinline__ bool split_combine(f32x4 (&acc)[2][2][4][2], const Unit& u, int wid, int lane) const {
        const __amdgpu_buffer_rsrc_t rs = __builtin_amdgcn_make_buffer_rsrc(slabs, 0, 256 * 131072, 0x00020000);
        const unsigned voff = ((unsigned)u.slab * 32768u + (unsigned)wid * 4096u + (unsigned)lane * 4u) * 4u;
#pragma unroll
        for (int i = 0; i < 8; ++i) __builtin_amdgcn_raw_buffer_store_b128(pack8(acc[0][(i >> 2) & 1][i & 3][0], acc[0][(i >> 2) & 1][i & 3][1]), rs, (int)(voff + (unsigned)i * 1024u), 0,   16);
        asm volatile("s_waitcnt vmcnt(0)" ::: "memory");
        unsigned t = 0; if (lane == 0) t = __hip_atomic_fetch_add(cnt + (size_t)u.cidx * 8 + wid, 1u, __ATOMIC_RELAXED, __HIP_MEMORY_SCOPE_AGENT);
        t = (unsigned)__builtin_amdgcn_readfirstlane((int)t);
        if (t != (unsigned)(u.nsplit - 1)) return false;
        __builtin_amdgcn_fence(__ATOMIC_ACQUIRE, "agent"); asm volatile("s_waitcnt vmcnt(0)" ::: "memory");
#pragma unroll
        for (int i = 0; i < 8; ++i) { const u32x4 w = pack8(acc[0][(i >> 2) & 1][i & 3][0], acc[0][(i >> 2) & 1][i & 3][1]);
            acc[0][(i >> 2) & 1][i & 3][0] = (f32x4){__uint_as_float(w.x << 16), __uint_as_float(w.x & 0xffff0000u), __uint_as_float(w.y << 16), __uint_as_float(w.y & 0xffff0000u)};
            acc[0][(i >> 2) & 1][i & 3][1] = (f32x4){__uint_as_float(w.z << 16), __uint_as_float(w.z & 0xffff0000u), __uint_as_float(w.w << 16), __uint_as_float(w.w & 0xffff0000u)}; }
        const int MA_ = ((TA + 7) & ~7) * nsplit, rb = u.slab >= MA_ ? MA_ : 0, sr = u.slab - rb;
        const int xs = sr & 7, vs = sr >> 3, own = (G == 256) ? (vs % u.nsplit) : (sr % u.nsplit), base = rb + ((G == 256) ? xs + 8 * ((vs / u.nsplit) * u.nsplit) : sr - own), stride = (G == 256) ? 8 : 1;
        const float* p0 = slabs + (size_t)wid * 4096 + lane * 4;
        const int nq = u.nsplit - 1;
        u32x4 bA[8], bB[8];
#define SC_SLAB(q) (p0 + (size_t)(base + stride * ((q) < own ? (q) : (q) + 1)) * 32768)
#define SC_LOAD(dst, q) do { const float* p_ = SC_SLAB(q); _Pragma("unroll") for (int k = 0; k < 8; ++k) dst[k] = *(const u32x4*)(p_ + k * 256); } while (0)
#define SC_ADD(src) do { _Pragma("unroll") for (int k = 0; k < 8; ++k) { const u32x4 w = src[k]; \
            acc[0][(k >> 2) & 1][k & 3][0] += (f32x4){__uint_as_float(w.x << 16), __uint_as_float(w.x & 0xffff0000u), __uint_as_float(w.y << 16), __uint_as_float(w.y & 0xffff0000u)}; \
            acc[0][(k >> 2) & 1][k & 3][1] += (f32x4){__uint_as_float(w.z << 16), __uint_as_float(w.z & 0xffff0000u), __uint_as_float(w.w << 16), __uint_as_float(w.w & 0xffff0000u)}; } } while (0)
        SC_LOAD(bA, 0);
        for (int q = 0; q < nq; q += 2) {
            if (q + 1 < nq) { SC_LOAD(bB, q + 1); asm volatile("s_waitcnt vmcnt(8)" ::: "memory"); } else asm volatile("s_waitcnt vmcnt(0)" ::: "memory");
            SC_ADD(bA);
            if (q + 1 < nq) {
                if (q + 2 < nq) { SC_LOAD(bA, q + 2); asm volatile("s_waitcnt vmcnt(8)" ::: "memory"); } else asm volatile("s_waitcnt vmcnt(0)" ::: "memory");
                SC_ADD(bB);
            }
        }
#undef SC_SLAB
#undef SC_LOAD
#undef SC_ADD
        return true;
    }
};

template <class Epi, class Sched, bool ALIGN_EPI = false, bool SP2 = false>
__device__ __forceinline__ void gemm_phase(PG8_LAS unsigned char* lds, const Gemm g, const Sched& S, const Epi& E) {
    int tid_l = threadIdx.x; asm volatile("" : "+v"(tid_l));
    const int tid = tid_l, wid = __builtin_amdgcn_readfirstlane(tid >> 6), lane = tid & 63, wr = wid >> 2, wc = wid & 3, fr = lane & 15, fq = lane >> 4;
    const int K = g.K;
    unsigned voffA[2], voffB[2];
#pragma unroll
    for (int i = 0; i < 2; ++i) { int R, C; stage_rc(tid * 16 + i * 8192, R, C); const int Rb = Epi::PERM ? ((R & ~31) + perm32(R & 31)) : R;
        voffA[i] = (unsigned)(R * K + C) * 2u; voffB[i] = (unsigned)(Rb * K + C) * 2u; }
    const size_t kstep = (size_t)(BK * 2);
    const size_t hstep = (size_t)HALF * K * 2;
    const size_t tstep = 2 * hstep;
    const unsigned ldsw = (unsigned)wid * 1024u;
    const int aoff = lds_byte(wr * 64 + fr, fq * 8), boff = lds_byte(wc * 32 + fr, fq * 8);
#define PG8_SA(b, h) (((b) * 2 + (h)) * HTB)
#define PG8_SB(b, h) ((4 + (b) * 2 + (h)) * HTB)
#define PG8_STAGE(bufoff, gbase, voff) do { _Pragma("unroll") for (int _i = 0; _i < 2; ++_i) \
        __builtin_amdgcn_global_load_lds((const unsigned*)((const char*)(gbase) + (voff)[_i]), (PG8_LAS unsigned*)(lds + (bufoff) + ldsw + _i * 8192), 16, 0, 0); } while (0)
#define PG8_LDA(dst, b, h) do { _Pragma("unroll") for (int m = 0; m < 4; ++m) _Pragma("unroll") for (int k = 0; k < 2; ++k) dst[m][k] = *(const PG8_LAS bf16x8*)(lds + PG8_SA(b, h) + aoff + m * 2048 + k * 1024); } while (0)
#define PG8_LDB(dst, b, h) do { _Pragma("unroll") for (int n = 0; n < 2; ++n) _Pragma("unroll") for (int k = 0; k < 2; ++k) dst[n][k] = *(const PG8_LAS bf16x8*)(lds + PG8_SB(b, h) + boff + n * 2048 + k * 1024); } while (0)
#define PG8_MMA(ai, bj, At, Bt) do { __builtin_amdgcn_s_setprio(1); _Pragma("unroll") for (int m = 0; m < 4; ++m) _Pragma("unroll") for (int n = 0; n < 2; ++n) _Pragma("unroll") for (int k = 0; k < 2; ++k) \
        acc[ai][bj][m][n] = __builtin_amdgcn_mfma_f32_16x16x32_bf16(Bt[n][k], At[m][k], acc[ai][bj][m][n], 0, 0, 0); __builtin_amdgcn_s_setprio(0); } while (0)
#define PG8_WAIT_V(n) asm volatile("s_waitcnt vmcnt(" #n ")" ::: "memory")
#define PG8_WAIT_L(n) asm volatile("s_waitcnt lgkmcnt(" #n ")" ::: "memory")
#define PG8_BAR __builtin_amdgcn_s_barrier()
#define PG8_SCHED __builtin_amdgcn_sched_barrier(0)
    Unit cur, nxt; int ui = 0;
    if (!S.next(0, cur)) return;
    f32x4 acc[2][2][4][2];
#pragma unroll
    for (int a = 0; a < 2; ++a)
#pragma unroll
        for (int b = 0; b < 2; ++b)
#pragma unroll
            for (int m = 0; m < 4; ++m)
#pragma unroll
                for (int n = 0; n < 2; ++n) acc[a][b][m][n] = (f32x4){0.f, 0.f, 0.f, 0.f};
    bf16x8 At[4][2], B0[2][2], B1[2][2];
    const char* cA = (const char*)g.A + (size_t)cur.pm * hstep + (size_t)cur.kt0 * kstep; const char* cB = (const char*)g.Bt + (size_t)cur.pn * tstep + (size_t)cur.kt0 * kstep;
    S.a_ready(cur);
    if constexpr (SP2) {
        PG8_STAGE(PG8_SB(0, 0), cB, voffB); PG8_STAGE(PG8_SB(0, 1), cB + hstep, voffB); PG8_STAGE(PG8_SA(0, 0), cA, voffA); PG8_STAGE(PG8_SA(0, 1), cA + hstep, voffA);
        if (wr == 1) PG8_BAR;
        PG8_WAIT_V(2); PG8_BAR;
        PG8_STAGE(PG8_SB(1, 0), cB + kstep, voffB); PG8_STAGE(PG8_SA(1, 0), cA + kstep, voffA); PG8_STAGE(PG8_SB(1, 1), cB + hstep + kstep, voffB);
        PG8_WAIT_V(6); PG8_BAR;
    } else {
        PG8_STAGE(PG8_SB(0, 0), cB, voffB); PG8_STAGE(PG8_SA(0, 0), cA, voffA); PG8_STAGE(PG8_SB(0, 1), cB + hstep, voffB); PG8_STAGE(PG8_SA(0, 1), cA + hstep, voffA);
        if (wr == 1) PG8_BAR;
        PG8_WAIT_V(4); PG8_BAR;
        PG8_STAGE(PG8_SB(1, 0), cB + kstep, voffB); PG8_STAGE(PG8_SA(1, 0), cA + kstep, voffA); PG8_STAGE(PG8_SB(1, 1), cB + hstep + kstep, voffB);
        PG8_WAIT_V(6); PG8_BAR;
    }
    for (;;) {
        const bool has_next = S.next(ui + 1, nxt);
        const char* nA = has_next ? (const char*)g.A + (size_t)nxt.pm * hstep + (size_t)nxt.kt0 * kstep : cA; const char* nB = has_next ? (const char*)g.Bt + (size_t)nxt.pn * tstep + (size_t)nxt.kt0 * kstep : cB;
        const int nt = cur.nt;
        if (!cur.half) {
        for (int t = 0; t < nt; t += 2) {
            const bool last = (t == nt - 2);
            const char* a1 = cA + (size_t)(t + 1) * kstep;
            const char* a2 = last ? nA : cA + (size_t)(t + 2) * kstep; const char* b2 = last ? nB : cB + (size_t)(t + 2) * kstep;
            const char* a3 = a2 + kstep; const char* b3 = b2 + kstep;
            if (last && has_next) S.a_ready(nxt);
            if constexpr (SP2) {
            PG8_LDB(B0, 0, 0); PG8_LDB(B1, 0, 1); PG8_SCHED; PG8_LDA(At, 0, 0); PG8_STAGE(PG8_SA(1, 1), a1 + hstep, voffA);
            PG8_WAIT_V(8); PG8_WAIT_L(0); PG8_BAR; PG8_MMA(0, 0, At, B0); PG8_MMA(0, 1, At, B1); PG8_BAR; PG8_SCHED;
            PG8_LDA(At, 0, 1); PG8_STAGE(PG8_SB(0, 0), b2, voffB); PG8_STAGE(PG8_SB(0, 1), b2 + hstep, voffB); PG8_STAGE(PG8_SA(0, 0), a2, voffA);
            PG8_WAIT_V(8); PG8_WAIT_L(0); PG8_BAR; PG8_MMA(1, 0, At, B0); PG8_MMA(1, 1, At, B1); PG8_BAR; PG8_SCHED;
            PG8_LDB(B0, 1, 0); PG8_LDB(B1, 1, 1); PG8_SCHED; PG8_LDA(At, 1, 0); PG8_STAGE(PG8_SA(0, 1), a2 + hstep, voffA);
            PG8_WAIT_V(8); PG8_WAIT_L(0); PG8_BAR; PG8_MMA(0, 0, At, B0); PG8_MMA(0, 1, At, B1); PG8_BAR; PG8_SCHED;
            PG8_LDA(At, 1, 1); PG8_STAGE(PG8_SB(1, 0), b3, voffB); PG8_STAGE(PG8_SB(1, 1), b3 + hstep, voffB); PG8_STAGE(PG8_SA(1, 0), a3, voffA);
            PG8_WAIT_V(8); PG8_WAIT_L(0); PG8_BAR; PG8_MMA(1, 0, At, B0); PG8_MMA(1, 1, At, B1); PG8_BAR; PG8_SCHED;
            } else {
            PG8_LDB(B0, 0, 0); PG8_SCHED; PG8_LDA(At, 0, 0); PG8_STAGE(PG8_SA(1, 1), a1 + hstep, voffA);
            PG8_WAIT_L(8); PG8_BAR; PG8_WAIT_L(0); PG8_MMA(0, 0, At, B0); PG8_BAR; PG8_SCHED;
            PG8_LDB(B1, 0, 1); PG8_STAGE(PG8_SB(0, 0), b2, voffB);
            PG8_BAR; PG8_WAIT_L(0); PG8_MMA(0, 1, At, B1); PG8_BAR;
            PG8_LDA(At, 0, 1); PG8_STAGE(PG8_SA(0, 0), a2, voffA);
            PG8_BAR; PG8_WAIT_L(0); PG8_MMA(1, 0, At, B0); PG8_BAR; PG8_SCHED;
            PG8_STAGE(PG8_SB(0, 1), b2 + hstep, voffB);
            PG8_WAIT_V(6); PG8_BAR; PG8_MMA(1, 1, At, B1); PG8_BAR;
            PG8_LDB(B0, 1, 0); PG8_SCHED; PG8_LDA(At, 1, 0); PG8_STAGE(PG8_SA(0, 1), a2 + hstep, voffA);
            PG8_WAIT_L(8); PG8_BAR; PG8_WAIT_L(0); PG8_MMA(0, 0, At, B0); PG8_BAR; PG8_SCHED;
            PG8_LDB(B1, 1, 1); PG8_STAGE(PG8_SB(1, 0), b3, voffB);
            PG8_BAR; PG8_WAIT_L(0); PG8_MMA(0, 1, At, B1); PG8_BAR;
            PG8_LDA(At, 1, 1); PG8_STAGE(PG8_SA(1, 0), a3, voffA);
            PG8_BAR; PG8_WAIT_L(0); PG8_MMA(1, 0, At, B0); PG8_BAR; PG8_SCHED;
            PG8_STAGE(PG8_SB(1, 1), b3 + hstep, voffB);
            PG8_WAIT_V(6); PG8_BAR; PG8_MMA(1, 1, At, B1); PG8_BAR;
            }
        }
        if constexpr (ALIGN_EPI) { if (wr == 0) PG8_BAR; }
        E(acc, cur, wr, wc, fr, fq); S.done(cur);
        } else {
        for (int t = 0; t < nt; t += 2) {
            const bool last = (t == nt - 2);
            const char* a1 = cA + (size_t)(t + 1) * kstep;
            const char* a2 = last ? nA : cA + (size_t)(t + 2) * kstep; const char* b2 = last ? nB : cB + (size_t)(t + 2) * kstep;
            const char* a3 = a2 + kstep; const char* b3 = b2 + kstep;
            if (last && has_next) S.a_ready(nxt);
            if constexpr (SP2) {
            PG8_LDB(B0, 0, 0); PG8_LDB(B1, 0, 1); PG8_SCHED; PG8_LDA(At, 0, 0); PG8_STAGE(PG8_SA(1, 1), a1 + hstep, voffA);
            PG8_WAIT_V(8); PG8_WAIT_L(0); PG8_BAR; PG8_MMA(0, 0, At, B0); PG8_MMA(0, 1, At, B1); PG8_BAR; PG8_SCHED;
            PG8_STAGE(PG8_SB(0, 0), b2, voffB); PG8_STAGE(PG8_SB(0, 1), b2 + hstep, voffB); PG8_STAGE(PG8_SA(0, 0), a2, voffA);
            PG8_WAIT_V(8); PG8_WAIT_L(0); PG8_BAR; PG8_BAR; PG8_SCHED;
            PG8_LDB(B0, 1, 0); PG8_LDB(B1, 1, 1); PG8_SCHED; PG8_LDA(At, 1, 0); PG8_STAGE(PG8_SA(0, 1), a2 + hstep, voffA);
            PG8_WAIT_V(8); PG8_WAIT_L(0); PG8_BAR; PG8_MMA(0, 0, At, B0); PG8_MMA(0, 1, At, B1); PG8_BAR; PG8_SCHED;
            PG8_STAGE(PG8_SB(1, 0), b3, voffB); PG8_STAGE(PG8_SB(1, 1), b3 + hstep, voffB); PG8_STAGE(PG8_SA(1, 0), a3, voffA);
            PG8_WAIT_V(8); PG8_WAIT_L(0); PG8_BAR; PG8_BAR; PG8_SCHED;
            } else {
            PG8_LDB(B0, 0, 0); PG8_SCHED; PG8_LDA(At, 0, 0); PG8_STAGE(PG8_SA(1, 1), a1 + hstep, voffA);
            PG8_WAIT_L(8); PG8_BAR; PG8_WAIT_L(0); PG8_MMA(0, 0, At, B0); PG8_BAR; PG8_SCHED;
            PG8_LDB(B1, 0, 1); PG8_STAGE(PG8_SB(0, 0), b2, voffB);
            PG8_BAR; PG8_WAIT_L(0); PG8_MMA(0, 1, At, B1); PG8_BAR;
            PG8_STAGE(PG8_SA(0, 0), a2, voffA);
            PG8_BAR; PG8_WAIT_L(0); PG8_BAR; PG8_SCHED;
            PG8_STAGE(PG8_SB(0, 1), b2 + hstep, voffB);
            PG8_WAIT_V(6); PG8_BAR; PG8_BAR;
            PG8_LDB(B0, 1, 0); PG8_SCHED; PG8_LDA(At, 1, 0); PG8_STAGE(PG8_SA(0, 1), a2 + hstep, voffA);
            PG8_WAIT_L(8); PG8_BAR; PG8_WAIT_L(0); PG8_MMA(0, 0, At, B0); PG8_BAR; PG8_SCHED;
            PG8_LDB(B1, 1, 1); PG8_STAGE(PG8_SB(1, 0), b3, voffB);
            PG8_BAR; PG8_WAIT_L(0); PG8_MMA(0, 1, At, B1); PG8_BAR;
            PG8_STAGE(PG8_SA(1, 0), a3, voffA);
            PG8_BAR; PG8_WAIT_L(0); PG8_BAR; PG8_SCHED;
            PG8_STAGE(PG8_SB(1, 1), b3 + hstep, voffB);
            PG8_WAIT_V(6); PG8_BAR; PG8_BAR;
            }
        }
        if constexpr (ALIGN_EPI) { if (wr == 0) PG8_BAR; }
        { bool fin = true; if (cur.nsplit > 1) fin = S.split_combine(acc, cur, wid, lane); if (fin) E.half(acc, cur, wr, wc, fr, fq); S.done(cur); }
        }
        if (!has_next) break;
#pragma unroll
        for (int a = 0; a < 2; ++a)
#pragma unroll
            for (int b = 0; b < 2; ++b)
#pragma unroll
                for (int m = 0; m < 4; ++m)
#pragma unroll
                    for (int n = 0; n < 2; ++n) acc[a][b][m][n] = (f32x4){0.f, 0.f, 0.f, 0.f};
        cur = nxt; cA = nA; cB = nB; ++ui;
        if constexpr (ALIGN_EPI) { if (wr == 1) PG8_BAR; }
    }
    PG8_WAIT_V(0);
    if constexpr (!ALIGN_EPI) { if (wr == 0) PG8_BAR; }
    PG8_BAR;
    if constexpr (Epi::AFTER_DRAIN) { E.fused(acc, cur, wr, wc, fr, fq, lds, wid, lane); S.done(cur); }
#undef PG8_SA
#undef PG8_SB
#undef PG8_STAGE
#undef PG8_LDA
#undef PG8_LDB
#undef PG8_MMA
#undef PG8_WAIT_V
#undef PG8_WAIT_L
#undef PG8_BAR
#undef PG8_SCHED
}
}

#ifndef PG8_SP2
#define PG8_SP2 true
#endif
#ifndef PG8_ALIGN
#define PG8_ALIGN true
#endif
#ifndef MK_PER_PHASE
#define MK_PER_PHASE 0
#endif

#ifndef EN_P0
#define EN_P0 1
#endif
#ifndef EN_RG0
#define EN_RG0 1
#endif
#ifndef EN_RG1
#define EN_RG1 1
#endif
#ifndef EN_ATT
#define EN_ATT 1
#endif
#ifndef EN_GU
#define EN_GU 1
#endif
#ifndef EN_DN
#define EN_DN 1
#endif
#ifndef EN_WIN
#define EN_WIN 1
#endif
#ifndef EN_KV
#define EN_KV 1
#endif
#ifndef EN_Q
#define EN_Q 1
#endif
#ifndef EN_RES
#define EN_RES 1
#endif
constexpr int NWAVES = 8;
constexpr int DM = 2048, DFF = 5632, NHEAD = 16;
constexpr int MROWS = 16896;
constexpr int ROW_P0 = 16, ROW_S0 = 16400, ROWS_REAL = 16656;
constexpr int KS_ROWS = 2112;
constexpr float LAM_INIT = 0.3555090675909693f;
constexpr float LOG2E = 1.4426950408889634f;
constexpr int NPHASE = 17;
constexpr size_t O_YP = 0, O_YS = 33554432, O_KP = 34078720, O_VP = 67665920, O_CP = 101253120, O_HP = 101259264, O_KS = 101261312, O_VS = 101785600, O_CS = 102309888, O_HS = 102408192, O_END = 102440960;

constexpr size_t MiB = 1u << 20;
constexpr size_t WS_CTL = 0, CTL_ZERO_BYTES = 1 * MiB;
constexpr size_t WS_GW = 1 * MiB;
constexpr size_t WS_WGU = 2 * MiB;
constexpr size_t WS_WDN = 178 * MiB;
constexpr size_t WS_WIN = 266 * MiB, WS_WOUT = 282 * MiB, WS_WKV = 290 * MiB, WS_WQ = 306 * MiB, WS_WO = 314 * MiB;
constexpr size_t WS_X16 = 322 * MiB;
constexpr size_t WS_BIG = 388 * MiB;
constexpr size_t WS_ACT = 586 * MiB;
constexpr size_t WS_KP = 652 * MiB, WS_VP = 717 * MiB;
constexpr size_t WS_KS = 782 * MiB, WS_VS = 914 * MiB;
constexpr size_t WS_TS = 1046 * MiB;
constexpr size_t WS_SLAB = 1048 * MiB;
constexpr size_t WS_AB = 1112 * MiB;
constexpr size_t WS_END = 1244 * MiB;
constexpr int CW_TMO = 0, CW_ATTQ = 64, CW_SCONV = 256, CW_BAR = 4096;
constexpr size_t CTL_SSQ = 65536;
constexpr size_t CTL_SCNT = 524288;
static_assert(CTL_SSQ + 6 * (size_t)MROWS * 4 <= CTL_SCNT && CTL_SCNT + 17 * 128 * 8 * 4 <= CTL_ZERO_BYTES, "ctl");

constexpr int RING_OFF = 0, RING_BYTES = 131072;
constexpr int LDSCTL_OFF = RING_BYTES, MISC_OFF = LDSCTL_OFF + 320;
constexpr int LDS_BYTES = 147456;

#define GAS __attribute__((address_space(1)))
#define LAS __attribute__((address_space(3)))
typedef unsigned short bf16;
typedef unsigned v4u __attribute__((ext_vector_type(4)));
typedef unsigned v2u __attribute__((ext_vector_type(2)));
typedef float f32x4 __attribute__((ext_vector_type(4)));
typedef float f32x2 __attribute__((ext_vector_type(2)));
typedef float f32x16 __attribute__((ext_vector_type(16)));
typedef short bf16x8 __attribute__((ext_vector_type(8)));
typedef short s16x4 __attribute__((ext_vector_type(4)));
typedef GAS unsigned gu32;
#define RLX_AGENT __ATOMIC_RELAXED, __HIP_MEMORY_SCOPE_AGENT
#define LDS_WAIT() asm volatile("s_waitcnt lgkmcnt(0)" ::: "memory")
#define VM_WAIT() asm volatile("s_waitcnt vmcnt(0)" ::: "memory")
__device__ __forceinline__ unsigned pk2(float lo, float hi) { typedef __bf16 bf16x2_t __attribute__((ext_vector_type(2))); f32x2 v = {lo, hi}; bf16x2_t b = __builtin_convertvector(v, bf16x2_t); return __builtin_bit_cast(unsigned, b); }
__device__ __forceinline__ unsigned f2bf(float f) { return pk2(f, 0.f) & 0xffffu; }
__device__ __forceinline__ float bf2f(bf16 b) { return __builtin_bit_cast(float, ((unsigned)b) << 16); }
__device__ __forceinline__ float wave_sum(float v) {
#pragma unroll
    for (int o = 1; o < 64; o <<= 1) v += __shfl_xor(v, o);
    return v;
}

#define XB_TMO      128
#define XB_XCNT(j)  (256  + 64 * (j))
#define XB_XSUB(j)  (1280 + 64 * (j))
#define XB_XGEN(j)  (2304 + 64 * (j))
#define XB_TOP      3328
#define XB_TOPGEN   3392
#define XCD_BAR_WORDS 3456
#define XB_SPIN_CAP (1u << 18)

__device__ __forceinline__ unsigned xb_ld(unsigned* p)              { return __hip_atomic_load(p, __ATOMIC_RELAXED, __HIP_MEMORY_SCOPE_AGENT); }
__device__ __forceinline__ unsigned xb_add(unsigned* p, unsigned v) { return __hip_atomic_fetch_add(p, v, __ATOMIC_RELAXED, __HIP_MEMORY_SCOPE_AGENT); }
__device__ __forceinline__ unsigned xb_xcc_id() { return (unsigned)__builtin_amdgcn_s_getreg((3 << 11) | 20) & 0xFu; }
#define XB_SPIN(cond, bar) do { unsigned _sp = 0; while (cond) { __builtin_amdgcn_s_sleep(1); \
    if ((++_sp & 255u) == 0u) { if (xb_ld(&(bar)[XB_TMO])) break; if (_sp > XB_SPIN_CAP) { atomicAdd(&(bar)[XB_TMO], 1u); break; } } } } while (0)

struct XcdBarrier {
    unsigned* bar; unsigned x;
    volatile LAS unsigned* st;
};

__device__ __forceinline__ XcdBarrier xcd_barrier_post(unsigned* bar, volatile LAS unsigned* st) {
    XcdBarrier b; b.bar = bar; b.x = xb_xcc_id(); b.st = st;
    if (threadIdx.x == 0) (void)xb_add(&bar[XB_XCNT(b.x)], 1u);
    return b;
}
__device__ __forceinline__ void xcd_barrier_complete(unsigned* bar, unsigned x, unsigned& nloc, unsigned& nx) {
    const unsigned G = gridDim.x * gridDim.y * gridDim.z;
    unsigned sum, cnt, mine, sp = 0u;
    for (;;) {
        sum = 0u; cnt = 0u; mine = 0u;
#pragma unroll
        for (unsigned j = 0; j < 16; ++j) { const unsigned c = xb_ld(&bar[XB_XCNT(j)]); sum += c; cnt += (c > 0u) ? 1u : 0u; mine = (j == x) ? c : mine; }
        if (sum == G) break;
        __builtin_amdgcn_s_sleep(1);
        if ((++sp & 255u) == 0u) { if (xb_ld(&bar[XB_TMO])) break; if (sp > XB_SPIN_CAP) { atomicAdd(&bar[XB_TMO], 1u); break; } }
    }
    nloc = mine > 0u ? mine : 1u; nx = cnt > 0u ? cnt : 1u;
}

__device__ __forceinline__ void xcd_barrier(const XcdBarrier& b) {
    asm volatile("s_waitcnt vmcnt(0)" ::: "memory");
    __syncthreads();
    if (threadIdx.x == 0) {
        unsigned* bar = b.bar;
        __builtin_amdgcn_s_waitcnt(0);
        unsigned nloc = b.st[0], nx = b.st[1];
        if (nloc == 0u) { xcd_barrier_complete(bar, b.x, nloc, nx); b.st[0] = nloc; b.st[1] = nx; }
        const unsigned old = xb_add(&bar[XB_XSUB(b.x)], 1u);
        const unsigned gen = old / nloc;
        if (old + 1u == (gen + 1u) * nloc) {
            __builtin_amdgcn_fence(__ATOMIC_RELEASE, "agent");
            asm volatile("s_waitcnt vmcnt(0)" ::: "memory");
            const unsigned og = xb_add(&bar[XB_TOP], 1u);
            const unsigned tg = og / nx;
            if (og + 1u == (tg + 1u) * nx) xb_add(&bar[XB_TOPGEN], 1u);
            else XB_SPIN(xb_ld(&bar[XB_TOPGEN]) == tg, bar);
            __builtin_amdgcn_fence(__ATOMIC_ACQUIRE, "agent");
            xb_add(&bar[XB_XGEN(b.x)], 1u);
            asm volatile("s_waitcnt vmcnt(0)" ::: "memory");
        } else {
            XB_SPIN(xb_ld(&bar[XB_XGEN(b.x)]) == gen, bar);
            __builtin_amdgcn_fence(__ATOMIC_ACQUIRE, "agent");
            asm volatile("s_waitcnt vmcnt(0)" ::: "memory");
        }
    }
    __syncthreads();
}

struct Args { const float* in[28]; float* out; unsigned char* ws; int ph_lo, ph_hi; };
typedef const __attribute__((address_space(4))) Args CArgs;
__device__ __forceinline__ CArgs* largs() { CArgs* p = (CArgs*)__builtin_amdgcn_kernarg_segment_ptr(); asm volatile("" : "+s"(p)); return p; }
__device__ __forceinline__ int lbid() { int b = (int)blockIdx.x; asm volatile("" : "+s"(b)); return b; }
struct Frame {
    LAS unsigned char* lds;
    volatile LAS unsigned* MISC;
    int tid, lane, wave, G;
};
#define P_IN(i) (args.in[i])
#define P_WS(T, off) ((T*)(args.ws + (off)))
#define P_GW P_WS(bf16, WS_GW)
#define P_WGU P_WS(bf16, WS_WGU)
#define P_WDN P_WS(bf16, WS_WDN)
#define P_WIN P_WS(bf16, WS_WIN)
#define P_WOUT P_WS(bf16, WS_WOUT)
#define P_WKV P_WS(bf16, WS_WKV)
#define P_WQ P_WS(bf16, WS_WQ)
#define P_WO P_WS(bf16, WS_WO)
#define P_X16 P_WS(bf16, WS_X16)
#define P_HID P_WS(bf16, WS_BIG)
#define P_GG P_WS(bf16, WS_BIG)
#define P_XB P_WS(float, WS_BIG + 66 * MiB)
#define P_A3 P_WS(bf16, WS_BIG)
#define P_ACT P_WS(bf16, WS_ACT)
#define P_KP P_WS(bf16, WS_KP)
#define P_VP P_WS(bf16, WS_VP)
#define P_KS P_WS(bf16, WS_KS)
#define P_VS P_WS(bf16, WS_VS)
#define P_TS P_WS(float, WS_TS)
#define P_SSQ P_WS(float, CTL_SSQ)
#define P_CTL ((gu32*)(args.ws + WS_CTL))
#define P_SLAB P_WS(float, WS_SLAB)
#define P_SCNT ((unsigned*)(args.ws + CTL_SCNT))
#define P_OUT (args.out)
enum { I_XP = 0, I_XS, I_CK, I_CV, I_SCONV, I_SH, I_META, I_FNORM, I_WG, I_WU, I_WD, I_RGNORM, I_RGWIN, I_CONVW, I_CONVB, I_GATEW, I_GATEB, I_LAMBDA, I_RGWOUT, I_KVNORM, I_WKV, I_KNORM, I_ATTNNORM, I_WQ, I_QNORM, I_DLAM, I_SUBNORM, I_WOP };

__device__ __forceinline__ void cvt_item(const float* W, int ldw, int n0, int k0, const float* gain, bf16* dst, int K, LAS float* scr, int lane) {
    float wv[32];
#pragma unroll
    for (int i = 0; i < 32; ++i) wv[i] = W[(size_t)(k0 + 2 * i + (lane >> 5)) * ldw + n0 + (lane & 31)];
#pragma unroll
    for (int i = 0; i < 32; ++i) { const int kk = 2 * i + (lane >> 5); const float g = gain ? gain[k0 + kk] : 1.f; scr[kk * 33 + (lane & 31)] = wv[i] * g; }
    LDS_WAIT(); asm volatile("" ::: "memory");
    const int c = lane & 7;
#pragma unroll
    for (int j = 0; j < 4; ++j) { const int n = (lane >> 3) + 8 * j; const LAS float* s = scr + (8 * c) * 33 + n;
        v4u o; o.x = pk2(s[0 * 33], s[1 * 33]); o.y = pk2(s[2 * 33], s[3 * 33]); o.z = pk2(s[4 * 33], s[5 * 33]); o.w = pk2(s[6 * 33], s[7 * 33]);
        *(GAS v4u*)(dst + (size_t)n * K + 8 * c) = o; }
    LDS_WAIT(); asm volatile("" ::: "memory");
}
__device__ __forceinline__ int p64col(int beta) { return 256 * (beta >> 3) + 64 * (beta & 3) + 32 * ((beta >> 2) & 1); }
__device__ __forceinline__ void p0_prologue(const Frame& F, CArgs& args) {
    int tid_l = threadIdx.x; asm volatile("" : "+v"(tid_l));
    const int lane = tid_l & 63, wave = __builtin_amdgcn_readfirstlane(tid_l >> 6);
    LAS float* scr = (LAS float*)(F.lds + RING_OFF + wave * 16384);
    const int gw = lbid() * NWAVES + wave, NGW = F.G * NWAVES;
    constexpr int IT_GU = 32 * 352, IT_DN = 88 * 64, IT_44 = 32 * 128, IT_22 = 32 * 64, IT_GW = 32 * 8;
    constexpr int NIT = 4 * IT_GU + 4 * IT_DN + 2 * IT_44 + 3 * IT_22 + IT_GW;
    for (int it = gw; it < NIT; it += NGW) {
        int r = it;
        if (r < 4 * IT_GU) { const int f = r / IT_GU; r -= f * IT_GU; const int kb = r / 352, beta = r % 352, pn = beta >> 3, bj = (beta >> 2) & 1, jb = beta & 3;
            const float* src = (bj ? P_IN(I_WU) : P_IN(I_WG)) + (size_t)f * DM * DFF;
            cvt_item(src, DFF, 128 * pn + 32 * jb, 64 * kb, P_IN(I_FNORM) + f * DM, P_WGU + (size_t)f * 11264 * DM + (size_t)(32 * beta) * DM + 64 * kb, DM, scr, lane); continue; }
        r -= 4 * IT_GU;
        if (r < 4 * IT_DN) { const int f = r / IT_DN; r -= f * IT_DN; const int kb = r / 64, beta = r % 64;
            cvt_item(P_IN(I_WD) + (size_t)f * DFF * DM, DM, p64col(beta), 64 * kb, nullptr, P_WDN + (size_t)f * DM * DFF + (size_t)(32 * beta) * DFF + 64 * kb, DFF, scr, lane); continue; }
        r -= 4 * IT_DN;
        if (r < IT_44) { const int kb = r / 128, beta = r % 128; cvt_item(P_IN(I_RGWIN), 4096, p64col(beta), 64 * kb, P_IN(I_RGNORM), P_WIN + (size_t)(32 * beta) * DM + 64 * kb, DM, scr, lane); continue; }
        r -= IT_44;
        if (r < IT_44) { const int kb = r / 128, beta = r % 128; cvt_item(P_IN(I_WKV), 4096, p64col(beta), 64 * kb, P_IN(I_KVNORM), P_WKV + (size_t)(32 * beta) * DM + 64 * kb, DM, scr, lane); continue; }
        r -= IT_44;
        if (r < IT_22) { const int kb = r / 64, beta = r % 64; cvt_item(P_IN(I_RGWOUT), DM, p64col(beta), 64 * kb, nullptr, P_WOUT + (size_t)(32 * beta) * DM + 64 * kb, DM, scr, lane); continue; }
        r -= IT_22;
        if (r < IT_22) { const int kb = r / 64, beta = r % 64; cvt_item(P_IN(I_WQ), DM, p64col(beta), 64 * kb, P_IN(I_ATTNNORM), P_WQ + (size_t)(32 * beta) * DM + 64 * kb, DM, scr, lane); continue; }
        r -= IT_22;
        if (r < IT_22) { const int kb = r / 64, beta = r % 64; cvt_item(P_IN(I_WOP), DM, p64col(beta), 64 * kb, nullptr, P_WO + (size_t)(32 * beta) * DM + 64 * kb, DM, scr, lane); continue; }
        r -= IT_22;
        { const int mat = r >> 3, i8 = r & 7; cvt_item(P_IN(I_GATEW) + (size_t)mat * 16384, 128, 32 * (i8 & 3), 64 * (i8 >> 2), nullptr, P_GW + (size_t)mat * 16384 + (size_t)(32 * (i8 & 3)) * 128 + 64 * (i8 >> 2), 128, scr, lane); }
    }
    for (int m = gw; m < MROWS; m += NGW) {
        const float* src = m < ROW_P0 ? P_IN(I_META) + (size_t)m * DM : m < ROW_S0 ? P_IN(I_XP) + (size_t)(m - ROW_P0) * DM : m < ROWS_REAL ? P_IN(I_XS) + (size_t)(m - ROW_S0) * DM : nullptr;
        float s = 0.f;
#pragma unroll
        for (int j = 0; j < 4; ++j) {
            f32x4 a = (f32x4){0.f, 0.f, 0.f, 0.f}, b = a;
            if (src) { a = *(const GAS f32x4*)(src + 512 * j + 8 * lane); b = *(const GAS f32x4*)(src + 512 * j + 8 * lane + 4); }
            s += (a[0] * a[0] + a[1] * a[1]) + (a[2] * a[2] + a[3] * a[3]) + (b[0] * b[0] + b[1] * b[1]) + (b[2] * b[2] + b[3] * b[3]);
            v4u o; o.x = pk2(a[0], a[1]); o.y = pk2(a[2], a[3]); o.z = pk2(b[0], b[1]); o.w = pk2(b[2], b[3]);
            *(GAS v4u*)(P_X16 + (size_t)m * DM + 512 * j + 8 * lane) = o;
        }
        s = wave_sum(s);
        if (lane == 0) P_SSQ[m] = s;
    }
}

constexpr int RG_XC = 0, RG_G = 17408, RG_SQ = RG_G + 2 * 64 * 528, RG_XCS = 272, RG_GS = 528;
template <int MODE> __device__ __forceinline__ void rg_phase(const Frame& F, CArgs& args) {
    LAS unsigned char* L = F.lds + RING_OFF;
    int tid_l = threadIdx.x; asm volatile("" : "+v"(tid_l));
    const int tid = tid_l, lane = tid & 63, wave = __builtin_amdgcn_readfirstlane(tid >> 6);
    const int c = tid & 127, q = tid >> 7, fr = lane & 15, fq = lane >> 4, k2 = wave >> 2, dq = wave & 3;
    const float* XB = P_XB;
    unsigned* AB = (unsigned*)(args.ws + WS_AB);
    for (int uidx = lbid(); uidx < 81 * 16; uidx += F.G) {
        int tl, n;
        if (uidx < 1024) { tl = 1 + (uidx >> 4); n = uidx & 15; } else { const int v = uidx - 1024; n = v & 15; const int t2 = v >> 4; tl = t2 == 0 ? 0 : 64 + t2; }
        const bool smp = tl >= 65; const int b = tl - 65;
        const bool full = !smp && tl != 0;
        const int row0 = smp ? ROW_S0 + 16 * b : (tl == 0 ? 0 : 16 + 256 * (tl - 1));
        const int nsub = full ? 4 : 1, nmb = full ? 4 : 1, nq = full ? 4 : 1;
        const int ch = n * 128 + c;
        const bool act = q < nq;
        if (MODE == 0) {
            const float cw0 = P_IN(I_CONVW)[ch], cw1 = P_IN(I_CONVW)[2048 + ch], cw2 = P_IN(I_CONVW)[4096 + ch], cw3 = P_IN(I_CONVW)[6144 + ch], cb = P_IN(I_CONVB)[ch];
            const float lam = P_IN(I_LAMBDA)[ch];
            const float ls8 = -8.0f * LOG2E * log1pf(__expf(-lam));
            bf16x8 Bw[2][4]; f32x4 gb[2];
            { const bf16* gwp = P_GW + ((size_t)(k2 * 16 + n) * 128 + 32 * dq + fr) * 128 + 8 * fq;
#pragma unroll
              for (int nb = 0; nb < 2; ++nb) {
#pragma unroll
                  for (int ks = 0; ks < 4; ++ks) Bw[nb][ks] = *(const GAS bf16x8*)(gwp + (size_t)(16 * nb) * 128 + 32 * ks);
                  gb[nb] = *(const GAS f32x4*)(P_IN(I_GATEB) + k2 * 2048 + n * 128 + 32 * dq + 16 * nb + 4 * fq); } }
            float At = 1.f, Bt = 0.f;
            float vn[19];
#define RG_LOADV(dst, ss) do { _Pragma("unroll") for (int j = 0; j < 19; ++j) { const int T = 64 * (ss) + 16 * q - 3 + j; float x = 0.f; \
                if (act) { if (smp) x = T >= 0 ? XB[(size_t)(row0 + T) * DM + ch] : P_IN(I_SCONV)[((size_t)b * 3 + 3 + T) * DM + ch]; \
                           else { const int g = row0 + T; x = g >= 0 ? XB[(size_t)g * DM + ch] : 0.f; } } \
                dst[j] = x; } } while (0)
            RG_LOADV(vn, 0);
            for (int s = 0; s < nsub; ++s) {
                float xc[16], v[19];
                const int T0 = 64 * s + 16 * q;
#pragma unroll
                for (int j = 0; j < 19; ++j) v[j] = vn[j];
                if (s + 1 < nsub) RG_LOADV(vn, s + 1);
#pragma unroll
                for (int i = 0; i < 16; ++i) { xc[i] = cb + cw0 * v[i] + cw1 * v[i + 1] + cw2 * v[i + 2] + cw3 * v[i + 3];
                    if (act) *(LAS bf16*)(L + RG_XC + (16 * q + i) * RG_XCS + 2 * c) = (bf16)f2bf(xc[i]); }
                __syncthreads();
#pragma unroll
                for (int m = 0; m < 4; ++m) {
                    if (m < nmb) {
                        f32x4 acc0 = (f32x4){0.f, 0.f, 0.f, 0.f}, acc1 = acc0;
#pragma unroll
                        for (int ks = 0; ks < 4; ++ks) { const bf16x8 a = *(const LAS bf16x8*)(L + RG_XC + (16 * m + fr) * RG_XCS + 64 * ks + 16 * fq);
                            acc0 = __builtin_amdgcn_mfma_f32_16x16x32_bf16(Bw[0][ks], a, acc0, 0, 0, 0); acc1 = __builtin_amdgcn_mfma_f32_16x16x32_bf16(Bw[1][ks], a, acc1, 0, 0, 0); }
                        f32x4 g0, g1;
#pragma unroll
                        for (int e = 0; e < 4; ++e) { g0[e] = pg8::fast_sigmoid(acc0[e] + gb[0][e]); g1[e] = pg8::fast_sigmoid(acc1[e] + gb[1][e]); }
                        LAS unsigned char* gp = L + RG_G + k2 * (64 * RG_GS) + (16 * m + fr) * RG_GS + (32 * dq + 4 * fq) * 4;
                        *(LAS f32x4*)gp = g0; *(LAS f32x4*)(gp + 64) = g1;
                    }
                }
                __syncthreads();
                float A = 1.f, B = 0.f;
#pragma unroll
                for (int i = 0; i < 16; ++i) {
                    if (act) { const float r = *(const LAS float*)(L + RG_G + (16 * q + i) * RG_GS + 4 * c), ig = *(const LAS float*)(L + RG_G + 64 * RG_GS + (16 * q + i) * RG_GS + 4 * c);
                        const float a = __builtin_amdgcn_exp2f(r * ls8), bb = __builtin_sqrtf(fmaxf(1.f - a * a, 0.f)) * (ig * xc[i]);
                        const unsigned w = pk2(1.f - a, bb);
                        const int T = T0 + i; const size_t row = (size_t)(row0 + T);
                        AB[row * DM + ch] = w;
                        const float ar = 1.f - __uint_as_float(w << 16), br = __uint_as_float(w & 0xffff0000u);
                        A *= ar; B = ar * B + br;
                        if (smp) { if (T >= 13) P_OUT[O_CS + ((size_t)b * 3 + (T - 13)) * DM + ch] = v[i + 3]; }
                        else { if (row >= 16397) P_OUT[O_CP + (row - 16397) * DM + ch] = v[i + 3]; }
                    }
                }
                *(LAS f32x2*)(L + RG_SQ + (q * 128 + c) * 8) = (f32x2){A, B};
                __syncthreads();
                float As = 1.f, Bs = 0.f;
#pragma unroll
                for (int qq = 0; qq < 4; ++qq) { const f32x2 sq = *(const LAS f32x2*)(L + RG_SQ + (qq * 128 + c) * 8); Bs = sq.x * Bs + sq.y; As *= sq.x; }
                Bt = As * Bt + Bs; At = As * At;
            }
            if (q == 0 && !smp) *(GAS f32x2*)(P_TS + ((size_t)tl * 2048 + ch) * 2) = (f32x2){At, Bt};
#undef RG_LOADV
        } else {
            float hc = 0.f;
            if (smp) hc = P_IN(I_SH)[b * 2048 + ch];
            else {
                float As = 1.f, Bs = 0.f;
#pragma unroll
                for (int hb = 0; hb < 2; ++hb) { f32x2 ab[8];
#pragma unroll
                    for (int k = 0; k < 8; ++k) { const int i = 16 * q + 8 * hb + k; ab[k] = i < tl ? *(const GAS f32x2*)(P_TS + ((size_t)i * 2048 + ch) * 2) : (f32x2){1.f, 0.f}; }
#pragma unroll
                    for (int k = 0; k < 8; ++k) { Bs = ab[k].x * Bs + ab[k].y; As *= ab[k].x; } }
                *(LAS f32x2*)(L + RG_SQ + (q * 128 + c) * 8) = (f32x2){As, Bs};
                __syncthreads();
#pragma unroll
                for (int qq = 0; qq < 4; ++qq) { const f32x2 sg = *(const LAS f32x2*)(L + RG_SQ + (qq * 128 + c) * 8); hc = sg.x * hc + sg.y; }
                __syncthreads();
            }
            unsigned wn[16]; unsigned short gn[16];
#define RG_LOADAB(ss) do { _Pragma("unroll") for (int i = 0; i < 16; ++i) { const size_t row = (size_t)(row0 + 64 * (ss) + 16 * q + i); wn[i] = act ? AB[row * DM + ch] : 0u; gn[i] = act ? P_GG[row * DM + ch] : (unsigned short)0; } } while (0)
            RG_LOADAB(0);
            for (int s = 0; s < nsub; ++s) {
                unsigned w[16]; unsigned short gg[16];
#pragma unroll
                for (int i = 0; i < 16; ++i) { w[i] = wn[i]; gg[i] = gn[i]; }
                if (s + 1 < nsub) RG_LOADAB(s + 1);
                const int T0 = 64 * s + 16 * q;
                float A = 1.f, B = 0.f;
#pragma unroll
                for (int i = 0; i < 16; ++i) { const float ar = 1.f - __uint_as_float(w[i] << 16), br = __uint_as_float(w[i] & 0xffff0000u); A *= ar; B = ar * B + br; }
                *(LAS f32x2*)(L + RG_SQ + (q * 128 + c) * 8) = (f32x2){A, B};
                __syncthreads();
                float h = hc, hn = hc;
#pragma unroll
                for (int qq = 0; qq < 4; ++qq) { const f32x2 sq = *(const LAS f32x2*)(L + RG_SQ + (qq * 128 + c) * 8); if (qq < q) h = sq.x * h + sq.y; hn = sq.x * hn + sq.y; }
                hc = hn;
                __syncthreads();
                if (act) {
#pragma unroll
                    for (int i = 0; i < 16; ++i) {
                        const float ar = 1.f - __uint_as_float(w[i] << 16), br = __uint_as_float(w[i] & 0xffff0000u);
                        h = ar * h + br;
                        const int T = T0 + i; const size_t row = (size_t)(row0 + T);
                        P_ACT[row * DM + ch] = (bf16)f2bf(bf2f(gg[i]) * h);
                        if (smp) { if (T == 15) P_OUT[O_HS + (size_t)b * DM + ch] = h; }
                        else { if (row == 16399) P_OUT[O_HP + ch] = h; }
                    }
                }
            }
#undef RG_LOADAB
        }
    }
}

namespace att {
typedef __attribute__((address_space(3))) const char* lcp;
constexpr int KSLOT = 16384, VRING = 65536, STG_OFF = 65536, STG_ROW = 272;
__device__ __forceinline__ int crow(int r, int hi) { return (r & 3) + 8 * (r >> 2) + 4 * hi; }
__device__ __forceinline__ void glds16(const void* gsrc, unsigned lds_dst) { unsigned keep;
    asm volatile("s_mov_b32 %0, m0\n\ts_mov_b32 m0, %2\n\ts_nop 0\n\tglobal_load_lds_dwordx4 %1, off\n\ts_mov_b32 m0, %0" : "=&s"(keep) : "v"(gsrc), "s"(lds_dst) : "memory"); }
__device__ __forceinline__ s16x4 vtr(lcp p) { typedef short v4i16_t __attribute__((ext_vector_type(4))); return __builtin_bit_cast(s16x4, __builtin_amdgcn_ds_read_tr16_b64_v4i16((__attribute__((address_space(3))) v4i16_t*)p)); }
__device__ __forceinline__ unsigned cvtpk(float lo, float hi) { typedef __bf16 bf16x2_t __attribute__((ext_vector_type(2))); f32x2 v = {lo, hi}; bf16x2_t b = __builtin_convertvector(v, bf16x2_t); return __builtin_bit_cast(unsigned, b); }
#define ATT_WAIT_BAR(N) asm volatile("s_waitcnt vmcnt(" #N ") lgkmcnt(0)\n\ts_barrier" ::: "memory")
struct UnitDesc { const bf16* Kb; const bf16* Vb; int qrow0, kb0, NT, NTF, h, sample, nvalid, dyn; float mref; };

template <int THR> __device__ __forceinline__ void attn_unit_s(LAS unsigned char* lds, const bf16* Q, bf16* O, const UnitDesc U, const float slope2, const float lam, const float* subg) {
    int tid_l = threadIdx.x; asm volatile("" : "+v"(tid_l));
    const int tid = tid_l, lane = tid & 63, r32 = lane & 31, hi = lane >> 5; const int wid = __builtin_amdgcn_readfirstlane(tid >> 6), rg = wid & 3, cc = wid >> 2;
    const unsigned lds0 = (unsigned)(uintptr_t)lds;
    const lcp L3 = (lcp)lds;
    const int qrow = U.qrow0 + (U.sample ? 0 : 32 * rg) + r32;
    const int qpos = U.sample ? 2064 + r32 : qrow;
    const int t_first = U.sample ? 0 : 1 - (rg >> 1);
    const bool wactive = U.sample ? (rg == 0) : true;
    const int NT = U.NT;
    const int kkey0 = 8 * wid + (lane >> 4);
    const bf16* ksrc = U.Kb + (size_t)kkey0 * DM + U.h * 128 + (((lane & 15) ^ (kkey0 & 15)) * 8);
    const bf16* ksrc2 = U.Kb + (size_t)(kkey0 + 4) * DM + U.h * 128 + (((lane & 15) ^ ((kkey0 + 4) & 15)) * 8);
    const bf16* vsrc = U.Vb + (size_t)(32 * (wid & 1) + (lane >> 2)) * DM + U.h * 128 + (wid >> 1) * 32 + (lane & 3) * 8;
    const unsigned kdst = lds0 + 2048u * (unsigned)wid, vdst = lds0 + VRING + 2048u * (unsigned)wid;
#define ATT_DMA_K(t) do { int kb_ = U.kb0 - 64 * (t); kb_ = kb_ < 0 ? 0 : kb_; const size_t ro_ = (size_t)kb_ * DM; const unsigned so_ = (unsigned)(((t) & 3) * KSLOT); \
        glds16(ksrc + ro_, (unsigned)__builtin_amdgcn_readfirstlane(kdst + so_)); glds16(ksrc2 + ro_, (unsigned)__builtin_amdgcn_readfirstlane(kdst + so_ + 1024u)); } while (0)
#define ATT_DMA_V(t) do { int kb_ = U.kb0 - 64 * (t); kb_ = kb_ < 0 ? 0 : kb_; const size_t ro_ = (size_t)kb_ * DM; const unsigned so_ = (unsigned)(((t) & 3) * KSLOT); \
        glds16(vsrc + ro_, (unsigned)__builtin_amdgcn_readfirstlane(vdst + so_)); glds16(vsrc + ro_ + 16 * DM, (unsigned)__builtin_amdgcn_readfirstlane(vdst + so_ + 1024u)); } while (0)
    bf16x8 qf[4];
    { const bf16* qp = Q + (size_t)qrow * DM + U.h * 128 + cc * 64 + hi * 8;
#pragma unroll
      for (int d0 = 0; d0 < 4; ++d0) qf[d0] = *(const GAS bf16x8*)(qp + d0 * 16); }
    asm volatile("s_waitcnt vmcnt(0)" ::: "memory");
    ATT_DMA_K(0); ATT_DMA_V(0);
    if (NT > 1) { ATT_DMA_K(1); ATT_DMA_V(1); }
    if (NT > 2) ATT_DMA_K(2);
    const bool dyn = U.dyn != 0;
    float m = dyn ? 0.f : U.mref, l = 0.f; bool first = dyn;
    f32x16 o[4];
#pragma unroll
    for (int d = 0; d < 4; ++d)
#pragma unroll
        for (int r = 0; r < 16; ++r) o[d][r] = 0.f;
    f32x16 pA0, pA1; v4u pw[4];
#define ATT_QK(tt, P0, P1) do { int kb = U.kb0 - 64 * (tt); kb = kb < 0 ? 0 : kb; \
        const bool gen = ((tt) == t_first) || (!U.sample && (tt) == U.NTF - 1); \
        if (gen) { const int vhi = (!U.sample && (tt) == U.NTF - 1) ? 16 : (U.sample ? 2080 : (1 << 30)); \
            _Pragma("unroll") for (int r = 0; r < 16; ++r) { const int kp = kb + crow(r, hi); \
                P0[r] = kp < vhi ? -slope2 * __builtin_fabsf((float)(qpos - kp)) - m : -INFINITY; \
                P1[r] = kp + 32 < vhi ? -slope2 * __builtin_fabsf((float)(qpos - kp - 32)) - m : -INFINITY; } \
        } else { const float tb = slope2 * (float)(kb + 4 * hi - qpos) - m; \
            const float s8_ = 8.0f * slope2, s32_ = 32.0f * slope2; \
            _Pragma("unroll") for (int r = 0; r < 16; ++r) { P0[r] = (r == 0) ? tb : ((r & 3) == 0 ? P0[r - 4] + s8_ : P0[r - 1] + slope2); P1[r] = P0[r] + s32_; } } \
        const lcp kp_ = L3 + (unsigned)(((tt) & 3) * KSLOT) + r32 * 256; \
        _Pragma("unroll") for (int d0 = 0; d0 < 4; ++d0) { const int po_ = ((8 * cc + 2 * d0 + hi) ^ (r32 & 15)) * 16; const bf16x8 a0 = *(const LAS bf16x8*)(kp_ + po_), a1 = *(const LAS bf16x8*)(kp_ + po_ + 32 * 256); \
            P0 = __builtin_amdgcn_mfma_f32_32x32x16_bf16(a0, qf[d0], P0, 0, 0, 0); P1 = __builtin_amdgcn_mfma_f32_32x32x16_bf16(a1, qf[d0], P1, 0, 0, 0); } } while (0)
#define ATT_PV(tt) do { const lcp vp = L3 + VRING + (unsigned)(((tt) & 3) * KSLOT) + (4 * hi + ((lane & 15) >> 2)) * 64 + ((lane >> 4) & 1) * 32 + (lane & 3) * 8; \
        _Pragma("unroll") for (int db = 0; db < 4; ++db) { if (db == 2) __builtin_amdgcn_sched_barrier(0); \
            _Pragma("unroll") for (int ks = 0; ks < 4; ++ks) { const s16x4 lo = vtr(vp + (db * 4 + ks) * 1024), hh = vtr(vp + (db * 4 + ks) * 1024 + 512); \
                const bf16x8 a = (bf16x8){lo[0], lo[1], lo[2], lo[3], hh[0], hh[1], hh[2], hh[3]}; \
                o[db] = __builtin_amdgcn_mfma_f32_32x32x16_bf16(a, __builtin_bit_cast(bf16x8, pw[ks]), o[db], 0, 0, 0); } } \
        __builtin_amdgcn_sched_barrier(0); } while (0)
#define ATT_STEP(t, PC0, PC1) do { \
        { const int nw_ = (((t) + 2 < NT) ? 2 : 0) + (((t) + 1 < NT) ? 2 : 0); if (nw_ == 4) { ATT_WAIT_BAR(4); } else if (nw_ == 2) { ATT_WAIT_BAR(2); } else { ATT_WAIT_BAR(0); } } \
        if ((t) + 3 < NT) ATT_DMA_K((t) + 3); \
        if ((t) + 2 < NT) ATT_DMA_V((t) + 2); \
        if (pvpend) { ATT_PV((t) - 1); pvpend = false; } \
        if (wactive && (t) >= t_first) { \
            ATT_QK(t, PC0, PC1); \
            if (dyn) { \
                float mx = __builtin_fmaxf(PC0[0], PC1[0]); \
                _Pragma("unroll") for (int r = 1; r < 16; ++r) mx = __builtin_fmaxf(mx, __builtin_fmaxf(PC0[r], PC1[r])); \
                { auto rr = __builtin_amdgcn_permlane32_swap(__float_as_uint(mx), __float_as_uint(mx), false, false); mx = __builtin_fmaxf(__uint_as_float(rr[0]), __uint_as_float(rr[1])); } \
                if (first || __any(mx > (float)THR)) { \
                    const float dl = first ? mx : __builtin_fmaxf(mx, 0.f); m += dl; \
                    _Pragma("unroll") for (int r = 0; r < 16; ++r) { PC0[r] -= dl; PC1[r] -= dl; } \
                    if (!first) { const float f = __builtin_amdgcn_exp2f(-dl); l *= f; \
                        _Pragma("unroll") for (int d = 0; d < 4; ++d) _Pragma("unroll") for (int r = 0; r < 16; ++r) o[d][r] *= f; } \
                    first = false; } } \
            float sacc = 0.f; \
            _Pragma("unroll") for (int r = 0; r < 16; ++r) { PC0[r] = __builtin_amdgcn_exp2f(PC0[r]); PC1[r] = __builtin_amdgcn_exp2f(PC1[r]); sacc += PC0[r] + PC1[r]; } \
            l += sacc; \
            _Pragma("unroll") for (int j = 0; j < 4; ++j) { pw[0][j] = cvtpk(PC0[2 * j], PC0[2 * j + 1]); pw[1][j] = cvtpk(PC0[8 + 2 * j], PC0[8 + 2 * j + 1]); pw[2][j] = cvtpk(PC1[2 * j], PC1[2 * j + 1]); pw[3][j] = cvtpk(PC1[8 + 2 * j], PC1[8 + 2 * j + 1]); } \
            if (cc == 0) { ATT_PV(t); } else pvpend = true; \
        } } while (0)
    if (NT > 2) { ATT_WAIT_BAR(6); } else if (NT > 1) { ATT_WAIT_BAR(4); } else { ATT_WAIT_BAR(0); }
    bool pvpend = false;
    for (int t = 0; t < NT; ++t) ATT_STEP(t, pA0, pA1);
    if (pvpend) ATT_PV(NT - 1);
#undef ATT_QK
#undef ATT_PV
#undef ATT_STEP
    { auto rr = __builtin_amdgcn_permlane32_swap(__float_as_uint(l), __float_as_uint(l), false, false); l = __uint_as_float(rr[0]) + __uint_as_float(rr[1]); }
    ATT_WAIT_BAR(0);
    const float inv = 1.0f / l;
    if (wactive && cc == 1) { const float sc = inv * lam;
#pragma unroll
        for (int db = 0; db < 4; ++db)
#pragma unroll
            for (int r = 0; r < 16; ++r) *(LAS float*)(lds + rg * 16384 + ((db * 16 + r) * 64 + lane) * 4) = o[db][r] * sc; }
    ATT_WAIT_BAR(0);
    if (wactive && cc == 0) {
        float ss = 0.f;
#pragma unroll
        for (int db = 0; db < 4; ++db)
#pragma unroll
            for (int r = 0; r < 16; ++r) { const float x = *(const LAS float*)(lds + rg * 16384 + ((db * 16 + r) * 64 + lane) * 4); const float d = o[db][r] * inv - x; o[db][r] = d; ss += d * d; }
        { auto rr = __builtin_amdgcn_permlane32_swap(__float_as_uint(ss), __float_as_uint(ss), false, false); ss = __uint_as_float(rr[0]) + __uint_as_float(rr[1]); }
        const float rs = __builtin_amdgcn_rsqf(ss * (1.0f / 128.0f) + 1e-6f) * (1.0f - LAM_INIT);
        LAS unsigned char* stg = lds + STG_OFF + rg * (32 * STG_ROW);
#pragma unroll
        for (int db = 0; db < 4; ++db)
#pragma unroll
            for (int rq = 0; rq < 4; ++rq) { const int dv = 32 * db + 8 * rq + 4 * hi; const f32x4 g = *(const GAS f32x4*)(subg + dv);
                v2u w; w.x = cvtpk(o[db][4 * rq] * rs * g[0], o[db][4 * rq + 1] * rs * g[1]); w.y = cvtpk(o[db][4 * rq + 2] * rs * g[2], o[db][4 * rq + 3] * rs * g[3]);
                *(LAS v2u*)(stg + r32 * STG_ROW + dv * 2) = w; }
        asm volatile("s_waitcnt lgkmcnt(0)" ::: "memory");
        bf16* Ow = O + (size_t)(U.qrow0 + (U.sample ? 0 : 32 * rg)) * DM + U.h * 128;
#pragma unroll
        for (int it = 0; it < 8; ++it) { const int row = it * 4 + (lane >> 4), chk = lane & 15; const v4u vv = *(const LAS v4u*)(stg + row * STG_ROW + chk * 16);
            if (row < U.nvalid) *(GAS v4u*)(Ow + (size_t)row * DM + chk * 8) = vv; }
    }
    asm volatile("s_waitcnt vmcnt(0)" ::: "memory");
    ATT_WAIT_BAR(0);
#undef ATT_DMA_K
#undef ATT_DMA_V
}
__device__ __forceinline__ void attn_unit_p(LAS unsigned char* lds, const bf16* Q, bf16* O, const UnitDesc U, const float slope2, volatile LAS unsigned* lamp, const float* subg) {
    int tid_l = threadIdx.x; asm volatile("" : "+v"(tid_l));
    const int tid = tid_l, lane = tid & 63, r32 = lane & 31, hi = lane >> 5; const int wid = __builtin_amdgcn_readfirstlane(tid >> 6);
    const unsigned lds0 = (unsigned)(uintptr_t)lds;
    const lcp L3 = (lcp)lds;
    const int qpos = U.qrow0 + 32 * wid + r32;
    const int t_first = 3 - (wid >> 1);
    const int NT = U.NT;
    const int kkey0 = 8 * wid + (lane >> 4);
    const bf16* ksrc = U.Kb + (size_t)kkey0 * DM + U.h * 128 + (((lane & 15) ^ (kkey0 & 15)) * 8);
    const int kd2 = 4 * DM + (((((lane & 15) ^ (kkey0 & 15)) & 4) != 0) ? -32 : 32);
    const bf16* vsrc = U.Vb + (size_t)(32 * (wid & 1) + (lane >> 2)) * DM + U.h * 128 + (wid >> 1) * 32 + (lane & 3) * 8;
    const unsigned kxo = (unsigned)(r32 * 256 + ((hi ^ (r32 & 15)) * 16));
    const unsigned kdst = lds0 + 2048u * (unsigned)wid, vdst = lds0 + 32768u + 2048u * (unsigned)wid;
#define ATT_DMA2(t) do { int kb_ = U.kb0 - 64 * (t); kb_ = kb_ < 0 ? 0 : kb_; const size_t ro_ = (size_t)kb_ * DM; const unsigned so_ = (unsigned)(((t) & 1) * KSLOT); \
        glds16(ksrc + ro_, (unsigned)__builtin_amdgcn_readfirstlane(kdst + so_)); glds16(ksrc + ro_ + kd2, (unsigned)__builtin_amdgcn_readfirstlane(kdst + so_ + 1024u)); \
        glds16(vsrc + ro_, (unsigned)__builtin_amdgcn_readfirstlane(vdst + so_)); glds16(vsrc + ro_ + 16 * DM, (unsigned)__builtin_amdgcn_readfirstlane(vdst + so_ + 1024u)); } while (0)
    const lcp qb_ = L3 + 65536 + wid * 8192 + lane * 16;
    { const bf16* qp = Q + (size_t)qpos * DM + U.h * 128 + hi * 8;
      bf16x8 qv[8];
#pragma unroll
      for (int f = 0; f < 8; ++f) qv[f] = *(const GAS bf16x8*)(qp + (f >> 2) * 64 + (f & 3) * 16);
#pragma unroll
      for (int f = 0; f < 8; ++f) *(LAS bf16x8*)(lds + 65536 + wid * 8192 + f * 1024 + lane * 16) = qv[f]; }
    asm volatile("s_waitcnt vmcnt(0) lgkmcnt(0)" ::: "memory");
    ATT_DMA2(0);
    const float mref = U.mref < 60.0f ? U.mref : 60.0f;
    f32x2 l0v = (f32x2){0.f, 0.f}, l1v = l0v;
    f32x16 o[2][4];
#pragma unroll
    for (int c = 0; c < 2; ++c)
#pragma unroll
        for (int d = 0; d < 4; ++d)
#pragma unroll
            for (int r = 0; r < 16; ++r) o[c][d][r] = 0.f;
    ATT_WAIT_BAR(0);
    for (int t = 0; t < NT; ++t) {
        if (t + 1 < NT) ATT_DMA2(t + 1);
        if (t >= t_first) {
            int kb = U.kb0 - 64 * t; kb = kb < 0 ? 0 : kb;
            const bool gen = (t == t_first) || (t == U.NTF - 1);
            const int vhi = (t == U.NTF - 1) ? 16 : (1 << 30);
            unsigned kxt = kxo + (unsigned)((t & 1) * KSLOT); asm volatile("" : "+v"(kxt));
            const lcp vp = L3 + 32768 + (unsigned)((t & 1) * KSLOT) + (4 * hi + ((lane & 15) >> 2)) * 64 + ((lane >> 4) & 1) * 32 + (lane & 3) * 8;
#pragma unroll
            for (int hf = 0; hf < 2; ++hf) {
                v4u pw[2][2];
#pragma unroll
                for (int c = 0; c < 2; ++c) {
                    f32x16 pp;
                    { const float tb = slope2 * (float)(kb + 32 * hf + 4 * hi - qpos), s8_ = 8.0f * slope2;
                      if (gen) {
                          const int thr = vhi - kb - 32 * hf - 4 * hi; float x = tb;
#pragma unroll
                          for (int r = 0; r < 16; ++r) { const int cr = (r & 3) + 8 * (r >> 2); x = (r == 0) ? tb : ((r & 3) == 0 ? x + (s8_ - 3.0f * slope2) : x + slope2); pp[r] = cr < thr ? -__builtin_fabsf(x) - mref : -INFINITY; }
                      } else { const float tb2 = tb - mref;
                          f32x2 b01 = (f32x2){tb2, tb2 + slope2}, b23 = b01 + (f32x2){2.0f * slope2, 2.0f * slope2};
#pragma unroll
                          for (int q4 = 0; q4 < 4; ++q4) { pp[4 * q4] = b01.x; pp[4 * q4 + 1] = b01.y; pp[4 * q4 + 2] = b23.x; pp[4 * q4 + 3] = b23.y; if (q4 < 3) { b01 += (f32x2){s8_, s8_}; b23 += (f32x2){s8_, s8_}; } } } }
                    {
                        bf16x8 ka[2], qa[2];
                        ka[0] = *(const LAS bf16x8*)(L3 + ((kxt ^ (unsigned)((8 * c) * 16)) + (unsigned)(hf * 32 * 256))); qa[0] = *(const LAS bf16x8*)(qb_ + (4 * c) * 1024);
#pragma unroll
                        for (int d0 = 0; d0 < 4; ++d0) {
                            if (d0 + 1 < 4) { ka[(d0 + 1) & 1] = *(const LAS bf16x8*)(L3 + ((kxt ^ (unsigned)((8 * c + 2 * (d0 + 1)) * 16)) + (unsigned)(hf * 32 * 256))); qa[(d0 + 1) & 1] = *(const LAS bf16x8*)(qb_ + (4 * c + d0 + 1) * 1024); }
                            pp = __builtin_amdgcn_mfma_f32_32x32x16_bf16(ka[d0 & 1], qa[d0 & 1], pp, 0, 0, 0); } }
#pragma unroll
                    for (int r = 0; r < 16; ++r) pp[r] = __builtin_amdgcn_exp2f(pp[r]);
#pragma unroll
                    for (int r = 0; r < 16; r += 2) { if (c == 0) l0v += (f32x2){pp[r], pp[r + 1]}; else l1v += (f32x2){pp[r], pp[r + 1]}; }
#pragma unroll
                    for (int j = 0; j < 4; ++j) { pw[c][0][j] = cvtpk(pp[2 * j], pp[2 * j + 1]); pw[c][1][j] = cvtpk(pp[8 + 2 * j], pp[8 + 2 * j + 1]); }
                }
                {
                    s16x4 vlo[3], vhh[3];
                    vlo[0] = vtr(vp + (2 * hf) * 1024); vhh[0] = vtr(vp + (2 * hf) * 1024 + 512);
                    vlo[1] = vtr(vp + (2 * hf + 1) * 1024); vhh[1] = vtr(vp + (2 * hf + 1) * 1024 + 512);
#pragma unroll
                    for (int i8 = 0; i8 < 8; ++i8) { const int db = i8 >> 1, k2 = i8 & 1;
                        if (i8 + 2 < 8) { const int dn = (i8 + 2) >> 1, kn = 2 * hf + ((i8 + 2) & 1); vlo[(i8 + 2) % 3] = vtr(vp + (dn * 4 + kn) * 1024); vhh[(i8 + 2) % 3] = vtr(vp + (dn * 4 + kn) * 1024 + 512); }
                        const s16x4 lo = vlo[i8 % 3], hh = vhh[i8 % 3];
                        const bf16x8 a = (bf16x8){lo[0], lo[1], lo[2], lo[3], hh[0], hh[1], hh[2], hh[3]};
                        o[0][db] = __builtin_amdgcn_mfma_f32_32x32x16_bf16(a, __builtin_bit_cast(bf16x8, pw[0][k2]), o[0][db], 0, 0, 0);
                        o[1][db] = __builtin_amdgcn_mfma_f32_32x32x16_bf16(a, __builtin_bit_cast(bf16x8, pw[1][k2]), o[1][db], 0, 0, 0); } }
                __builtin_amdgcn_sched_barrier(0);
            }
        }
        ATT_WAIT_BAR(0);
    }
    {
        float l0 = l0v.x + l0v.y, l1 = l1v.x + l1v.y;
        { auto rr = __builtin_amdgcn_permlane32_swap(__float_as_uint(l0), __float_as_uint(l0), false, false); l0 = __uint_as_float(rr[0]) + __uint_as_float(rr[1]); }
        { auto rr = __builtin_amdgcn_permlane32_swap(__float_as_uint(l1), __float_as_uint(l1), false, false); l1 = __uint_as_float(rr[0]) + __uint_as_float(rr[1]); }
        const float i0 = 1.0f / l0, i1 = __uint_as_float(lamp[0]) / l1;
        float ss = 0.f;
#pragma unroll
        for (int db = 0; db < 4; ++db)
#pragma unroll
            for (int r = 0; r < 16; ++r) { const float d = o[0][db][r] * i0 - o[1][db][r] * i1; o[0][db][r] = d; ss += d * d; }
        { auto rr = __builtin_amdgcn_permlane32_swap(__float_as_uint(ss), __float_as_uint(ss), false, false); ss = __uint_as_float(rr[0]) + __uint_as_float(rr[1]); }
        const float rs = __builtin_amdgcn_rsqf(ss * (1.0f / 128.0f) + 1e-6f) * (1.0f - LAM_INIT);
        LAS unsigned char* stg = lds + 65536 + wid * 8192;
        const float* sg_ = subg; asm volatile("" : "+s"(sg_));
#pragma unroll
        for (int db = 0; db < 4; ++db)
#pragma unroll
            for (int rq = 0; rq < 4; ++rq) { const int dv = 32 * db + 8 * rq + 4 * hi; const f32x4 g = *(const GAS f32x4*)(sg_ + dv);
                v2u w; w.x = cvtpk(o[0][db][4 * rq] * rs * g[0], o[0][db][4 * rq + 1] * rs * g[1]); w.y = cvtpk(o[0][db][4 * rq + 2] * rs * g[2], o[0][db][4 * rq + 3] * rs * g[3]);
                *(LAS v2u*)(stg + r32 * 256 + dv * 2) = w; }
        asm volatile("s_waitcnt lgkmcnt(0)" ::: "memory");
        bf16* Ow = O + (size_t)(U.qrow0 + 32 * wid) * DM + U.h * 128;
#pragma unroll
        for (int it = 0; it < 8; ++it) { const int row = it * 4 + (lane >> 4), chk = lane & 15; const v4u vv = *(const LAS v4u*)(stg + row * 256 + chk * 16);
            *(GAS v4u*)(Ow + (size_t)row * DM + chk * 8) = vv; }
    }
    asm volatile("s_waitcnt vmcnt(0) lgkmcnt(0)" ::: "memory");
    ATT_WAIT_BAR(0);
#undef ATT_DMA2
}
}


__device__ __forceinline__ void attn_conv_unit(CArgs& args, int cu) {
    int tid_l = threadIdx.x; asm volatile("" : "+v"(tid_l));
    const int lane = tid_l & 63, wave = __builtin_amdgcn_readfirstlane(tid_l >> 6);
    const __amdgpu_buffer_rsrc_t rs = __builtin_amdgcn_make_buffer_rsrc(P_KS, 0, (int)(264 * MiB), 0x00020000);
#pragma unroll 1
    for (int k = 0; k < 16; k += 2) {
        f32x4 va[2][8];
#pragma unroll
        for (int rr = 0; rr < 2; ++rr) { const int ri = 128 * cu + 16 * wave + k + rr, which = ri >> 15, idx = ri & 32767;
            const float* src = (which ? P_IN(I_CV) : P_IN(I_CK)) + (size_t)idx * DM;
#pragma unroll
            for (int j = 0; j < 4; ++j) { va[rr][2 * j] = *(const GAS f32x4*)(src + 512 * j + 8 * lane); va[rr][2 * j + 1] = *(const GAS f32x4*)(src + 512 * j + 8 * lane + 4); } }
#pragma unroll
        for (int rr = 0; rr < 2; ++rr) { const int ri = 128 * cu + 16 * wave + k + rr, which = ri >> 15, idx = ri & 32767, b = idx >> 11, p = idx & 2047;
            const unsigned off = (unsigned)(((size_t)which * 16 * KS_ROWS + (size_t)b * KS_ROWS + 16 + p) * DM * 2);
#pragma unroll
            for (int j = 0; j < 4; ++j) { const f32x4 a = va[rr][2 * j], bq = va[rr][2 * j + 1];
                v4u o; o.x = pk2(a[0], a[1]); o.y = pk2(a[2], a[3]); o.z = pk2(bq[0], bq[1]); o.w = pk2(bq[2], bq[3]);
                __builtin_amdgcn_raw_buffer_store_b128(o, rs, (int)(off + (unsigned)(512 * j + 8 * lane) * 2u), 0,   16); } }
    }
    asm volatile("s_waitcnt vmcnt(0)" ::: "memory");
    __syncthreads();
    if (threadIdx.x == 0) { const int b = ((128 * cu) & 32767) >> 11; __hip_atomic_fetch_add((unsigned*)(P_CTL + CW_SCONV) + 16 * b, 1u, __ATOMIC_RELAXED, __HIP_MEMORY_SCOPE_AGENT); }
}
__device__ __forceinline__ void attn_phase(const Frame& F, CArgs& args) {
    int ln = threadIdx.x & 63; asm volatile("" : "+v"(ln));
    float lam;
    { const float* dl = P_IN(I_DLAM); const float a = wave_sum(dl[ln] * dl[64 + ln]), b = wave_sum(dl[128 + ln] * dl[192 + ln]); lam = __expf(a) - __expf(b) + LAM_INIT; }
    float tcut, smax2;
    { float mq = __builtin_fabsf(P_IN(I_QNORM)[ln]), mk = __builtin_fabsf(P_IN(I_KNORM)[ln]);
#pragma unroll
      for (int o = 1; o < 64; o <<= 1) { mq = __builtin_fmaxf(mq, __shfl_xor(mq, o)); mk = __builtin_fmaxf(mk, __shfl_xor(mk, o)); }
      tcut = 2.0f * (8.0f * mq * mk * 1.02f) + 106.0f; smax2 = 8.0f * mq * mk * 1.02f * LOG2E; }
    if (threadIdx.x == 0) { F.MISC[20] = __float_as_uint(lam); F.MISC[21] = __float_as_uint(tcut); F.MISC[22] = __float_as_uint(smax2); }
    __syncthreads();
    const bf16* Q = P_ACT; bf16* O = P_A3;
    const int nun = 1024 + 512 + 256;
    unsigned* qctr = (unsigned*)(P_CTL + CW_ATTQ);
    for (;;) {
        if (threadIdx.x == 0) F.MISC[16] = atomicAdd(qctr, 1u);
        __syncthreads();
        const int idx = (int)F.MISC[16];
        if (idx >= nun) break;
        int uid, sunit = -1;
        if (idx < 256) uid = idx;
        else if (idx < 1280) { const int g = (idx - 256) >> 1; if (idx & 1) { attn_conv_unit(args, g); continue; } uid = 256 + g; }
        else { const int g = (idx - 1280) >> 1; if (idx & 1) sunit = g; uid = 768 + g; }
        const float tcut_u = __uint_as_float((unsigned)__builtin_amdgcn_readfirstlane((int)F.MISC[21])), smax2_u = __uint_as_float((unsigned)__builtin_amdgcn_readfirstlane((int)F.MISC[22]));
        att::UnitDesc U;
        if (sunit < 0) { const int jb = 63 - (uid >> 4); U.h = 15 - (uid & 15); U.Kb = P_KP; U.Vb = P_VP; U.qrow0 = 16 + 256 * jb; U.kb0 = 16 + 64 * (4 * jb + 3); U.NTF = 4 * jb + 5; U.sample = 0; U.nvalid = 32;
            const float slope = exp2f(-0.5f * (float)(U.h + 1));
            const float w = (tcut_u / slope + 255.0f) * (1.0f / 64.0f); const int wt = w > 1000.f ? 1000 : (int)w + 1;
            U.NT = wt < U.NTF ? wt : U.NTF; U.dyn = smax2_u < 40.0f ? 0 : 1; U.mref = smax2_u; }
        else {
            const int b = sunit >> 4;
            if (threadIdx.x == 0) { unsigned* cw = (unsigned*)(P_CTL + CW_SCONV) + 16 * b; unsigned sp = 0;
                while (__hip_atomic_load(cw, __ATOMIC_RELAXED, __HIP_MEMORY_SCOPE_AGENT) < 32u && ++sp < (1u << 22)) __builtin_amdgcn_s_sleep(2);
                __builtin_amdgcn_fence(__ATOMIC_ACQUIRE, "agent"); asm volatile("s_waitcnt vmcnt(0)" ::: "memory"); }
            __syncthreads();
            U.h = sunit & 15; U.Kb = P_KS + (size_t)b * KS_ROWS * DM; U.Vb = P_VS + (size_t)b * KS_ROWS * DM; U.qrow0 = ROW_S0 + 16 * b; U.kb0 = 2048; U.NT = 33; U.NTF = 33; U.sample = 1; U.nvalid = 16; U.dyn = 1; U.mref = 0.f; }
        const float slope2 = exp2f(-0.5f * (float)(U.h + 1)) * LOG2E;
        if (sunit < 0) att::attn_unit_p(F.lds + RING_OFF, Q, O, U, slope2, F.MISC + 20, P_IN(I_SUBNORM)); else att::attn_unit_s<8>(F.lds + RING_OFF, Q, O, U, slope2, __uint_as_float(F.MISC[20]), P_IN(I_SUBNORM));
    }
}

__global__ void __launch_bounds__(NWAVES * 64, 2) fwd_kernel(Args args_kv) {
    extern __shared__ __attribute__((aligned(16))) unsigned char lds[];
    Frame F;
    F.lds = (LAS unsigned char*)lds;
    F.MISC = (volatile LAS unsigned*)(F.lds + MISC_OFF);
    F.tid = threadIdx.x; F.lane = F.tid & 63; F.wave = __builtin_amdgcn_readfirstlane(F.tid >> 6); F.G = gridDim.x;
    for (int u = F.tid; u < (LDS_BYTES - LDSCTL_OFF) / 4; u += NWAVES * 64) ((LAS unsigned*)(F.lds + LDSCTL_OFF))[u] = 0u;
    __syncthreads();
    const Args& args = args_kv;
    const int lo = args.ph_lo, hi = args.ph_hi;
    XcdBarrier bar; bar.bar = (unsigned*)(P_CTL + CW_BAR); bar.x = 0; bar.st = nullptr;
    if (hi - lo > 1) bar = xcd_barrier_post((unsigned*)(P_CTL + CW_BAR), F.MISC + 8);
    int ph = 0;
#define RUN() (ph >= lo && ph < hi)
#define SEAM() do { if (ph >= lo && ph + 1 < hi) xcd_barrier(bar); ++ph; } while (0)
#define SEAM_NOBAR() do { if (MK_PER_PHASE) { SEAM(); } else { ++ph; } } while (0)

    if (RUN() && EN_P0) p0_prologue(F, *largs());
    SEAM();
    for (int ls = 0; ls < 4; ++ls) {
        if (RUN() && EN_GU) {
            CArgs& args = *largs();
            pg8::Gemm g{P_X16, P_WGU + (size_t)ls * 11264 * DM, MROWS, 11264, DM}; pg8::SplitOrder S; S.init(11264, DM, F.G, lbid(), 2, ph * 128, P_SLAB, P_SCNT, 120, 1);
            const int si = ls == 0 ? 0 : ls == 1 ? 2 : ls == 2 ? 3 : 5;
            pg8::EpiGU E{P_HID, P_SSQ + (size_t)si * MROWS};
            pg8::gemm_phase<pg8::EpiGU, pg8::SplitOrder, PG8_ALIGN, PG8_SP2>(F.lds + RING_OFF, g, S, E);
        }
        SEAM();
        if (RUN() && EN_DN) {
            CArgs& args = *largs();
            pg8::Gemm g{P_HID, P_WDN + (size_t)ls * DM * DFF, MROWS, DM, DFF}; pg8::SplitOrder S; S.init(DM, DFF, F.G, lbid(), 8, ph * 128, P_SLAB, P_SCNT);
            const int so = ls == 0 ? 1 : ls == 1 ? 3 : ls == 2 ? 4 : 0;
            pg8::EpiRes E{P_X16, P_SSQ + (size_t)so * MROWS, 0.5f, ls == 3 ? 1 : 0, P_OUT + O_YP, P_OUT + O_YS};
            pg8::gemm_phase<pg8::EpiRes, pg8::SplitOrder, PG8_ALIGN, PG8_SP2>(F.lds + RING_OFF, g, S, E);
        }
        SEAM();
        if (ls == 0) {
            if (RUN() && EN_WIN) {
            CArgs& args = *largs();
                pg8::Gemm g{P_X16, P_WIN, MROWS, 4096, DM}; pg8::SplitOrder S; S.init(4096, DM, F.G, lbid(), 4, ph * 128, P_SLAB, P_SCNT);
                pg8::EpiWin E{P_GG, P_XB, P_SSQ + (size_t)1 * MROWS};
                pg8::gemm_phase<pg8::EpiWin, pg8::SplitOrder, PG8_ALIGN, PG8_SP2>(F.lds + RING_OFF, g, S, E);
            }
            SEAM();
            if (RUN() && EN_RG0) rg_phase<0>(F, *largs());
            SEAM();
            if (RUN() && EN_RG1) rg_phase<1>(F, *largs());
            SEAM();
        } else if (ls == 1) {
            if (RUN() && EN_KV) {
            CArgs& args = *largs();
                pg8::Gemm g{P_X16, P_WKV, MROWS, 4096, DM}; pg8::SplitOrder S; S.init(4096, DM, F.G, lbid(), 4, ph * 128, P_SLAB + (size_t)256 * 32768, P_SCNT);
                pg8::EpiKV E{P_SSQ + (size_t)3 * MROWS, P_IN(I_KNORM), P_OUT + O_KP, P_OUT + O_VP, P_OUT + O_KS, P_OUT + O_VS, P_KP, P_VP, P_KS, P_VS};
                pg8::gemm_phase<pg8::EpiKV, pg8::SplitOrder, PG8_ALIGN, PG8_SP2>(F.lds + RING_OFF, g, S, E);
            }
            SEAM_NOBAR();
        } else if (ls == 2) {
            if (RUN() && EN_Q) {
            CArgs& args = *largs();
                pg8::Gemm g{P_X16, P_WQ, MROWS, DM, DM}; pg8::SplitOrder S; S.init(DM, DM, F.G, lbid(), 4, ph * 128, P_SLAB, P_SCNT);
                pg8::EpiQ E{P_SSQ + (size_t)4 * MROWS, P_IN(I_QNORM), P_ACT, 0.125f * LOG2E};
                pg8::gemm_phase<pg8::EpiQ, pg8::SplitOrder, PG8_ALIGN, PG8_SP2>(F.lds + RING_OFF, g, S, E);
            }
            SEAM();
            if (RUN() && EN_ATT) attn_phase(F, *largs());
            SEAM();
        }
        if (ls == 0 || ls == 2) {
            if (RUN() && EN_RES) {
            CArgs& args = *largs();
                pg8::Gemm g{ls == 0 ? P_ACT : P_A3, ls == 0 ? P_WOUT : P_WO, MROWS, DM, DM}; pg8::SplitOrder S; S.init(DM, DM, F.G, lbid(), 4, ph * 128, P_SLAB, P_SCNT);
                pg8::EpiRes E{P_X16, P_SSQ + (size_t)(ls == 0 ? 2 : 5) * MROWS, 1.0f, 0, P_OUT + O_YP, P_OUT + O_YS};
                pg8::gemm_phase<pg8::EpiRes, pg8::SplitOrder, PG8_ALIGN, PG8_SP2>(F.lds + RING_OFF, g, S, E);
            }
            SEAM();
        }
    }
#undef RUN
#undef SEAM
}

extern "C" void kernel_launch(void* const* d_in, const int* in_sizes, int n_in, void* d_out, int out_size, void* d_ws, size_t ws_size, hipStream_t stream) {
    static int grid = 0;
    if (grid == 0) {
        if (n_in != 28 || in_sizes[0] != 16384 * DM || (size_t)out_size != O_END || ws_size < WS_END) {
            fprintf(stderr, "kernel_launch: unexpected shapes: n_in %d, in0 %d, out %d, ws %zu (need %zu); nothing launched\n", n_in, n_in > 0 ? in_sizes[0] : -1, out_size, ws_size, (size_t)WS_END); grid = -1; return; }
        int dev = 0, cus = 0, per_cu = 0;
        if (hipGetDevice(&dev) != hipSuccess || hipDeviceGetAttribute(&cus, hipDeviceAttributeMultiprocessorCount, dev) != hipSuccess) { grid = -1; return; }
        if (hipFuncSetAttribute((const void*)fwd_kernel, hipFuncAttributeMaxDynamicSharedMemorySize, LDS_BYTES) != hipSuccess) { fprintf(stderr, "kernel_launch: hipFuncSetAttribute failed\n"); grid = -1; return; }
        if (hipOccupancyMaxActiveBlocksPerMultiprocessor(&per_cu, (const void*)fwd_kernel, NWAVES * 64, LDS_BYTES) != hipSuccess || per_cu < 1) { fprintf(stderr, "kernel_launch: occupancy query says %d blocks per CU\n", per_cu); }
        (void)hipGetLastError();
        grid = cus;
    }
    if (grid < 0) return;
    if (hipMemsetAsync((char*)d_ws + WS_CTL, 0, CTL_ZERO_BYTES, stream) != hipSuccess) return;
    Args a{};
    for (int i = 0; i < 28; ++i) a.in[i] = (const float*)d_in[i];
    a.out = (float*)d_out; a.ws = (unsigned char*)d_ws;
#if MK_PER_PHASE
    for (int p = 0; p < NPHASE; ++p) { a.ph_lo = p; a.ph_hi = p + 1; hipLaunchKernelGGL(fwd_kernel, dim3(grid), dim3(NWAVES * 64), LDS_BYTES, stream, a); }
#else
    a.ph_lo = 0; a.ph_hi = NPHASE;
    hipLaunchKernelGGL(fwd_kernel, dim3(grid), dim3(NWAVES * 64), LDS_BYTES, stream, a);
#endif
    const hipError_t le = hipPeekAtLastError();
    if (le != hipSuccess) fprintf(stderr, "kernel_launch: launch failed: %s\n", hipGetErrorName(le));
}
```

```cpp
#include <hip/hip_runtime.h>
#include <cstdio>
#include <cstdint>
namespace pg8 {
#define PG8_LAS __attribute__((address_space(3)))
typedef unsigned short bf16_t;
typedef short bf16x8 __attribute__((ext_vector_type(8)));
typedef float f32x4 __attribute__((ext_vector_type(4)));
typedef unsigned u32x4 __attribute__((ext_vector_type(4)));
constexpr int BM = 256, BK = 64, HALF = 128, HTB = HALF * BK * 2  , STAGE_BYTES = 8 * HTB, NXCD = 8, WGM = 8;

__host__ __device__ __forceinline__ int lds_byte(int r, int c) { const int st = (r >> 4) * 2 + (c >> 5), rr = r & 15, cc = c & 31, ob = rr * 64 + cc * 2; return st * 1024 + (ob ^ (((ob >> 9) & 1) << 5)); }
__host__ __device__ __forceinline__ void stage_rc(int b, int& R, int& C) { const int st = b / 1024, sb = b % 1024, swz = sb ^ (((sb >> 9) & 1) << 5); R = (st >> 1) * 16 + swz / 64; C = (st & 1) * 32 + (swz % 64) / 2; }
__host__ __device__ __forceinline__ int perm32(int rho) { const int n = rho >> 4, i = rho & 15; return 8 * (i >> 2) + 4 * n + (i & 3); }

struct Unit { int pm, pn, kt0, nt, nsplit, slab, cidx, half; };
struct Gemm { const bf16_t* A; const bf16_t* Bt; int M, N, K; };

struct StaticOrder {
    int nM, nN, nwg, G, c;
    __host__ __device__ void init(int M, int N, int G_, int c_) { nM = M / BM; nN = N / BM; nwg = nM * nN; G = G_; c = c_; }
    __host__ __device__ bool next(int i, Unit& u) const {
        const long L = (long)i * G + c; if (L >= nwg) return false;
        int wgid = (int)L; { const int q = nwg / NXCD, r = nwg % NXCD, xcd = wgid % NXCD, off = wgid / NXCD; wgid = (xcd < r ? xcd * (q + 1) : r * (q + 1) + (xcd - r) * q) + off; }
        const int nig = WGM * nN, gid = wgid / nig, fm = gid * WGM, gsz = (nM - fm) < WGM ? (nM - fm) : WGM;
        u.pm = 2 * (fm + ((wgid % nig) % gsz)); u.pn = (wgid % nig) / gsz; u.kt0 = 0; u.nt = 0; u.nsplit = 1; u.slab = 0; u.cidx = 0; u.half = 0; return true;
    }
    __device__ __forceinline__ void a_ready(const Unit&) const {}
    __device__ __forceinline__ void done(const Unit&) const {}
};

__device__ __forceinline__ unsigned cvt_pk_bf16(float lo, float hi) { unsigned r; asm volatile("v_cvt_pk_bf16_f32 %0, %1, %2" : "=v"(r) : "v"(lo), "v"(hi)); return r; }
constexpr float RMS_EPS = 1e-6f;
__device__ __forceinline__ float row_rstd(const float* ssq, int row) { return __builtin_amdgcn_rsqf(ssq[row] * (1.0f / 2048.0f) + RMS_EPS); }
__device__ __forceinline__ float fast_sigmoid(float x) { return __builtin_amdgcn_rcpf(1.0f + __builtin_amdgcn_exp2f(-1.4426950408889634f * x)); }
__device__ __forceinline__ u32x4 pack8(const f32x4 a, const f32x4 b) { u32x4 w; w.x = cvt_pk_bf16(a[0], a[1]); w.y = cvt_pk_bf16(a[2], a[3]); w.z = cvt_pk_bf16(b[0], b[1]); w.w = cvt_pk_bf16(b[2], b[3]); return w; }

struct EpiGU {
    static constexpr bool PERM = true, AFTER_DRAIN = false;
    bf16_t* H; const float* ssq;
    template <bool HF> __device__ __forceinline__ void run(const f32x4 (&acc)[2][2][4][2], const Unit& u, int wr, int wc, int fr, int fq) const {
        typedef float f2 __attribute__((ext_vector_type(2)));
        typedef __bf16 b2 __attribute__((ext_vector_type(2)));
        const int colh = u.pn * 128 + wc * 32 + 8 * fq;
        float rsv[8];
#pragma unroll
        for (int i = 0; i < (HF ? 4 : 8); ++i) rsv[i] = row_rstd(ssq, u.pm * HALF + (i >> 2) * HALF + wr * 64 + (i & 3) * 16 + fr);
#pragma unroll
        for (int ai = 0; ai < (HF ? 1 : 2); ++ai)
#pragma unroll
            for (int m = 0; m < 4; ++m) {
                const int row = u.pm * HALF + ai * HALF + wr * 64 + m * 16 + fr; const float rs = rsv[ai * 4 + m];
                const float nrs = -1.4426950408889634f * rs, rs2 = rs * rs;
                f2 g[4], up[4], t[4], r[4];
#pragma unroll
                for (int p = 0; p < 4; ++p) { g[p] = (f2){acc[ai][0][m][p >> 1][2 * (p & 1)], acc[ai][0][m][p >> 1][2 * (p & 1) + 1]}; up[p] = (f2){acc[ai][1][m][p >> 1][2 * (p & 1)], acc[ai][1][m][p >> 1][2 * (p & 1) + 1]}; }
#pragma unroll
                for (int p = 0; p < 4; ++p) t[p] = g[p] * (f2){nrs, nrs};
#pragma unroll
                for (int p = 0; p < 4; ++p) { t[p].x = __builtin_amdgcn_exp2f(t[p].x); t[p].y = __builtin_amdgcn_exp2f(t[p].y); }
#pragma unroll
                for (int p = 0; p < 4; ++p) { t[p] = t[p] + (f2){1.0f, 1.0f}; g[p] = g[p] * up[p]; }
#pragma unroll
                for (int p = 0; p < 4; ++p) { r[p].x = __builtin_amdgcn_rcpf(t[p].x); r[p].y = __builtin_amdgcn_rcpf(t[p].y); }
                u32x4 w;
#pragma unroll
                for (int p = 0; p < 4; ++p) { const f2 h = g[p] * (r[p] * (f2){rs2, rs2}); w[p] = __builtin_bit_cast(unsigned, __builtin_convertvector(h, b2)); }
                *(u32x4*)(H + (size_t)row * 5632 + colh) = w;
            }
    }
    __device__ __forceinline__ void operator()(const f32x4 (&acc)[2][2][4][2], const Unit& u, int wr, int wc, int fr, int fq) const { run<false>(acc, u, wr, wc, fr, fq); }
    __device__ __forceinline__ void half(const f32x4 (&acc)[2][2][4][2], const Unit& u, int wr, int wc, int fr, int fq) const { run<true>(acc, u, wr, wc, fr, fq); }
};
struct EpiRes {
    static constexpr bool PERM = true, AFTER_DRAIN = false;
    bf16_t* x16; float* ssq; float scale; int final_; float* yp; float* ys;
    template <bool HF> __device__ __forceinline__ void run(const f32x4 (&acc)[2][2][4][2], const Unit& u, int wr, int wc, int fr, int fq) const {
        const int col = u.pn * BM + wc * 64 + 8 * fq;
        u32x4 xw[HF ? 4 : 8][2];
#pragma unroll
        for (int i = 0; i < (HF ? 4 : 8); ++i) { const bf16_t* xq = x16 + (size_t)(u.pm * HALF + (i >> 2) * HALF + wr * 64 + (i & 3) * 16 + fr) * 2048 + col; xw[i][0] = *(const u32x4*)xq; xw[i][1] = *(const u32x4*)(xq + 32); }
#pragma unroll
        for (int ai = 0; ai < (HF ? 1 : 2); ++ai)
#pragma unroll
            for (int m = 0; m < 4; ++m) {
                const int row = u.pm * HALF + ai * HALF + wr * 64 + m * 16 + fr;
                bf16_t* xp = x16 + (size_t)row * 2048 + col; float sq = 0.f;
                float* op = nullptr;
                if (final_) { if (row >= 16 && row < 16400) op = yp + (size_t)(row - 16) * 2048 + col; else if (row >= 16400 && row < 16656) op = ys + (size_t)(row - 16400) * 2048 + col; }
                const u32x4 w0 = xw[ai * 4 + m][0], w1 = xw[ai * 4 + m][1];
#pragma unroll
                for (int bj = 0; bj < 2; ++bj) {
                    const u32x4 w = bj ? w1 : w0;
                    const f32x4 x0 = (f32x4){__uint_as_float(w.x << 16), __uint_as_float(w.x & 0xffff0000u), __uint_as_float(w.y << 16), __uint_as_float(w.y & 0xffff0000u)};
                    const f32x4 x1 = (f32x4){__uint_as_float(w.z << 16), __uint_as_float(w.z & 0xffff0000u), __uint_as_float(w.w << 16), __uint_as_float(w.w & 0xffff0000u)};
                    const f32x4 v0 = x0 + acc[ai][bj][m][0] * scale, v1 = x1 + acc[ai][bj][m][1] * scale;
                    if (final_) { if (op) { *(f32x4*)(op + 32 * bj) = v0; *(f32x4*)(op + 32 * bj + 4) = v1; } }
                    else { *(u32x4*)(xp + 32 * bj) = pack8(v0, v1);
                        sq += (v0[0] * v0[0] + v0[1] * v0[1]) + (v0[2] * v0[2] + v0[3] * v0[3]) + (v1[0] * v1[0] + v1[1] * v1[1]) + (v1[2] * v1[2] + v1[3] * v1[3]); }
                }
                if (!final_) { sq += __shfl_xor(sq, 16); sq += __shfl_xor(sq, 32); if (fq == 0) atomicAdd(ssq + row, sq); }
            }
    }
    __device__ __forceinline__ void operator()(const f32x4 (&acc)[2][2][4][2], const Unit& u, int wr, int wc, int fr, int fq) const { run<false>(acc, u, wr, wc, fr, fq); }
    __device__ __forceinline__ void half(const f32x4 (&acc)[2][2][4][2], const Unit& u, int wr, int wc, int fr, int fq) const { run<true>(acc, u, wr, wc, fr, fq); }
};
struct EpiWin {
    static constexpr bool PERM = true, AFTER_DRAIN = false;
    bf16_t* GG; float* XB; const float* ssq;
    template <bool HF> __device__ __forceinline__ void run(const f32x4 (&acc)[2][2][4][2], const Unit& u, int wr, int wc, int fr, int fq) const {
        const int col = (u.pn & 7) * BM + wc * 64 + 8 * fq; const bool isg = u.pn < 8;
        float rsv[HF ? 4 : 8];
#pragma unroll
        for (int i = 0; i < (HF ? 4 : 8); ++i) rsv[i] = row_rstd(ssq, u.pm * HALF + (i >> 2) * HALF + wr * 64 + (i & 3) * 16 + fr);
#pragma unroll
        for (int ai = 0; ai < (HF ? 1 : 2); ++ai)
#pragma unroll
            for (int m = 0; m < 4; ++m) {
                const int row = u.pm * HALF + ai * HALF + wr * 64 + m * 16 + fr; const float rs = rsv[ai * 4 + m];
#pragma unroll
                for (int bj = 0; bj < 2; ++bj) {
                    f32x4 v0 = acc[ai][bj][m][0] * rs, v1 = acc[ai][bj][m][1] * rs;
                    if (isg) {
#pragma unroll
                        for (int e = 0; e < 4; ++e) { const float a = v0[e], b = v1[e];
                            v0[e] = a * fast_sigmoid(1.5957691216057308f * (a + 0.044715f * a * a * a)); v1[e] = b * fast_sigmoid(1.5957691216057308f * (b + 0.044715f * b * b * b)); }
                        *(u32x4*)(GG + (size_t)row * 2048 + col + 32 * bj) = pack8(v0, v1);
                    } else { float* xp = XB + (size_t)row * 2048 + col + 32 * bj; *(f32x4*)xp = v0; *(f32x4*)(xp + 4) = v1; }
                }
            }
    }
    __device__ __forceinline__ void operator()(const f32x4 (&acc)[2][2][4][2], const Unit& u, int wr, int wc, int fr, int fq) const { run<false>(acc, u, wr, wc, fr, fq); }
    __device__ __forceinline__ void half(const f32x4 (&acc)[2][2][4][2], const Unit& u, int wr, int wc, int fr, int fq) const { run<true>(acc, u, wr, wc, fr, fq); }
};
__device__ __forceinline__ float group_rstd64(const f32x4 (&v)[2][2]) {
    float s = 0.f;
#pragma unroll
    for (int bj = 0; bj < 2; ++bj)
#pragma unroll
        for (int n = 0; n < 2; ++n) s += (v[bj][n][0] * v[bj][n][0] + v[bj][n][1] * v[bj][n][1]) + (v[bj][n][2] * v[bj][n][2] + v[bj][n][3] * v[bj][n][3]);
    s += __shfl_xor(s, 16); s += __shfl_xor(s, 32);
    return __builtin_amdgcn_rsqf(s * (1.0f / 64.0f) + RMS_EPS);
}
struct EpiKV {
    static constexpr bool PERM = true, AFTER_DRAIN = false;
    const float* ssq; const float* kg;
    float* okp; float* ovp; float* oks; float* ovs;
    bf16_t* KP; bf16_t* VP; bf16_t* KS; bf16_t* VS;
    template <bool HF> __device__ __forceinline__ void run(const f32x4 (&acc)[2][2][4][2], const Unit& u, int wr, int wc, int fr, int fq) const {
        const bool isk = u.pn < 8; const int col = (u.pn & 7) * BM + wc * 64 + 8 * fq;
        f32x4 g[2][2];
#pragma unroll
        for (int bj = 0; bj < 2; ++bj)
#pragma unroll
            for (int n = 0; n < 2; ++n) g[bj][n] = isk ? *(const f32x4*)(kg + 32 * bj + 8 * fq + 4 * n) : (f32x4){1.f, 1.f, 1.f, 1.f};
        float* o32p = isk ? okp : ovp; float* o32s = isk ? oks : ovs; bf16_t* b16p = isk ? KP : VP; bf16_t* b16s = isk ? KS : VS;
        float rsv[HF ? 4 : 8];
#pragma unroll
        for (int i = 0; i < (HF ? 4 : 8); ++i) rsv[i] = row_rstd(ssq, u.pm * HALF + (i >> 2) * HALF + wr * 64 + (i & 3) * 16 + fr);
#pragma unroll
        for (int ai = 0; ai < (HF ? 1 : 2); ++ai)
#pragma unroll
            for (int m = 0; m < 4; ++m) {
                const int row = u.pm * HALF + ai * HALF + wr * 64 + m * 16 + fr; const float rs = rsv[ai * 4 + m];
                f32x4 v[2][2];
#pragma unroll
                for (int bj = 0; bj < 2; ++bj)
#pragma unroll
                    for (int n = 0; n < 2; ++n) v[bj][n] = acc[ai][bj][m][n] * rs;
                if (isk) { const float gr = group_rstd64(v);
#pragma unroll
                    for (int bj = 0; bj < 2; ++bj)
#pragma unroll
                        for (int n = 0; n < 2; ++n) v[bj][n] = v[bj][n] * gr * g[bj][n]; }
                float* o32 = nullptr; bf16_t* b16 = nullptr;
                if (row < 16400) { o32 = o32p + (size_t)row * 2048; b16 = b16p + (size_t)row * 2048; }
                else if (row < 16656) { const int sr = row - 16400; o32 = o32s + (size_t)sr * 2048; b16 = b16s + ((size_t)(sr >> 4) * 2112 + 2064 + (sr & 15)) * 2048; }
                if (o32) {
#pragma unroll
                    for (int bj = 0; bj < 2; ++bj) { float* p = o32 + col + 32 * bj; *(f32x4*)p = v[bj][0]; *(f32x4*)(p + 4) = v[bj][1]; *(u32x4*)(b16 + col + 32 * bj) = pack8(v[bj][0], v[bj][1]); }
                    if (row < 16) {
                        for (int b = 0; b < 16; ++b) { bf16_t* q = b16s + ((size_t)b * 2112 + row) * 2048 + col;
#pragma unroll
                            for (int bj = 0; bj < 2; ++bj) *(u32x4*)(q + 32 * bj) = pack8(v[bj][0], v[bj][1]); }
                    }
                }
            }
    }
    __device__ __forceinline__ void operator()(const f32x4 (&acc)[2][2][4][2], const Unit& u, int wr, int wc, int fr, int fq) const { run<false>(acc, u, wr, wc, fr, fq); }
    __device__ __forceinline__ void half(const f32x4 (&acc)[2][2][4][2], const Unit& u, int wr, int wc, int fr, int fq) const { run<true>(acc, u, wr, wc, fr, fq); }
};
struct EpiQ {
    static constexpr bool PERM = true, AFTER_DRAIN = false;
    const float* ssq; const float* qg; bf16_t* Q; float c2;
    template <bool HF> __device__ __forceinline__ void run(const f32x4 (&acc)[2][2][4][2], const Unit& u, int wr, int wc, int fr, int fq) const {
        const int col = u.pn * BM + wc * 64 + 8 * fq;
        f32x4 g[2][2];
        float rsv[HF ? 4 : 8];
#pragma unroll
        for (int i = 0; i < (HF ? 4 : 8); ++i) rsv[i] = row_rstd(ssq, u.pm * HALF + (i >> 2) * HALF + wr * 64 + (i & 3) * 16 + fr);
#pragma unroll
        for (int bj = 0; bj < 2; ++bj)
#pragma unroll
            for (int n = 0; n < 2; ++n) g[bj][n] = *(const f32x4*)(qg + 32 * bj + 8 * fq + 4 * n) * c2;
#pragma unroll
        for (int ai = 0; ai < (HF ? 1 : 2); ++ai)
#pragma unroll
            for (int m = 0; m < 4; ++m) {
                const int row = u.pm * HALF + ai * HALF + wr * 64 + m * 16 + fr; const float rs = rsv[ai * 4 + m];
                f32x4 v[2][2];
#pragma unroll
                for (int bj = 0; bj < 2; ++bj)
#pragma unroll
                    for (int n = 0; n < 2; ++n) v[bj][n] = acc[ai][bj][m][n] * rs;
                const float gr = group_rstd64(v);
#pragma unroll
                for (int bj = 0; bj < 2; ++bj) *(u32x4*)(Q + (size_t)row * 2048 + col + 32 * bj) = pack8(v[bj][0] * gr * g[bj][0], v[bj][1] * gr * g[bj][1]);
            }
    }
    __device__ __forceinline__ void operator()(const f32x4 (&acc)[2][2][4][2], const Unit& u, int wr, int wc, int fr, int fq) const { run<false>(acc, u, wr, wc, fr, fq); }
    __device__ __forceinline__ void half(const f32x4 (&acc)[2][2][4][2], const Unit& u, int wr, int wc, int fr, int fq) const { run<true>(acc, u, wr, wc, fr, fq); }
};

struct SplitOrder {
    int nN, nwgP, G, c, nsplit, nsB, TA, npairs, cbase; long skipP; float* slabs; unsigned* cnt;
    __device__ __forceinline__ void init(int N, int K, int G_, int c_, int nsplit_, int cbase_, float* slabs_, unsigned* cnt_, int TA_ = 1 << 20, int nsB_ = 1) {
        nN = N / BM; nwgP = 64 * nN; G = G_; c = c_; nsplit = nsplit_; nsB = nsB_; TA = TA_ < 3 * nN ? TA_ : 3 * nN; npairs = K / (2 * BK); cbase = cbase_; slabs = slabs_; cnt = cnt_; skipP = 0; }
    __device__ __forceinline__ bool next(int i, Unit& u) const {
        const long L = (long)i * G + c + skipP;
        if (L < nwgP) { int wgid = (int)L; { const int q = nwgP / NXCD, r = nwgP % NXCD, xcd = wgid % NXCD, off = wgid / NXCD; wgid = (xcd < r ? xcd * (q + 1) : r * (q + 1) + (xcd - r) * q) + off; }
            const int nig = WGM * nN, gid = wgid / nig, fm = gid * WGM;
            u.pm = 2 * (fm + ((wgid % nig) % WGM)); u.pn = (wgid % nig) / WGM; u.kt0 = 0; u.nt = 2 * npairs; u.nsplit = 1; u.slab = 0; u.cidx = 0; u.half = 0; return true; }
        const int m = (int)(L - nwgP); int tau, j, ns = nsplit, mm = m, t0 = 0;
        const int MA = ((TA + 7) & ~7) * nsplit;
        if (m >= MA) { mm = m - MA; ns = nsB; t0 = TA; }
        if (G == 256) { if (m >= 256) return false; const int x = mm & 7, v = mm >> 3; tau = t0 + 8 * (v / ns) + x; j = v % ns; }
        else { tau = t0 + mm / ns; j = mm % ns; }
        if (tau >= 3 * nN || (t0 == 0 && tau >= TA)) return false;
        const int per = npairs / ns, rem = npairs - per * ns;
        u.pm = 128 + tau / nN; u.pn = tau % nN; u.kt0 = 2 * (j * per + (j < rem ? j : rem)); u.nt = 2 * (per + (j < rem ? 1 : 0)); u.nsplit = ns; u.slab = m; u.cidx = cbase + tau; u.half = 1; return true;
    }
    __device__ __forceinline__ void a_ready(const Unit&) const {}
    __device__ __forceinline__ void done(const Unit&) const {}
    __device__ __forceinline__ bool split_combine(f32x4 (&acc)[2][2][4][2], const Unit& u, int wid, int lane) const {
        const __amdgpu_buffer_rsrc_t rs = __builtin_amdgcn_make_buffer_rsrc(slabs, 0, 256 * 131072, 0x00020000);
        const unsigned voff = ((unsigned)u.slab * 32768u + (unsigned)wid * 4096u + (unsigned)lane * 4u) * 4u;
#pragma unroll
        for (int i = 0; i < 8; ++i) __builtin_amdgcn_raw_buffer_store_b128(pack8(acc[0][(i >> 2) & 1][i & 3][0], acc[0][(i >> 2) & 1][i & 3][1]), rs, (int)(voff + (unsigned)i * 1024u), 0,   16);
        asm volatile("s_waitcnt vmcnt(0)" ::: "memory");
        unsigned t = 0; if (lane == 0) t = __hip_atomic_fetch_add(cnt + (size_t)u.cidx * 8 + wid, 1u, __ATOMIC_RELAXED, __HIP_MEMORY_SCOPE_AGENT);
        t = (unsigned)__builtin_amdgcn_readfirstlane((int)t);
        if (t != (unsigned)(u.nsplit - 1)) return false;
        __builtin_amdgcn_fence(__ATOMIC_ACQUIRE, "agent"); asm volatile("s_waitcnt vmcnt(0)" ::: "memory");
#pragma unroll
        for (int i = 0; i < 8; ++i) { const u32x4 w = pack8(acc[0][(i >> 2) & 1][i & 3][0], acc[0][(i >> 2) & 1][i & 3][1]);
            acc[0][(i >> 2) & 1][i & 3][0] = (f32x4){__uint_as_float(w.x << 16), __uint_as_float(w.x & 0xffff0000u), __uint_as_float(w.y << 16), __uint_as_float(w.y & 0xffff0000u)};
            acc[0][(i >> 2) & 1][i & 3][1] = (f32x4){__uint_as_float(w.z << 16), __uint_as_float(w.z & 0xffff0000u), __uint_as_float(w.w << 16), __uint_as_float(w.w & 0xffff0000u)}; }
        const int MA_ = ((TA + 7) & ~7) * nsplit, rb = u.slab >= MA_ ? MA_ : 0, sr = u.slab - rb;
        const int xs = sr & 7, vs = sr >> 3, own = (G == 256) ? (vs % u.nsplit) : (sr % u.nsplit), base = rb + ((G == 256) ? xs + 8 * ((vs / u.nsplit) * u.nsplit) : sr - own), stride = (G == 256) ? 8 : 1;
        const float* p0 = slabs + (size_t)wid * 4096 + lane * 4;
        const int nq = u.nsplit - 1;
        u32x4 bA[8], bB[8];
#define SC_SLAB(q) (p0 + (size_t)(base + stride * ((q) < own ? (q) : (q) + 1)) * 32768)
#define SC_LOAD(dst, q) do { const float* p_ = SC_SLAB(q); _Pragma("unroll") for (int k = 0; k < 8; ++k) dst[k] = *(const u32x4*)(p_ + k * 256); } while (0)
#define SC_ADD(src) do { _Pragma("unroll") for (int k = 0; k < 8; ++k) { const u32x4 w = src[k]; \
            acc[0][(k >> 2) & 1][k & 3][0] += (f32x4){__uint_as_float(w.x << 16), __uint_as_float(w.x & 0xffff0000u), __uint_as_float(w.y << 16), __uint_as_float(w.y & 0xffff0000u)}; \
            acc[0][(k >> 2) & 1][k & 3][1] += (f32x4){__uint_as_float(w.z << 16), __uint_as_float(w.z & 0xffff0000u), __uint_as_float(w.w << 16), __uint_as_float(w.w & 0xffff0000u)}; } } while (0)
        SC_LOAD(bA, 0);
        for (int q = 0; q < nq; q += 2) {
            if (q + 1 < nq) { SC_LOAD(bB, q + 1); asm volatile("s_waitcnt vmcnt(8)" ::: "memory"); } else asm volatile("s_waitcnt vmcnt(0)" ::: "memory");
            SC_ADD(bA);
            if (q + 1 < nq) {
                if (q + 2 < nq) { SC_LOAD(bA, q + 2); asm volatile("s_waitcnt vmcnt(8)" ::: "memory"); } else asm volatile("s_waitcnt vmcnt(0)" ::: "memory");
                SC_ADD(bB);
            }
        }
#undef SC_SLAB
#undef SC_LOAD
#undef SC_ADD
        return true;
    }
};

template <class Epi, class Sched, bool ALIGN_EPI = false, bool SP2 = false>
__device__ __forceinline__ void gemm_phase(PG8_LAS unsigned char* lds, const Gemm g, const Sched& S, const Epi& E) {
    int tid_l = threadIdx.x; asm volatile("" : "+v"(tid_l));
    const int tid = tid_l, wid = __builtin_amdgcn_readfirstlane(tid >> 6), lane = tid & 63, wr = wid >> 2, wc = wid & 3, fr = lane & 15, fq = lane >> 4;
    const int K = g.K;
    unsigned voffA[2], voffB[2];
#pragma unroll
    for (int i = 0; i < 2; ++i) { int R, C; stage_rc(tid * 16 + i * 8192, R, C); const int Rb = Epi::PERM ? ((R & ~31) + perm32(R & 31)) : R;
        voffA[i] = (unsigned)(R * K + C) * 2u; voffB[i] = (unsigned)(Rb * K + C) * 2u; }
    const size_t kstep = (size_t)(BK * 2);
    const size_t hstep = (size_t)HALF * K * 2;
    const size_t tstep = 2 * hstep;
    const unsigned ldsw = (unsigned)wid * 1024u;
    const int aoff = lds_byte(wr * 64 + fr, fq * 8), boff = lds_byte(wc * 32 + fr, fq * 8);
#define PG8_SA(b, h) (((b) * 2 + (h)) * HTB)
#define PG8_SB(b, h) ((4 + (b) * 2 + (h)) * HTB)
#define PG8_STAGE(bufoff, gbase, voff) do { _Pragma("unroll") for (int _i = 0; _i < 2; ++_i) \
        __builtin_amdgcn_global_load_lds((const unsigned*)((const char*)(gbase) + (voff)[_i]), (PG8_LAS unsigned*)(lds + (bufoff) + ldsw + _i * 8192), 16, 0, 0); } while (0)
#define PG8_LDA(dst, b, h) do { _Pragma("unroll") for (int m = 0; m < 4; ++m) _Pragma("unroll") for (int k = 0; k < 2; ++k) dst[m][k] = *(const PG8_LAS bf16x8*)(lds + PG8_SA(b, h) + aoff + m * 2048 + k * 1024); } while (0)
#define PG8_LDB(dst, b, h) do { _Pragma("unroll") for (int n = 0; n < 2; ++n) _Pragma("unroll") for (int k = 0; k < 2; ++k) dst[n][k] = *(const PG8_LAS bf16x8*)(lds + PG8_SB(b, h) + boff + n * 2048 + k * 1024); } while (0)
#define PG8_MMA(ai, bj, At, Bt) do { __builtin_amdgcn_s_setprio(1); _Pragma("unroll") for (int m = 0; m < 4; ++m) _Pragma("unroll") for (int n = 0; n < 2; ++n) _Pragma("unroll") for (int k = 0; k < 2; ++k) \
        acc[ai][bj][m][n] = __builtin_amdgcn_mfma_f32_16x16x32_bf16(Bt[n][k], At[m][k], acc[ai][bj][m][n], 0, 0, 0); __builtin_amdgcn_s_setprio(0); } while (0)
#define PG8_WAIT_V(n) asm volatile("s_waitcnt vmcnt(" #n ")" ::: "memory")
#define PG8_WAIT_L(n) asm volatile("s_waitcnt lgkmcnt(" #n ")" ::: "memory")
#define PG8_BAR __builtin_amdgcn_s_barrier()
#define PG8_SCHED __builtin_amdgcn_sched_barrier(0)
    Unit cur, nxt; int ui = 0;
    if (!S.next(0, cur)) return;
    f32x4 acc[2][2][4][2];
#pragma unroll
    for (int a = 0; a < 2; ++a)
#pragma unroll
        for (int b = 0; b < 2; ++b)
#pragma unroll
            for (int m = 0; m < 4; ++m)
#pragma unroll
                for (int n = 0; n < 2; ++n) acc[a][b][m][n] = (f32x4){0.f, 0.f, 0.f, 0.f};
    bf16x8 At[4][2], B0[2][2], B1[2][2];
    const char* cA = (const char*)g.A + (size_t)cur.pm * hstep + (size_t)cur.kt0 * kstep; const char* cB = (const char*)g.Bt + (size_t)cur.pn * tstep + (size_t)cur.kt0 * kstep;
    S.a_ready(cur);
    if constexpr (SP2) {
        PG8_STAGE(PG8_SB(0, 0), cB, voffB); PG8_STAGE(PG8_SB(0, 1), cB + hstep, voffB); PG8_STAGE(PG8_SA(0, 0), cA, voffA); PG8_STAGE(PG8_SA(0, 1), cA + hstep, voffA);
        if (wr == 1) PG8_BAR;
        PG8_WAIT_V(2); PG8_BAR;
        PG8_STAGE(PG8_SB(1, 0), cB + kstep, voffB); PG8_STAGE(PG8_SA(1, 0), cA + kstep, voffA); PG8_STAGE(PG8_SB(1, 1), cB + hstep + kstep, voffB);
        PG8_WAIT_V(6); PG8_BAR;
    } else {
        PG8_STAGE(PG8_SB(0, 0), cB, voffB); PG8_STAGE(PG8_SA(0, 0), cA, voffA); PG8_STAGE(PG8_SB(0, 1), cB + hstep, voffB); PG8_STAGE(PG8_SA(0, 1), cA + hstep, voffA);
        if (wr == 1) PG8_BAR;
        PG8_WAIT_V(4); PG8_BAR;
        PG8_STAGE(PG8_SB(1, 0), cB + kstep, voffB); PG8_STAGE(PG8_SA(1, 0), cA + kstep, voffA); PG8_STAGE(PG8_SB(1, 1), cB + hstep + kstep, voffB);
        PG8_WAIT_V(6); PG8_BAR;
    }
    for (;;) {
        const bool has_next = S.next(ui + 1, nxt);
        const char* nA = has_next ? (const char*)g.A + (size_t)nxt.pm * hstep + (size_t)nxt.kt0 * kstep : cA; const char* nB = has_next ? (const char*)g.Bt + (size_t)nxt.pn * tstep + (size_t)nxt.kt0 * kstep : cB;
        const int nt = cur.nt;
        if (!cur.half) {
        for (int t = 0; t < nt; t += 2) {
            const bool last = (t == nt - 2);
            const char* a1 = cA + (size_t)(t + 1) * kstep;
            const char* a2 = last ? nA : cA + (size_t)(t + 2) * kstep; const char* b2 = last ? nB : cB + (size_t)(t + 2) * kstep;
            const char* a3 = a2 + kstep; const char* b3 = b2 + kstep;
            if (last && has_next) S.a_ready(nxt);
            if constexpr (SP2) {
            PG8_LDB(B0, 0, 0); PG8_LDB(B1, 0, 1); PG8_SCHED; PG8_LDA(At, 0, 0); PG8_STAGE(PG8_SA(1, 1), a1 + hstep, voffA);
            PG8_WAIT_V(8); PG8_WAIT_L(0); PG8_BAR; PG8_MMA(0, 0, At, B0); PG8_MMA(0, 1, At, B1); PG8_BAR; PG8_SCHED;
            PG8_LDA(At, 0, 1); PG8_STAGE(PG8_SB(0, 0), b2, voffB); PG8_STAGE(PG8_SB(0, 1), b2 + hstep, voffB); PG8_STAGE(PG8_SA(0, 0), a2, voffA);
            PG8_WAIT_V(8); PG8_WAIT_L(0); PG8_BAR; PG8_MMA(1, 0, At, B0); PG8_MMA(1, 1, At, B1); PG8_BAR; PG8_SCHED;
            PG8_LDB(B0, 1, 0); PG8_LDB(B1, 1, 1); PG8_SCHED; PG8_LDA(At, 1, 0); PG8_STAGE(PG8_SA(0, 1), a2 + hstep, voffA);
            PG8_WAIT_V(8); PG8_WAIT_L(0); PG8_BAR; PG8_MMA(0, 0, At, B0); PG8_MMA(0, 1, At, B1); PG8_BAR; PG8_SCHED;
            PG8_LDA(At, 1, 1); PG8_STAGE(PG8_SB(1, 0), b3, voffB); PG8_STAGE(PG8_SB(1, 1), b3 + hstep, voffB); PG8_STAGE(PG8_SA(1, 0), a3, voffA);
            PG8_WAIT_V(8); PG8_WAIT_L(0); PG8_BAR; PG8_MMA(1, 0, At, B0); PG8_MMA(1, 1, At, B1); PG8_BAR; PG8_SCHED;
            } else {
            PG8_LDB(B0, 0, 0); PG8_SCHED; PG8_LDA(At, 0, 0); PG8_STAGE(PG8_SA(1, 1), a1 + hstep, voffA);
            PG8_WAIT_L(8); PG8_BAR; PG8_WAIT_L(0); PG8_MMA(0, 0, At, B0); PG8_BAR; PG8_SCHED;
            PG8_LDB(B1, 0, 1); PG8_STAGE(PG8_SB(0, 0), b2, voffB);
            PG8_BAR; PG8_WAIT_L(0); PG8_MMA(0, 1, At, B1); PG8_BAR;
            PG8_LDA(At, 0, 1); PG8_STAGE(PG8_SA(0, 0), a2, voffA);
            PG8_BAR; PG8_WAIT_L(0); PG8_MMA(1, 0, At, B0); PG8_BAR; PG8_SCHED;
            PG8_STAGE(PG8_SB(0, 1), b2 + hstep, voffB);
            PG8_WAIT_V(6); PG8_BAR; PG8_MMA(1, 1, At, B1); PG8_BAR;
            PG8_LDB(B0, 1, 0); PG8_SCHED; PG8_LDA(At, 1, 0); PG8_STAGE(PG8_SA(0, 1), a2 + hstep, voffA);
            PG8_WAIT_L(8); PG8_BAR; PG8_WAIT_L(0); PG8_MMA(0, 0, At, B0); PG8_BAR; PG8_SCHED;
            PG8_LDB(B1, 1, 1); PG8_STAGE(PG8_SB(1, 0), b3, voffB);
            PG8_BAR; PG8_WAIT_L(0); PG8_MMA(0, 1, At, B1); PG8_BAR;
            PG8_LDA(At, 1, 1); PG8_STAGE(PG8_SA(1, 0), a3, voffA);
            PG8_BAR; PG8_WAIT_L(0); PG8_MMA(1, 0, At, B0); PG8_BAR; PG8_SCHED;
            PG8_STAGE(PG8_SB(1, 1), b3 + hstep, voffB);
            PG8_WAIT_V(6); PG8_BAR; PG8_MMA(1, 1, At, B1); PG8_BAR;
            }
        }
        if constexpr (ALIGN_EPI) { if (wr == 0) PG8_BAR; }
        E(acc, cur, wr, wc, fr, fq); S.done(cur);
        } else {
        for (int t = 0; t < nt; t += 2) {
            const bool last = (t == nt - 2);
            const char* a1 = cA + (size_t)(t + 1) * kstep;
            const char* a2 = last ? nA : cA + (size_t)(t + 2) * kstep; const char* b2 = last ? nB : cB + (size_t)(t + 2) * kstep;
            const char* a3 = a2 + kstep; const char* b3 = b2 + kstep;
            if (last && has_next) S.a_ready(nxt);
            if constexpr (SP2) {
            PG8_LDB(B0, 0, 0); PG8_LDB(B1, 0, 1); PG8_SCHED; PG8_LDA(At, 0, 0); PG8_STAGE(PG8_SA(1, 1), a1 + hstep, voffA);
            PG8_WAIT_V(8); PG8_WAIT_L(0); PG8_BAR; PG8_MMA(0, 0, At, B0); PG8_MMA(0, 1, At, B1); PG8_BAR; PG8_SCHED;
            PG8_STAGE(PG8_SB(0, 0), b2, voffB); PG8_STAGE(PG8_SB(0, 1), b2 + hstep, voffB); PG8_STAGE(PG8_SA(0, 0), a2, voffA);
            PG8_WAIT_V(8); PG8_WAIT_L(0); PG8_BAR; PG8_BAR; PG8_SCHED;
            PG8_LDB(B0, 1, 0); PG8_LDB(B1, 1, 1); PG8_SCHED; PG8_LDA(At, 1, 0); PG8_STAGE(PG8_SA(0, 1), a2 + hstep, voffA);
            PG8_WAIT_V(8); PG8_WAIT_L(0); PG8_BAR; PG8_MMA(0, 0, At, B0); PG8_MMA(0, 1, At, B1); PG8_BAR; PG8_SCHED;
            PG8_STAGE(PG8_SB(1, 0), b3, voffB); PG8_STAGE(PG8_SB(1, 1), b3 + hstep, voffB); PG8_STAGE(PG8_SA(1, 0), a3, voffA);
            PG8_WAIT_V(8); PG8_WAIT_L(0); PG8_BAR; PG8_BAR; PG8_SCHED;
            } else {
            PG8_LDB(B0, 0, 0); PG8_SCHED; PG8_LDA(At, 0, 0); PG8_STAGE(PG8_SA(1, 1), a1 + hstep, voffA);
            PG8_WAIT_L(8); PG8_BAR; PG8_WAIT_L(0); PG8_MMA(0, 0, At, B0); PG8_BAR; PG8_SCHED;
            PG8_LDB(B1, 0, 1); PG8_STAGE(PG8_SB(0, 0), b2, voffB);
            PG8_BAR; PG8_WAIT_L(0); PG8_MMA(0, 1, At, B1); PG8_BAR;
            PG8_STAGE(PG8_SA(0, 0), a2, voffA);
            PG8_BAR; PG8_WAIT_L(0); PG8_BAR; PG8_SCHED;
            PG8_STAGE(PG8_SB(0, 1), b2 + hstep, voffB);
            PG8_WAIT_V(6); PG8_BAR; PG8_BAR;
            PG8_LDB(B0, 1, 0); PG8_SCHED; PG8_LDA(At, 1, 0); PG8_STAGE(PG8_SA(0, 1), a2 + hstep, voffA);
            PG8_WAIT_L(8); PG8_BAR; PG8_WAIT_L(0); PG8_MMA(0, 0, At, B0); PG8_BAR; PG8_SCHED;
            PG8_LDB(B1, 1, 1); PG8_STAGE(PG8_SB(1, 0), b3, voffB);
            PG8_BAR; PG8_WAIT_L(0); PG8_MMA(0, 1, At, B1); PG8_BAR;
            PG8_STAGE(PG8_SA(1, 0), a3, voffA);
            PG8_BAR; PG8_WAIT_L(0); PG8_BAR; PG8_SCHED;
            PG8_STAGE(PG8_SB(1, 1), b3 + hstep, voffB);
            PG8_WAIT_V(6); PG8_BAR; PG8_BAR;
            }
        }
        if constexpr (ALIGN_EPI) { if (wr == 0) PG8_BAR; }
        { bool fin = true; if (cur.nsplit > 1) fin = S.split_combine(acc, cur, wid, lane); if (fin) E.half(acc, cur, wr, wc, fr, fq); S.done(cur); }
        }
        if (!has_next) break;
#pragma unroll
        for (int a = 0; a < 2; ++a)
#pragma unroll
            for (int b = 0; b < 2; ++b)
#pragma unroll
                for (int m = 0; m < 4; ++m)
#pragma unroll
                    for (int n = 0; n < 2; ++n) acc[a][b][m][n] = (f32x4){0.f, 0.f, 0.f, 0.f};
        cur = nxt; cA = nA; cB = nB; ++ui;
        if constexpr (ALIGN_EPI) { if (wr == 1) PG8_BAR; }
    }
    PG8_WAIT_V(0);
    if constexpr (!ALIGN_EPI) { if (wr == 0) PG8_BAR; }
    PG8_BAR;
    if constexpr (Epi::AFTER_DRAIN) { E.fused(acc, cur, wr, wc, fr, fq, lds, wid, lane); S.done(cur); }
#undef PG8_SA
#undef PG8_SB
#undef PG8_STAGE
#undef PG8_LDA
#undef PG8_LDB
#undef PG8_MMA
#undef PG8_WAIT_V
#undef PG8_WAIT_L
#undef PG8_BAR
#undef PG8_SCHED
}
}

#ifndef PG8_SP2
#define PG8_SP2 true
#endif
#ifndef PG8_ALIGN
#define PG8_ALIGN true
#endif
#ifndef MK_PER_PHASE
#define MK_PER_PHASE 0
#endif

#ifndef EN_P0
#define EN_P0 1
#endif
#ifndef EN_RG0
#define EN_RG0 1
#endif
#ifndef EN_RG1
#define EN_RG1 1
#endif
#ifndef EN_ATT
#define EN_ATT 1
#endif
#ifndef EN_GU
#define EN_GU 1
#endif
#ifndef EN_DN
#define EN_DN 1
#endif
#ifndef EN_WIN
#define EN_WIN 1
#endif
#ifndef EN_KV
#define EN_KV 1
#endif
#ifndef EN_Q
#define EN_Q 1
#endif
#ifndef EN_RES
#define EN_RES 1
#endif
constexpr int NWAVES = 8;
constexpr int DM = 2048, DFF = 5632, NHEAD = 16;
constexpr int MROWS = 16896;
constexpr int ROW_P0 = 16, ROW_S0 = 16400, ROWS_REAL = 16656;
constexpr int KS_ROWS = 2112;
constexpr float LAM_INIT = 0.3555090675909693f;
constexpr float LOG2E = 1.4426950408889634f;
constexpr int NPHASE = 17;
constexpr size_t O_YP = 0, O_YS = 33554432, O_KP = 34078720, O_VP = 67665920, O_CP = 101253120, O_HP = 101259264, O_KS = 101261312, O_VS = 101785600, O_CS = 102309888, O_HS = 102408192, O_END = 102440960;

constexpr size_t MiB = 1u << 20;
constexpr size_t WS_CTL = 0, CTL_ZERO_BYTES = 1 * MiB;
constexpr size_t WS_GW = 1 * MiB;
constexpr size_t WS_WGU = 2 * MiB;
constexpr size_t WS_WDN = 178 * MiB;
constexpr size_t WS_WIN = 266 * MiB, WS_WOUT = 282 * MiB, WS_WKV = 290 * MiB, WS_WQ = 306 * MiB, WS_WO = 314 * MiB;
constexpr size_t WS_X16 = 322 * MiB;
constexpr size_t WS_BIG = 388 * MiB;
constexpr size_t WS_ACT = 586 * MiB;
constexpr size_t WS_KP = 652 * MiB, WS_VP = 717 * MiB;
constexpr size_t WS_KS = 782 * MiB, WS_VS = 914 * MiB;
constexpr size_t WS_TS = 1046 * MiB;
constexpr size_t WS_SLAB = 1048 * MiB;
constexpr size_t WS_AB = 1112 * MiB;
constexpr size_t WS_END = 1244 * MiB;
constexpr int CW_TMO = 0, CW_ATTQ = 64, CW_SCONV = 256, CW_BAR = 4096;
constexpr size_t CTL_SSQ = 65536;
constexpr size_t CTL_SCNT = 524288;
static_assert(CTL_SSQ + 6 * (size_t)MROWS * 4 <= CTL_SCNT && CTL_SCNT + 17 * 128 * 8 * 4 <= CTL_ZERO_BYTES, "ctl");

constexpr int RING_OFF = 0, RING_BYTES = 131072;
constexpr int LDSCTL_OFF = RING_BYTES, MISC_OFF = LDSCTL_OFF + 320;
constexpr int LDS_BYTES = 147456;

#define GAS __attribute__((address_space(1)))
#define LAS __attribute__((address_space(3)))
typedef unsigned short bf16;
typedef unsigned v4u __attribute__((ext_vector_type(4)));
typedef unsigned v2u __attribute__((ext_vector_type(2)));
typedef float f32x4 __attribute__((ext_vector_type(4)));
typedef float f32x2 __attribute__((ext_vector_type(2)));
typedef float f32x16 __attribute__((ext_vector_type(16)));
typedef short bf16x8 __attribute__((ext_vector_type(8)));
typedef short s16x4 __attribute__((ext_vector_type(4)));
typedef GAS unsigned gu32;
#define RLX_AGENT __ATOMIC_RELAXED, __HIP_MEMORY_SCOPE_AGENT
#define LDS_WAIT() asm volatile("s_waitcnt lgkmcnt(0)" ::: "memory")
#define VM_WAIT() asm volatile("s_waitcnt vmcnt(0)" ::: "memory")
__device__ __forceinline__ unsigned pk2(float lo, float hi) { typedef __bf16 bf16x2_t __attribute__((ext_vector_type(2))); f32x2 v = {lo, hi}; bf16x2_t b = __builtin_convertvector(v, bf16x2_t); return __builtin_bit_cast(unsigned, b); }
__device__ __forceinline__ unsigned f2bf(float f) { return pk2(f, 0.f) & 0xffffu; }
__device__ __forceinline__ float bf2f(bf16 b) { return __builtin_bit_cast(float, ((unsigned)b) << 16); }
__device__ __forceinline__ float wave_sum(float v) {
#pragma unroll
    for (int o = 1; o < 64; o <<= 1) v += __shfl_xor(v, o);
    return v;
}

#define XB_TMO      128
#define XB_XCNT(j)  (256  + 64 * (j))
#define XB_XSUB(j)  (1280 + 64 * (j))
#define XB_XGEN(j)  (2304 + 64 * (j))
#define XB_TOP      3328
#define XB_TOPGEN   3392
#define XCD_BAR_WORDS 3456
#define XB_SPIN_CAP (1u << 18)

__device__ __forceinline__ unsigned xb_ld(unsigned* p)              { return __hip_atomic_load(p, __ATOMIC_RELAXED, __HIP_MEMORY_SCOPE_AGENT); }
__device__ __forceinline__ unsigned xb_add(unsigned* p, unsigned v) { return __hip_atomic_fetch_add(p, v, __ATOMIC_RELAXED, __HIP_MEMORY_SCOPE_AGENT); }
__device__ __forceinline__ unsigned xb_xcc_id() { return (unsigned)__builtin_amdgcn_s_getreg((3 << 11) | 20) & 0xFu; }
#define XB_SPIN(cond, bar) do { unsigned _sp = 0; while (cond) { __builtin_amdgcn_s_sleep(1); \
    if ((++_sp & 255u) == 0u) { if (xb_ld(&(bar)[XB_TMO])) break; if (_sp > XB_SPIN_CAP) { atomicAdd(&(bar)[XB_TMO], 1u); break; } } } } while (0)

struct XcdBarrier {
    unsigned* bar; unsigned x;
    volatile LAS unsigned* st;
};

__device__ __forceinline__ XcdBarrier xcd_barrier_post(unsigned* bar, volatile LAS unsigned* st) {
    XcdBarrier b; b.bar = bar; b.x = xb_xcc_id(); b.st = st;
    if (threadIdx.x == 0) (void)xb_add(&bar[XB_XCNT(b.x)], 1u);
    return b;
}
__device__ __forceinline__ void xcd_barrier_complete(unsigned* bar, unsigned x, unsigned& nloc, unsigned& nx) {
    const unsigned G = gridDim.x * gridDim.y * gridDim.z;
    unsigned sum, cnt, mine, sp = 0u;
    for (;;) {
        sum = 0u; cnt = 0u; mine = 0u;
#pragma unroll
        for (unsigned j = 0; j < 16; ++j) { const unsigned c = xb_ld(&bar[XB_XCNT(j)]); sum += c; cnt += (c > 0u) ? 1u : 0u; mine = (j == x) ? c : mine; }
        if (sum == G) break;
        __builtin_amdgcn_s_sleep(1);
        if ((++sp & 255u) == 0u) { if (xb_ld(&bar[XB_TMO])) break; if (sp > XB_SPIN_CAP) { atomicAdd(&bar[XB_TMO], 1u); break; } }
    }
    nloc = mine > 0u ? mine : 1u; nx = cnt > 0u ? cnt : 1u;
}

__device__ __forceinline__ void xcd_barrier(const XcdBarrier& b) {
    asm volatile("s_waitcnt vmcnt(0)" ::: "memory");
    __syncthreads();
    if (threadIdx.x == 0) {
        unsigned* bar = b.bar;
        __builtin_amdgcn_s_waitcnt(0);
        unsigned nloc = b.st[0], nx = b.st[1];
        if (nloc == 0u) { xcd_barrier_complete(bar, b.x, nloc, nx); b.st[0] = nloc; b.st[1] = nx; }
        const unsigned old = xb_add(&bar[XB_XSUB(b.x)], 1u);
        const unsigned gen = old / nloc;
        if (old + 1u == (gen + 1u) * nloc) {
            __builtin_amdgcn_fence(__ATOMIC_RELEASE, "agent");
            asm volatile("s_waitcnt vmcnt(0)" ::: "memory");
            const unsigned og = xb_add(&bar[XB_TOP], 1u);
            const unsigned tg = og / nx;
            if (og + 1u == (tg + 1u) * nx) xb_add(&bar[XB_TOPGEN], 1u);
            else XB_SPIN(xb_ld(&bar[XB_TOPGEN]) == tg, bar);
            __builtin_amdgcn_fence(__ATOMIC_ACQUIRE, "agent");
            xb_add(&bar[XB_XGEN(b.x)], 1u);
            asm volatile("s_waitcnt vmcnt(0)" ::: "memory");
        } else {
            XB_SPIN(xb_ld(&bar[XB_XGEN(b.x)]) == gen, bar);
            __builtin_amdgcn_fence(__ATOMIC_ACQUIRE, "agent");
            asm volatile("s_waitcnt vmcnt(0)" ::: "memory");
        }
    }
    __syncthreads();
}

struct Args { const float* in[28]; float* out; unsigned char* ws; int ph_lo, ph_hi; };
typedef const __attribute__((address_space(4))) Args CArgs;
__device__ __forceinline__ CArgs* largs() { CArgs* p = (CArgs*)__builtin_amdgcn_kernarg_segment_ptr(); asm volatile("" : "+s"(p)); return p; }
__device__ __forceinline__ int lbid() { int b = (int)blockIdx.x; asm volatile("" : "+s"(b)); return b; }
struct Frame {
    LAS unsigned char* lds;
    volatile LAS unsigned* MISC;
    int tid, lane, wave, G;
};
#define P_IN(i) (args.in[i])
#define P_WS(T, off) ((T*)(args.ws + (off)))
#define P_GW P_WS(bf16, WS_GW)
#define P_WGU P_WS(bf16, WS_WGU)
#define P_WDN P_WS(bf16, WS_WDN)
#define P_WIN P_WS(bf16, WS_WIN)
#define P_WOUT P_WS(bf16, WS_WOUT)
#define P_WKV P_WS(bf16, WS_WKV)
#define P_WQ P_WS(bf16, WS_WQ)
#define P_WO P_WS(bf16, WS_WO)
#define P_X16 P_WS(bf16, WS_X16)
#define P_HID P_WS(bf16, WS_BIG)
#define P_GG P_WS(bf16, WS_BIG)
#define P_XB P_WS(float, WS_BIG + 66 * MiB)
#define P_A3 P_WS(bf16, WS_BIG)
#define P_ACT P_WS(bf16, WS_ACT)
#define P_KP P_WS(bf16, WS_KP)
#define P_VP P_WS(bf16, WS_VP)
#define P_KS P_WS(bf16, WS_KS)
#define P_VS P_WS(bf16, WS_VS)
#define P_TS P_WS(float, WS_TS)
#define P_SSQ P_WS(float, CTL_SSQ)
#define P_CTL ((gu32*)(args.ws + WS_CTL))
#define P_SLAB P_WS(float, WS_SLAB)
#define P_SCNT ((unsigned*)(args.ws + CTL_SCNT))
#define P_OUT (args.out)
enum { I_XP = 0, I_XS, I_CK, I_CV, I_SCONV, I_SH, I_META, I_FNORM, I_WG, I_WU, I_WD, I_RGNORM, I_RGWIN, I_CONVW, I_CONVB, I_GATEW, I_GATEB, I_LAMBDA, I_RGWOUT, I_KVNORM, I_WKV, I_KNORM, I_ATTNNORM, I_WQ, I_QNORM, I_DLAM, I_SUBNORM, I_WOP };

__device__ __forceinline__ void cvt_item(const float* W, int ldw, int n0, int k0, const float* gain, bf16* dst, int K, LAS float* scr, int lane) {
    float wv[32];
#pragma unroll
    for (int i = 0; i < 32; ++i) wv[i] = W[(size_t)(k0 + 2 * i + (lane >> 5)) * ldw + n0 + (lane & 31)];
#pragma unroll
    for (int i = 0; i < 32; ++i) { const int kk = 2 * i + (lane >> 5); const float g = gain ? gain[k0 + kk] : 1.f; scr[kk * 33 + (lane & 31)] = wv[i] * g; }
    LDS_WAIT(); asm volatile("" ::: "memory");
    const int c = lane & 7;
#pragma unroll
    for (int j = 0; j < 4; ++j) { const int n = (lane >> 3) + 8 * j; const LAS float* s = scr + (8 * c) * 33 + n;
        v4u o; o.x = pk2(s[0 * 33], s[1 * 33]); o.y = pk2(s[2 * 33], s[3 * 33]); o.z = pk2(s[4 * 33], s[5 * 33]); o.w = pk2(s[6 * 33], s[7 * 33]);
        *(GAS v4u*)(dst + (size_t)n * K + 8 * c) = o; }
    LDS_WAIT(); asm volatile("" ::: "memory");
}
__device__ __forceinline__ int p64col(int beta) { return 256 * (beta >> 3) + 64 * (beta & 3) + 32 * ((beta >> 2) & 1); }
__device__ __forceinline__ void p0_prologue(const Frame& F, CArgs& args) {
    int tid_l = threadIdx.x; asm volatile("" : "+v"(tid_l));
    const int lane = tid_l & 63, wave = __builtin_amdgcn_readfirstlane(tid_l >> 6);
    LAS float* scr = (LAS float*)(F.lds + RING_OFF + wave * 16384);
    const int gw = lbid() * NWAVES + wave, NGW = F.G * NWAVES;
    constexpr int IT_GU = 32 * 352, IT_DN = 88 * 64, IT_44 = 32 * 128, IT_22 = 32 * 64, IT_GW = 32 * 8;
    constexpr int NIT = 4 * IT_GU + 4 * IT_DN + 2 * IT_44 + 3 * IT_22 + IT_GW;
    for (int it = gw; it < NIT; it += NGW) {
        int r = it;
        if (r < 4 * IT_GU) { const int f = r / IT_GU; r -= f * IT_GU; const int kb = r / 352, beta = r % 352, pn = beta >> 3, bj = (beta >> 2) & 1, jb = beta & 3;
            const float* src = (bj ? P_IN(I_WU) : P_IN(I_WG)) + (size_t)f * DM * DFF;
            cvt_item(src, DFF, 128 * pn + 32 * jb, 64 * kb, P_IN(I_FNORM) + f * DM, P_WGU + (size_t)f * 11264 * DM + (size_t)(32 * beta) * DM + 64 * kb, DM, scr, lane); continue; }
        r -= 4 * IT_GU;
        if (r < 4 * IT_DN) { const int f = r / IT_DN; r -= f * IT_DN; const int kb = r / 64, beta = r % 64;
            cvt_item(P_IN(I_WD) + (size_t)f * DFF * DM, DM, p64col(beta), 64 * kb, nullptr, P_WDN + (size_t)f * DM * DFF + (size_t)(32 * beta) * DFF + 64 * kb, DFF, scr, lane); continue; }
        r -= 4 * IT_DN;
        if (r < IT_44) { const int kb = r / 128, beta = r % 128; cvt_item(P_IN(I_RGWIN), 4096, p64col(beta), 64 * kb, P_IN(I_RGNORM), P_WIN + (size_t)(32 * beta) * DM + 64 * kb, DM, scr, lane); continue; }
        r -= IT_44;
        if (r < IT_44) { const int kb = r / 128, beta = r % 128; cvt_item(P_IN(I_WKV), 4096, p64col(beta), 64 * kb, P_IN(I_KVNORM), P_WKV + (size_t)(32 * beta) * DM + 64 * kb, DM, scr, lane); continue; }
        r -= IT_44;
        if (r < IT_22) { const int kb = r / 64, beta = r % 64; cvt_item(P_IN(I_RGWOUT), DM, p64col(beta), 64 * kb, nullptr, P_WOUT + (size_t)(32 * beta) * DM + 64 * kb, DM, scr, lane); continue; }
        r -= IT_22;
        if (r < IT_22) { const int kb = r / 64, beta = r % 64; cvt_item(P_IN(I_WQ), DM, p64col(beta), 64 * kb, P_IN(I_ATTNNORM), P_WQ + (size_t)(32 * beta) * DM + 64 * kb, DM, scr, lane); continue; }
        r -= IT_22;
        if (r < IT_22) { const int kb = r / 64, beta = r % 64; cvt_item(P_IN(I_WOP), DM, p64col(beta), 64 * kb, nullptr, P_WO + (size_t)(32 * beta) * DM + 64 * kb, DM, scr, lane); continue; }
        r -= IT_22;
        { const int mat = r >> 3, i8 = r & 7; cvt_item(P_IN(I_GATEW) + (size_t)mat * 16384, 128, 32 * (i8 & 3), 64 * (i8 >> 2), nullptr, P_GW + (size_t)mat * 16384 + (size_t)(32 * (i8 & 3)) * 128 + 64 * (i8 >> 2), 128, scr, lane); }
    }
    for (int m = gw; m < MROWS; m += NGW) {
        const float* src = m < ROW_P0 ? P_IN(I_META) + (size_t)m * DM : m < ROW_S0 ? P_IN(I_XP) + (size_t)(m - ROW_P0) * DM : m < ROWS_REAL ? P_IN(I_XS) + (size_t)(m - ROW_S0) * DM : nullptr;
        float s = 0.f;
#pragma unroll
        for (int j = 0; j < 4; ++j) {
            f32x4 a = (f32x4){0.f, 0.f, 0.f, 0.f}, b = a;
            if (src) { a = *(const GAS f32x4*)(src + 512 * j + 8 * lane); b = *(const GAS f32x4*)(src + 512 * j + 8 * lane + 4); }
            s += (a[0] * a[0] + a[1] * a[1]) + (a[2] * a[2] + a[3] * a[3]) + (b[0] * b[0] + b[1] * b[1]) + (b[2] * b[2] + b[3] * b[3]);
            v4u o; o.x = pk2(a[0], a[1]); o.y = pk2(a[2], a[3]); o.z = pk2(b[0], b[1]); o.w = pk2(b[2], b[3]);
            *(GAS v4u*)(P_X16 + (size_t)m * DM + 512 * j + 8 * lane) = o;
        }
        s = wave_sum(s);
        if (lane == 0) P_SSQ[m] = s;
    }
}

constexpr int RG_XC = 0, RG_G = 17408, RG_SQ = RG_G + 2 * 64 * 528, RG_XCS = 272, RG_GS = 528;
template <int MODE> __device__ __forceinline__ void rg_phase(const Frame& F, CArgs& args) {
    LAS unsigned char* L = F.lds + RING_OFF;
    int tid_l = threadIdx.x; asm volatile("" : "+v"(tid_l));
    const int tid = tid_l, lane = tid & 63, wave = __builtin_amdgcn_readfirstlane(tid >> 6);
    const int c = tid & 127, q = tid >> 7, fr = lane & 15, fq = lane >> 4, k2 = wave >> 2, dq = wave & 3;
    const float* XB = P_XB;
    unsigned* AB = (unsigned*)(args.ws + WS_AB);
    for (int uidx = lbid(); uidx < 81 * 16; uidx += F.G) {
        int tl, n;
        if (uidx < 1024) { tl = 1 + (uidx >> 4); n = uidx & 15; } else { const int v = uidx - 1024; n = v & 15; const int t2 = v >> 4; tl = t2 == 0 ? 0 : 64 + t2; }
        const bool smp = tl >= 65; const int b = tl - 65;
        const bool full = !smp && tl != 0;
        const int row0 = smp ? ROW_S0 + 16 * b : (tl == 0 ? 0 : 16 + 256 * (tl - 1));
        const int nsub = full ? 4 : 1, nmb = full ? 4 : 1, nq = full ? 4 : 1;
        const int ch = n * 128 + c;
        const bool act = q < nq;
        if (MODE == 0) {
            const float cw0 = P_IN(I_CONVW)[ch], cw1 = P_IN(I_CONVW)[2048 + ch], cw2 = P_IN(I_CONVW)[4096 + ch], cw3 = P_IN(I_CONVW)[6144 + ch], cb = P_IN(I_CONVB)[ch];
            const float lam = P_IN(I_LAMBDA)[ch];
            const float ls8 = -8.0f * LOG2E * log1pf(__expf(-lam));
            bf16x8 Bw[2][4]; f32x4 gb[2];
            { const bf16* gwp = P_GW + ((size_t)(k2 * 16 + n) * 128 + 32 * dq + fr) * 128 + 8 * fq;
#pragma unroll
              for (int nb = 0; nb < 2; ++nb) {
#pragma unroll
                  for (int ks = 0; ks < 4; ++ks) Bw[nb][ks] = *(const GAS bf16x8*)(gwp + (size_t)(16 * nb) * 128 + 32 * ks);
                  gb[nb] = *(const GAS f32x4*)(P_IN(I_GATEB) + k2 * 2048 + n * 128 + 32 * dq + 16 * nb + 4 * fq); } }
            float At = 1.f, Bt = 0.f;
            float vn[19];
#define RG_LOADV(dst, ss) do { _Pragma("unroll") for (int j = 0; j < 19; ++j) { const int T = 64 * (ss) + 16 * q - 3 + j; float x = 0.f; \
                if (act) { if (smp) x = T >= 0 ? XB[(size_t)(row0 + T) * DM + ch] : P_IN(I_SCONV)[((size_t)b * 3 + 3 + T) * DM + ch]; \
                           else { const int g = row0 + T; x = g >= 0 ? XB[(size_t)g * DM + ch] : 0.f; } } \
                dst[j] = x; } } while (0)
            RG_LOADV(vn, 0);
            for (int s = 0; s < nsub; ++s) {
                float xc[16], v[19];
                const int T0 = 64 * s + 16 * q;
#pragma unroll
                for (int j = 0; j < 19; ++j) v[j] = vn[j];
                if (s + 1 < nsub) RG_LOADV(vn, s + 1);
#pragma unroll
                for (int i = 0; i < 16; ++i) { xc[i] = cb + cw0 * v[i] + cw1 * v[i + 1] + cw2 * v[i + 2] + cw3 * v[i + 3];
                    if (act) *(LAS bf16*)(L + RG_XC + (16 * q + i) * RG_XCS + 2 * c) = (bf16)f2bf(xc[i]); }
                __syncthreads();
#pragma unroll
                for (int m = 0; m < 4; ++m) {
                    if (m < nmb) {
                        f32x4 acc0 = (f32x4){0.f, 0.f, 0.f, 0.f}, acc1 = acc0;
#pragma unroll
                        for (int ks = 0; ks < 4; ++ks) { const bf16x8 a = *(const LAS bf16x8*)(L + RG_XC + (16 * m + fr) * RG_XCS + 64 * ks + 16 * fq);
                            acc0 = __builtin_amdgcn_mfma_f32_16x16x32_bf16(Bw[0][ks], a, acc0, 0, 0, 0); acc1 = __builtin_amdgcn_mfma_f32_16x16x32_bf16(Bw[1][ks], a, acc1, 0, 0, 0); }
                        f32x4 g0, g1;
#pragma unroll
                        for (int e = 0; e < 4; ++e) { g0[e] = pg8::fast_sigmoid(acc0[e] + gb[0][e]); g1[e] = pg8::fast_sigmoid(acc1[e] + gb[1][e]); }
                        LAS unsigned char* gp = L + RG_G + k2 * (64 * RG_GS) + (16 * m + fr) * RG_GS + (32 * dq + 4 * fq) * 4;
                        *(LAS f32x4*)gp = g0; *(LAS f32x4*)(gp + 64) = g1;
                    }
                }
                __syncthreads();
                float A = 1.f, B = 0.f;
#pragma unroll
                for (int i = 0; i < 16; ++i) {
                    if (act) { const float r = *(const LAS float*)(L + RG_G + (16 * q + i) * RG_GS + 4 * c), ig = *(const LAS float*)(L + RG_G + 64 * RG_GS + (16 * q + i) * RG_GS + 4 * c);
                        const float a = __builtin_amdgcn_exp2f(r * ls8), bb = __builtin_sqrtf(fmaxf(1.f - a * a, 0.f)) * (ig * xc[i]);
                        const unsigned w = pk2(1.f - a, bb);
                        const int T = T0 + i; const size_t row = (size_t)(row0 + T);
                        AB[row * DM + ch] = w;
                        const float ar = 1.f - __uint_as_float(w << 16), br = __uint_as_float(w & 0xffff0000u);
                        A *= ar; B = ar * B + br;
                        if (smp) { if (T >= 13) P_OUT[O_CS + ((size_t)b * 3 + (T - 13)) * DM + ch] = v[i + 3]; }
                        else { if (row >= 16397) P_OUT[O_CP + (row - 16397) * DM + ch] = v[i + 3]; }
                    }
                }
                *(LAS f32x2*)(L + RG_SQ + (q * 128 + c) * 8) = (f32x2){A, B};
                __syncthreads();
                float As = 1.f, Bs = 0.f;
#pragma unroll
                for (int qq = 0; qq < 4; ++qq) { const f32x2 sq = *(const LAS f32x2*)(L + RG_SQ + (qq * 128 + c) * 8); Bs = sq.x * Bs + sq.y; As *= sq.x; }
                Bt = As * Bt + Bs; At = As * At;
            }
            if (q == 0 && !smp) *(GAS f32x2*)(P_TS + ((size_t)tl * 2048 + ch) * 2) = (f32x2){At, Bt};
#undef RG_LOADV
        } else {
            float hc = 0.f;
            if (smp) hc = P_IN(I_SH)[b * 2048 + ch];
            else {
                float As = 1.f, Bs = 0.f;
#pragma unroll
                for (int hb = 0; hb < 2; ++hb) { f32x2 ab[8];
#pragma unroll
                    for (int k = 0; k < 8; ++k) { const int i = 16 * q + 8 * hb + k; ab[k] = i < tl ? *(const GAS f32x2*)(P_TS + ((size_t)i * 2048 + ch) * 2) : (f32x2){1.f, 0.f}; }
#pragma unroll
                    for (int k = 0; k < 8; ++k) { Bs = ab[k].x * Bs + ab[k].y; As *= ab[k].x; } }
                *(LAS f32x2*)(L + RG_SQ + (q * 128 + c) * 8) = (f32x2){As, Bs};
                __syncthreads();
#pragma unroll
                for (int qq = 0; qq < 4; ++qq) { const f32x2 sg = *(const LAS f32x2*)(L + RG_SQ + (qq * 128 + c) * 8); hc = sg.x * hc + sg.y; }
                __syncthreads();
            }
            unsigned wn[16]; unsigned short gn[16];
#define RG_LOADAB(ss) do { _Pragma("unroll") for (int i = 0; i < 16; ++i) { const size_t row = (size_t)(row0 + 64 * (ss) + 16 * q + i); wn[i] = act ? AB[row * DM + ch] : 0u; gn[i] = act ? P_GG[row * DM + ch] : (unsigned short)0; } } while (0)
            RG_LOADAB(0);
            for (int s = 0; s < nsub; ++s) {
                unsigned w[16]; unsigned short gg[16];
#pragma unroll
                for (int i = 0; i < 16; ++i) { w[i] = wn[i]; gg[i] = gn[i]; }
                if (s + 1 < nsub) RG_LOADAB(s + 1);
                const int T0 = 64 * s + 16 * q;
                float A = 1.f, B = 0.f;
#pragma unroll
                for (int i = 0; i < 16; ++i) { const float ar = 1.f - __uint_as_float(w[i] << 16), br = __uint_as_float(w[i] & 0xffff0000u); A *= ar; B = ar * B + br; }
                *(LAS f32x2*)(L + RG_SQ + (q * 128 + c) * 8) = (f32x2){A, B};
                __syncthreads();
                float h = hc, hn = hc;
#pragma unroll
                for (int qq = 0; qq < 4; ++qq) { const f32x2 sq = *(const LAS f32x2*)(L + RG_SQ + (qq * 128 + c) * 8); if (qq < q) h = sq.x * h + sq.y; hn = sq.x * hn + sq.y; }
                hc = hn;
                __syncthreads();
                if (act) {
#pragma unroll
                    for (int i = 0; i < 16; ++i) {
                        const float ar = 1.f - __uint_as_float(w[i] << 16), br = __uint_as_float(w[i] & 0xffff0000u);
                        h = ar * h + br;
                        const int T = T0 + i; const size_t row = (size_t)(row0 + T);
                        P_ACT[row * DM + ch] = (bf16)f2bf(bf2f(gg[i]) * h);
                        if (smp) { if (T == 15) P_OUT[O_HS + (size_t)b * DM + ch] = h; }
                        else { if (row == 16399) P_OUT[O_HP + ch] = h; }
                    }
                }
            }
#undef RG_LOADAB
        }
    }
}

namespace att {
typedef __attribute__((address_space(3))) const char* lcp;
constexpr int KSLOT = 16384, VRING = 65536, STG_OFF = 65536, STG_ROW = 272;
__device__ __forceinline__ int crow(int r, int hi) { return (r & 3) + 8 * (r >> 2) + 4 * hi; }
__device__ __forceinline__ void glds16(const void* gsrc, unsigned lds_dst) { unsigned keep;
    asm volatile("s_mov_b32 %0, m0\n\ts_mov_b32 m0, %2\n\ts_nop 0\n\tglobal_load_lds_dwordx4 %1, off\n\ts_mov_b32 m0, %0" : "=&s"(keep) : "v"(gsrc), "s"(lds_dst) : "memory"); }
__device__ __forceinline__ s16x4 vtr(lcp p) { typedef short v4i16_t __attribute__((ext_vector_type(4))); return __builtin_bit_cast(s16x4, __builtin_amdgcn_ds_read_tr16_b64_v4i16((__attribute__((address_space(3))) v4i16_t*)p)); }
__device__ __forceinline__ unsigned cvtpk(float lo, float hi) { typedef __bf16 bf16x2_t __attribute__((ext_vector_type(2))); f32x2 v = {lo, hi}; bf16x2_t b = __builtin_convertvector(v, bf16x2_t); return __builtin_bit_cast(unsigned, b); }
#define ATT_WAIT_BAR(N) asm volatile("s_waitcnt vmcnt(" #N ") lgkmcnt(0)\n\ts_barrier" ::: "memory")
struct UnitDesc { const bf16* Kb; const bf16* Vb; int qrow0, kb0, NT, NTF, h, sample, nvalid, dyn; float mref; };

template <int THR> __device__ __forceinline__ void attn_unit_s(LAS unsigned char* lds, const bf16* Q, bf16* O, const UnitDesc U, const float slope2, const float lam, const float* subg) {
    int tid_l = threadIdx.x; asm volatile("" : "+v"(tid_l));
    const int tid = tid_l, lane = tid & 63, r32 = lane & 31, hi = lane >> 5; const int wid = __builtin_amdgcn_readfirstlane(tid >> 6), rg = wid & 3, cc = wid >> 2;
    const unsigned lds0 = (unsigned)(uintptr_t)lds;
    const lcp L3 = (lcp)lds;
    const int qrow = U.qrow0 + (U.sample ? 0 : 32 * rg) + r32;
    const int qpos = U.sample ? 2064 + r32 : qrow;
    const int t_first = U.sample ? 0 : 1 - (rg >> 1);
    const bool wactive = U.sample ? (rg == 0) : true;
    const int NT = U.NT;
    const int kkey0 = 8 * wid + (lane >> 4);
    const bf16* ksrc = U.Kb + (size_t)kkey0 * DM + U.h * 128 + (((lane & 15) ^ (kkey0 & 15)) * 8);
    const bf16* ksrc2 = U.Kb + (size_t)(kkey0 + 4) * DM + U.h * 128 + (((lane & 15) ^ ((kkey0 + 4) & 15)) * 8);
    const bf16* vsrc = U.Vb + (size_t)(32 * (wid & 1) + (lane >> 2)) * DM + U.h * 128 + (wid >> 1) * 32 + (lane & 3) * 8;
    const unsigned kdst = lds0 + 2048u * (unsigned)wid, vdst = lds0 + VRING + 2048u * (unsigned)wid;
#define ATT_DMA_K(t) do { int kb_ = U.kb0 - 64 * (t); kb_ = kb_ < 0 ? 0 : kb_; const size_t ro_ = (size_t)kb_ * DM; const unsigned so_ = (unsigned)(((t) & 3) * KSLOT); \
        glds16(ksrc + ro_, (unsigned)__builtin_amdgcn_readfirstlane(kdst + so_)); glds16(ksrc2 + ro_, (unsigned)__builtin_amdgcn_readfirstlane(kdst + so_ + 1024u)); } while (0)
#define ATT_DMA_V(t) do { int kb_ = U.kb0 - 64 * (t); kb_ = kb_ < 0 ? 0 : kb_; const size_t ro_ = (size_t)kb_ * DM; const unsigned so_ = (unsigned)(((t) & 3) * KSLOT); \
        glds16(vsrc + ro_, (unsigned)__builtin_amdgcn_readfirstlane(vdst + so_)); glds16(vsrc + ro_ + 16 * DM, (unsigned)__builtin_amdgcn_readfirstlane(vdst + so_ + 1024u)); } while (0)
    bf16x8 qf[4];
    { const bf16* qp = Q + (size_t)qrow * DM + U.h * 128 + cc * 64 + hi * 8;
#pragma unroll
      for (int d0 = 0; d0 < 4; ++d0) qf[d0] = *(const GAS bf16x8*)(qp + d0 * 16); }
    asm volatile("s_waitcnt vmcnt(0)" ::: "memory");
    ATT_DMA_K(0); ATT_DMA_V(0);
    if (NT > 1) { ATT_DMA_K(1); ATT_DMA_V(1); }
    if (NT > 2) ATT_DMA_K(2);
    const bool dyn = U.dyn != 0;
    float m = dyn ? 0.f : U.mref, l = 0.f; bool first = dyn;
    f32x16 o[4];
#pragma unroll
    for (int d = 0; d < 4; ++d)
#pragma unroll
        for (int r = 0; r < 16; ++r) o[d][r] = 0.f;
    f32x16 pA0, pA1; v4u pw[4];
#define ATT_QK(tt, P0, P1) do { int kb = U.kb0 - 64 * (tt); kb = kb < 0 ? 0 : kb; \
        const bool gen = ((tt) == t_first) || (!U.sample && (tt) == U.NTF - 1); \
        if (gen) { const int vhi = (!U.sample && (tt) == U.NTF - 1) ? 16 : (U.sample ? 2080 : (1 << 30)); \
            _Pragma("unroll") for (int r = 0; r < 16; ++r) { const int kp = kb + crow(r, hi); \
                P0[r] = kp < vhi ? -slope2 * __builtin_fabsf((float)(qpos - kp)) - m : -INFINITY; \
                P1[r] = kp + 32 < vhi ? -slope2 * __builtin_fabsf((float)(qpos - kp - 32)) - m : -INFINITY; } \
        } else { const float tb = slope2 * (float)(kb + 4 * hi - qpos) - m; \
            const float s8_ = 8.0f * slope2, s32_ = 32.0f * slope2; \
            _Pragma("unroll") for (int r = 0; r < 16; ++r) { P0[r] = (r == 0) ? tb : ((r & 3) == 0 ? P0[r - 4] + s8_ : P0[r - 1] + slope2); P1[r] = P0[r] + s32_; } } \
        const lcp kp_ = L3 + (unsigned)(((tt) & 3) * KSLOT) + r32 * 256; \
        bf16x8 ka0_[2], ka1_[2]; { const int po_ = ((8 * cc + hi) ^ (r32 & 15)) * 16; ka0_[0] = *(const LAS bf16x8*)(kp_ + po_); ka1_[0] = *(const LAS bf16x8*)(kp_ + po_ + 32 * 256); }     \
        _Pragma("unroll") for (int d0 = 0; d0 < 4; ++d0) { \
            if (d0 + 1 < 4) { const int po_ = ((8 * cc + 2 * (d0 + 1) + hi) ^ (r32 & 15)) * 16; ka0_[(d0 + 1) & 1] = *(const LAS bf16x8*)(kp_ + po_); ka1_[(d0 + 1) & 1] = *(const LAS bf16x8*)(kp_ + po_ + 32 * 256); } \
            P0 = __builtin_amdgcn_mfma_f32_32x32x16_bf16(ka0_[d0 & 1], qf[d0], P0, 0, 0, 0); P1 = __builtin_amdgcn_mfma_f32_32x32x16_bf16(ka1_[d0 & 1], qf[d0], P1, 0, 0, 0); } } while (0)
#define ATT_PV(tt) do { const lcp vp = L3 + VRING + (unsigned)(((tt) & 3) * KSLOT) + (4 * hi + ((lane & 15) >> 2)) * 64 + ((lane >> 4) & 1) * 32 + (lane & 3) * 8; \
        s16x4 vl_[3], vh_[3]; vl_[0] = vtr(vp); vh_[0] = vtr(vp + 512); vl_[1] = vtr(vp + 1024); vh_[1] = vtr(vp + 1024 + 512);     \
        _Pragma("unroll") for (int i16 = 0; i16 < 16; ++i16) { const int db = i16 >> 2, ks = i16 & 3; \
            if (i16 + 2 < 16) { vl_[(i16 + 2) % 3] = vtr(vp + (i16 + 2) * 1024); vh_[(i16 + 2) % 3] = vtr(vp + (i16 + 2) * 1024 + 512); } \
            const s16x4 lo = vl_[i16 % 3], hh = vh_[i16 % 3]; \
            const bf16x8 a = (bf16x8){lo[0], lo[1], lo[2], lo[3], hh[0], hh[1], hh[2], hh[3]}; \
            o[db] = __builtin_amdgcn_mfma_f32_32x32x16_bf16(a, __builtin_bit_cast(bf16x8, pw[ks]), o[db], 0, 0, 0); } \
        __builtin_amdgcn_sched_barrier(0); } while (0)
#define ATT_STEP(t, PC0, PC1) do { \
        { const int nw_ = (((t) + 2 < NT) ? 2 : 0) + (((t) + 1 < NT) ? 2 : 0); if (nw_ == 4) { ATT_WAIT_BAR(4); } else if (nw_ == 2) { ATT_WAIT_BAR(2); } else { ATT_WAIT_BAR(0); } } \
        if ((t) + 3 < NT) ATT_DMA_K((t) + 3); \
        if ((t) + 2 < NT) ATT_DMA_V((t) + 2); \
        if (pvpend) { ATT_PV((t) - 1); pvpend = false; } \
        if (wactive && (t) >= t_first) { \
            ATT_QK(t, PC0, PC1); \
            if (dyn) { \
                float mx = __builtin_fmaxf(PC0[0], PC1[0]); \
                _Pragma("unroll") for (int r = 1; r < 16; ++r) mx = __builtin_fmaxf(mx, __builtin_fmaxf(PC0[r], PC1[r])); \
                { auto rr = __builtin_amdgcn_permlane32_swap(__float_as_uint(mx), __float_as_uint(mx), false, false); mx = __builtin_fmaxf(__uint_as_float(rr[0]), __uint_as_float(rr[1])); } \
                if (first || __any(mx > (float)THR)) { \
                    const float dl = first ? mx : __builtin_fmaxf(mx, 0.f); m += dl; \
                    _Pragma("unroll") for (int r = 0; r < 16; ++r) { PC0[r] -= dl; PC1[r] -= dl; } \
                    if (!first) { const float f = __builtin_amdgcn_exp2f(-dl); l *= f; \
                        _Pragma("unroll") for (int d = 0; d < 4; ++d) _Pragma("unroll") for (int r = 0; r < 16; ++r) o[d][r] *= f; } \
                    first = false; } } \
            float sacc = 0.f; \
            _Pragma("unroll") for (int r = 0; r < 16; ++r) { PC0[r] = __builtin_amdgcn_exp2f(PC0[r]); PC1[r] = __builtin_amdgcn_exp2f(PC1[r]); sacc += PC0[r] + PC1[r]; } \
            l += sacc; \
            _Pragma("unroll") for (int j = 0; j < 4; ++j) { pw[0][j] = cvtpk(PC0[2 * j], PC0[2 * j + 1]); pw[1][j] = cvtpk(PC0[8 + 2 * j], PC0[8 + 2 * j + 1]); pw[2][j] = cvtpk(PC1[2 * j], PC1[2 * j + 1]); pw[3][j] = cvtpk(PC1[8 + 2 * j], PC1[8 + 2 * j + 1]); } \
            if (cc == 0) { ATT_PV(t); } else pvpend = true; \
        } } while (0)
    if (NT > 2) { ATT_WAIT_BAR(6); } else if (NT > 1) { ATT_WAIT_BAR(4); } else { ATT_WAIT_BAR(0); }
    bool pvpend = false;
    for (int t = 0; t < NT; ++t) ATT_STEP(t, pA0, pA1);
    if (pvpend) ATT_PV(NT - 1);
#undef ATT_QK
#undef ATT_PV
#undef ATT_STEP
    { auto rr = __builtin_amdgcn_permlane32_swap(__float_as_uint(l), __float_as_uint(l), false, false); l = __uint_as_float(rr[0]) + __uint_as_float(rr[1]); }
    ATT_WAIT_BAR(0);
    const float inv = 1.0f / l;
    if (wactive && cc == 1) { const float sc = inv * lam;
#pragma unroll
        for (int db = 0; db < 4; ++db)
#pragma unroll
            for (int r = 0; r < 16; ++r) *(LAS float*)(lds + rg * 16384 + ((db * 16 + r) * 64 + lane) * 4) = o[db][r] * sc; }
    ATT_WAIT_BAR(0);
    if (wactive && cc == 0) {
        float ss = 0.f;
#pragma unroll
        for (int db = 0; db < 4; ++db)
#pragma unroll
            for (int r = 0; r < 16; ++r) { const float x = *(const LAS float*)(lds + rg * 16384 + ((db * 16 + r) * 64 + lane) * 4); const float d = o[db][r] * inv - x; o[db][r] = d; ss += d * d; }
        { auto rr = __builtin_amdgcn_permlane32_swap(__float_as_uint(ss), __float_as_uint(ss), false, false); ss = __uint_as_float(rr[0]) + __uint_as_float(rr[1]); }
        const float rs = __builtin_amdgcn_rsqf(ss * (1.0f / 128.0f) + 1e-6f) * (1.0f - LAM_INIT);
        LAS unsigned char* stg = lds + STG_OFF + rg * (32 * STG_ROW);
#pragma unroll
        for (int db = 0; db < 4; ++db)
#pragma unroll
            for (int rq = 0; rq < 4; ++rq) { const int dv = 32 * db + 8 * rq + 4 * hi; const f32x4 g = *(const GAS f32x4*)(subg + dv);
                v2u w; w.x = cvtpk(o[db][4 * rq] * rs * g[0], o[db][4 * rq + 1] * rs * g[1]); w.y = cvtpk(o[db][4 * rq + 2] * rs * g[2], o[db][4 * rq + 3] * rs * g[3]);
                *(LAS v2u*)(stg + r32 * STG_ROW + dv * 2) = w; }
        asm volatile("s_waitcnt lgkmcnt(0)" ::: "memory");
        bf16* Ow = O + (size_t)(U.qrow0 + (U.sample ? 0 : 32 * rg)) * DM + U.h * 128;
#pragma unroll
        for (int it = 0; it < 8; ++it) { const int row = it * 4 + (lane >> 4), chk = lane & 15; const v4u vv = *(const LAS v4u*)(stg + row * STG_ROW + chk * 16);
            if (row < U.nvalid) *(GAS v4u*)(Ow + (size_t)row * DM + chk * 8) = vv; }
    }
    asm volatile("s_waitcnt vmcnt(0)" ::: "memory");
    ATT_WAIT_BAR(0);
#undef ATT_DMA_K
#undef ATT_DMA_V
}
__device__ __forceinline__ void attn_unit_p(LAS unsigned char* lds, const bf16* Q, bf16* O, const UnitDesc U, const float slope2, volatile LAS unsigned* lamp, const float* subg) {
    int tid_l = threadIdx.x; asm volatile("" : "+v"(tid_l));
    const int tid = tid_l, lane = tid & 63, r32 = lane & 31, hi = lane >> 5; const int wid = __builtin_amdgcn_readfirstlane(tid >> 6);
    const unsigned lds0 = (unsigned)(uintptr_t)lds;
    const lcp L3 = (lcp)lds;
    const int qpos = U.qrow0 + 32 * wid + r32;
    const int t_first = 3 - (wid >> 1);
    const int NT = U.NT;
    const int kkey0 = 8 * wid + (lane >> 4);
    const bf16* ksrc = U.Kb + (size_t)kkey0 * DM + U.h * 128 + (((lane & 15) ^ (kkey0 & 15)) * 8);
    const int kd2 = 4 * DM + (((((lane & 15) ^ (kkey0 & 15)) & 4) != 0) ? -32 : 32);
    const bf16* vsrc = U.Vb + (size_t)(32 * (wid & 1) + (lane >> 2)) * DM + U.h * 128 + (wid >> 1) * 32 + (lane & 3) * 8;
    const unsigned kxo = (unsigned)(r32 * 256 + ((hi ^ (r32 & 15)) * 16));
    const unsigned kdst = lds0 + 2048u * (unsigned)wid, vdst = lds0 + 32768u + 2048u * (unsigned)wid;
#define ATT_DMA2(t) do { int kb_ = U.kb0 - 64 * (t); kb_ = kb_ < 0 ? 0 : kb_; const size_t ro_ = (size_t)kb_ * DM; const unsigned so_ = (unsigned)(((t) & 1) * KSLOT); \
        glds16(ksrc + ro_, (unsigned)__builtin_amdgcn_readfirstlane(kdst + so_)); glds16(ksrc + ro_ + kd2, (unsigned)__builtin_amdgcn_readfirstlane(kdst + so_ + 1024u)); \
        glds16(vsrc + ro_, (unsigned)__builtin_amdgcn_readfirstlane(vdst + so_)); glds16(vsrc + ro_ + 16 * DM, (unsigned)__builtin_amdgcn_readfirstlane(vdst + so_ + 1024u)); } while (0)
    const lcp qb_ = L3 + 65536 + wid * 8192 + lane * 16;
    { const bf16* qp = Q + (size_t)qpos * DM + U.h * 128 + hi * 8;
      bf16x8 qv[8];
#pragma unroll
      for (int f = 0; f < 8; ++f) qv[f] = *(const GAS bf16x8*)(qp + (f >> 2) * 64 + (f & 3) * 16);
#pragma unroll
      for (int f = 0; f < 8; ++f) *(LAS bf16x8*)(lds + 65536 + wid * 8192 + f * 1024 + lane * 16) = qv[f]; }
    asm volatile("s_waitcnt vmcnt(0) lgkmcnt(0)" ::: "memory");
    ATT_DMA2(0);
    const float mref = U.mref < 60.0f ? U.mref : 60.0f;
    f32x2 l0v = (f32x2){0.f, 0.f}, l1v = l0v;
    f32x16 o[2][4];
#pragma unroll
    for (int c = 0; c < 2; ++c)
#pragma unroll
        for (int d = 0; d < 4; ++d)
#pragma unroll
            for (int r = 0; r < 16; ++r) o[c][d][r] = 0.f;
    ATT_WAIT_BAR(0);
    for (int t = 0; t < NT; ++t) {
        if (t + 1 < NT) ATT_DMA2(t + 1);
        if (t >= t_first) {
            int kb = U.kb0 - 64 * t; kb = kb < 0 ? 0 : kb;
            const bool gen = (t == t_first) || (t == U.NTF - 1);
            const int vhi = (t == U.NTF - 1) ? 16 : (1 << 30);
            unsigned kxt = kxo + (unsigned)((t & 1) * KSLOT); asm volatile("" : "+v"(kxt));
            const lcp vp = L3 + 32768 + (unsigned)((t & 1) * KSLOT) + (4 * hi + ((lane & 15) >> 2)) * 64 + ((lane >> 4) & 1) * 32 + (lane & 3) * 8;
#pragma unroll
            for (int hf = 0; hf < 2; ++hf) {
                v4u pw[2][2];
#pragma unroll
                for (int c = 0; c < 2; ++c) {
                    f32x16 pp;
                    { const float tb = slope2 * (float)(kb + 32 * hf + 4 * hi - qpos), s8_ = 8.0f * slope2;
                      if (gen) {
                          const int thr = vhi - kb - 32 * hf - 4 * hi; float x = tb;
#pragma unroll
                          for (int r = 0; r < 16; ++r) { const int cr = (r & 3) + 8 * (r >> 2); x = (r == 0) ? tb : ((r & 3) == 0 ? x + (s8_ - 3.0f * slope2) : x + slope2); pp[r] = cr < thr ? -__builtin_fabsf(x) - mref : -INFINITY; }
                      } else { const float tb2 = tb - mref;
                          f32x2 b01 = (f32x2){tb2, tb2 + slope2}, b23 = b01 + (f32x2){2.0f * slope2, 2.0f * slope2};
#pragma unroll
                          for (int q4 = 0; q4 < 4; ++q4) { pp[4 * q4] = b01.x; pp[4 * q4 + 1] = b01.y; pp[4 * q4 + 2] = b23.x; pp[4 * q4 + 3] = b23.y; if (q4 < 3) { b01 += (f32x2){s8_, s8_}; b23 += (f32x2){s8_, s8_}; } } } }
                    {
                        bf16x8 ka[2], qa[2];
                        ka[0] = *(const LAS bf16x8*)(L3 + ((kxt ^ (unsigned)((8 * c) * 16)) + (unsigned)(hf * 32 * 256))); qa[0] = *(const LAS bf16x8*)(qb_ + (4 * c) * 1024);
#pragma unroll
                        for (int d0 = 0; d0 < 4; ++d0) {
                            if (d0 + 1 < 4) { ka[(d0 + 1) & 1] = *(const LAS bf16x8*)(L3 + ((kxt ^ (unsigned)((8 * c + 2 * (d0 + 1)) * 16)) + (unsigned)(hf * 32 * 256))); qa[(d0 + 1) & 1] = *(const LAS bf16x8*)(qb_ + (4 * c + d0 + 1) * 1024); }
                            pp = __builtin_amdgcn_mfma_f32_32x32x16_bf16(ka[d0 & 1], qa[d0 & 1], pp, 0, 0, 0); } }
#pragma unroll
                    for (int r = 0; r < 16; ++r) pp[r] = __builtin_amdgcn_exp2f(pp[r]);
#pragma unroll
                    for (int r = 0; r < 16; r += 2) { if (c == 0) l0v += (f32x2){pp[r], pp[r + 1]}; else l1v += (f32x2){pp[r], pp[r + 1]}; }
#pragma unroll
                    for (int j = 0; j < 4; ++j) { pw[c][0][j] = cvtpk(pp[2 * j], pp[2 * j + 1]); pw[c][1][j] = cvtpk(pp[8 + 2 * j], pp[8 + 2 * j + 1]); }
                }
                {
                    s16x4 vlo[3], vhh[3];
                    vlo[0] = vtr(vp + (2 * hf) * 1024); vhh[0] = vtr(vp + (2 * hf) * 1024 + 512);
                    vlo[1] = vtr(vp + (2 * hf + 1) * 1024); vhh[1] = vtr(vp + (2 * hf + 1) * 1024 + 512);
#pragma unroll
                    for (int i8 = 0; i8 < 8; ++i8) { const int db = i8 >> 1, k2 = i8 & 1;
                        if (i8 + 2 < 8) { const int dn = (i8 + 2) >> 1, kn = 2 * hf + ((i8 + 2) & 1); vlo[(i8 + 2) % 3] = vtr(vp + (dn * 4 + kn) * 1024); vhh[(i8 + 2) % 3] = vtr(vp + (dn * 4 + kn) * 1024 + 512); }
                        const s16x4 lo = vlo[i8 % 3], hh = vhh[i8 % 3];
                        const bf16x8 a = (bf16x8){lo[0], lo[1], lo[2], lo[3], hh[0], hh[1], hh[2], hh[3]};
                        o[0][db] = __builtin_amdgcn_mfma_f32_32x32x16_bf16(a, __builtin_bit_cast(bf16x8, pw[0][k2]), o[0][db], 0, 0, 0);
                        o[1][db] = __builtin_amdgcn_mfma_f32_32x32x16_bf16(a, __builtin_bit_cast(bf16x8, pw[1][k2]), o[1][db], 0, 0, 0); } }
                __builtin_amdgcn_sched_barrier(0);
            }
        }
        ATT_WAIT_BAR(0);
    }
    {
        float l0 = l0v.x + l0v.y, l1 = l1v.x + l1v.y;
        { auto rr = __builtin_amdgcn_permlane32_swap(__float_as_uint(l0), __float_as_uint(l0), false, false); l0 = __uint_as_float(rr[0]) + __uint_as_float(rr[1]); }
        { auto rr = __builtin_amdgcn_permlane32_swap(__float_as_uint(l1), __float_as_uint(l1), false, false); l1 = __uint_as_float(rr[0]) + __uint_as_float(rr[1]); }
        const float i0 = 1.0f / l0, i1 = __uint_as_float(lamp[0]) / l1;
        float ss = 0.f;
#pragma unroll
        for (int db = 0; db < 4; ++db)
#pragma unroll
            for (int r = 0; r < 16; ++r) { const float d = o[0][db][r] * i0 - o[1][db][r] * i1; o[0][db][r] = d; ss += d * d; }
        { auto rr = __builtin_amdgcn_permlane32_swap(__float_as_uint(ss), __float_as_uint(ss), false, false); ss = __uint_as_float(rr[0]) + __uint_as_float(rr[1]); }
        const float rs = __builtin_amdgcn_rsqf(ss * (1.0f / 128.0f) + 1e-6f) * (1.0f - LAM_INIT);
        LAS unsigned char* stg = lds + 65536 + wid * 8192;
        const float* sg_ = subg; asm volatile("" : "+s"(sg_));
#pragma unroll
        for (int db = 0; db < 4; ++db)
#pragma unroll
            for (int rq = 0; rq < 4; ++rq) { const int dv = 32 * db + 8 * rq + 4 * hi; const f32x4 g = *(const GAS f32x4*)(sg_ + dv);
                v2u w; w.x = cvtpk(o[0][db][4 * rq] * rs * g[0], o[0][db][4 * rq + 1] * rs * g[1]); w.y = cvtpk(o[0][db][4 * rq + 2] * rs * g[2], o[0][db][4 * rq + 3] * rs * g[3]);
                *(LAS v2u*)(stg + r32 * 256 + dv * 2) = w; }
        asm volatile("s_waitcnt lgkmcnt(0)" ::: "memory");
        bf16* Ow = O + (size_t)(U.qrow0 + 32 * wid) * DM + U.h * 128;
#pragma unroll
        for (int it = 0; it < 8; ++it) { const int row = it * 4 + (lane >> 4), chk = lane & 15; const v4u vv = *(const LAS v4u*)(stg + row * 256 + chk * 16);
            *(GAS v4u*)(Ow + (size_t)row * DM + chk * 8) = vv; }
    }
    asm volatile("s_waitcnt vmcnt(0) lgkmcnt(0)" ::: "memory");
    ATT_WAIT_BAR(0);
#undef ATT_DMA2
}
}


__device__ __forceinline__ void attn_conv_unit(CArgs& args, int cu) {
    int tid_l = threadIdx.x; asm volatile("" : "+v"(tid_l));
    const int lane = tid_l & 63, wave = __builtin_amdgcn_readfirstlane(tid_l >> 6);
    const __amdgpu_buffer_rsrc_t rs = __builtin_amdgcn_make_buffer_rsrc(P_KS, 0, (int)(264 * MiB), 0x00020000);
#pragma unroll 1
    for (int k = 0; k < 16; k += 2) {
        f32x4 va[2][8];
#pragma unroll
        for (int rr = 0; rr < 2; ++rr) { const int ri = 128 * cu + 16 * wave + k + rr, which = ri >> 15, idx = ri & 32767;
            const float* src = (which ? P_IN(I_CV) : P_IN(I_CK)) + (size_t)idx * DM;
#pragma unroll
            for (int j = 0; j < 4; ++j) { va[rr][2 * j] = *(const GAS f32x4*)(src + 512 * j + 8 * lane); va[rr][2 * j + 1] = *(const GAS f32x4*)(src + 512 * j + 8 * lane + 4); } }
#pragma unroll
        for (int rr = 0; rr < 2; ++rr) { const int ri = 128 * cu + 16 * wave + k + rr, which = ri >> 15, idx = ri & 32767, b = idx >> 11, p = idx & 2047;
            const unsigned off = (unsigned)(((size_t)which * 16 * KS_ROWS + (size_t)b * KS_ROWS + 16 + p) * DM * 2);
#pragma unroll
            for (int j = 0; j < 4; ++j) { const f32x4 a = va[rr][2 * j], bq = va[rr][2 * j + 1];
                v4u o; o.x = pk2(a[0], a[1]); o.y = pk2(a[2], a[3]); o.z = pk2(bq[0], bq[1]); o.w = pk2(bq[2], bq[3]);
                __builtin_amdgcn_raw_buffer_store_b128(o, rs, (int)(off + (unsigned)(512 * j + 8 * lane) * 2u), 0,   16); } }
    }
    asm volatile("s_waitcnt vmcnt(0)" ::: "memory");
    __syncthreads();
    if (threadIdx.x == 0) { const int b = ((128 * cu) & 32767) >> 11; __hip_atomic_fetch_add((unsigned*)(P_CTL + CW_SCONV) + 16 * b, 1u, __ATOMIC_RELAXED, __HIP_MEMORY_SCOPE_AGENT); }
}
__device__ __forceinline__ void attn_phase(const Frame& F, CArgs& args) {
    int ln = threadIdx.x & 63; asm volatile("" : "+v"(ln));
    float lam;
    { const float* dl = P_IN(I_DLAM); const float a = wave_sum(dl[ln] * dl[64 + ln]), b = wave_sum(dl[128 + ln] * dl[192 + ln]); lam = __expf(a) - __expf(b) + LAM_INIT; }
    float tcut, smax2;
    { float mq = __builtin_fabsf(P_IN(I_QNORM)[ln]), mk = __builtin_fabsf(P_IN(I_KNORM)[ln]);
#pragma unroll
      for (int o = 1; o < 64; o <<= 1) { mq = __builtin_fmaxf(mq, __shfl_xor(mq, o)); mk = __builtin_fmaxf(mk, __shfl_xor(mk, o)); }
      tcut = 2.0f * (8.0f * mq * mk * 1.02f) + 106.0f; smax2 = 8.0f * mq * mk * 1.02f * LOG2E; }
    if (threadIdx.x == 0) { F.MISC[20] = __float_as_uint(lam); F.MISC[21] = __float_as_uint(tcut); F.MISC[22] = __float_as_uint(smax2); }
    __syncthreads();
    const bf16* Q = P_ACT; bf16* O = P_A3;
    const int nun = 1024 + 512 + 256;
    unsigned* qctr = (unsigned*)(P_CTL + CW_ATTQ);
    for (;;) {
        if (threadIdx.x == 0) F.MISC[16] = atomicAdd(qctr, 1u);
        __syncthreads();
        const int idx = (int)F.MISC[16];
        if (idx >= nun) break;
        int uid, sunit = -1;
        if (idx < 256) uid = idx;
        else if (idx < 1280) { const int g = (idx - 256) >> 1; if (idx & 1) { attn_conv_unit(args, g); continue; } uid = 256 + g; }
        else { const int g = (idx - 1280) >> 1; if (idx & 1) sunit = g; uid = 768 + g; }
        const float tcut_u = __uint_as_float((unsigned)__builtin_amdgcn_readfirstlane((int)F.MISC[21])), smax2_u = __uint_as_float((unsigned)__builtin_amdgcn_readfirstlane((int)F.MISC[22]));
        att::UnitDesc U;
        if (sunit < 0) { const int jb = 63 - (uid >> 4); U.h = 15 - (uid & 15); U.Kb = P_KP; U.Vb = P_VP; U.qrow0 = 16 + 256 * jb; U.kb0 = 16 + 64 * (4 * jb + 3); U.NTF = 4 * jb + 5; U.sample = 0; U.nvalid = 32;
            const float slope = exp2f(-0.5f * (float)(U.h + 1));
            const float w = (tcut_u / slope + 255.0f) * (1.0f / 64.0f); const int wt = w > 1000.f ? 1000 : (int)w + 1;
            U.NT = wt < U.NTF ? wt : U.NTF; U.dyn = smax2_u < 40.0f ? 0 : 1; U.mref = smax2_u; }
        else {
            const int b = sunit >> 4;
            if (threadIdx.x == 0) { unsigned* cw = (unsigned*)(P_CTL + CW_SCONV) + 16 * b; unsigned sp = 0;
                while (__hip_atomic_load(cw, __ATOMIC_RELAXED, __HIP_MEMORY_SCOPE_AGENT) < 32u && ++sp < (1u << 22)) __builtin_amdgcn_s_sleep(2);
                __builtin_amdgcn_fence(__ATOMIC_ACQUIRE, "agent"); asm volatile("s_waitcnt vmcnt(0)" ::: "memory"); }
            __syncthreads();
            U.h = sunit & 15; U.Kb = P_KS + (size_t)b * KS_ROWS * DM; U.Vb = P_VS + (size_t)b * KS_ROWS * DM; U.qrow0 = ROW_S0 + 16 * b; U.kb0 = 2048; U.NT = 33; U.NTF = 33; U.sample = 1; U.nvalid = 16; U.dyn = 1; U.mref = 0.f; }
        const float slope2 = exp2f(-0.5f * (float)(U.h + 1)) * LOG2E;
        if (sunit < 0) att::attn_unit_p(F.lds + RING_OFF, Q, O, U, slope2, F.MISC + 20, P_IN(I_SUBNORM)); else att::attn_unit_s<8>(F.lds + RING_OFF, Q, O, U, slope2, __uint_as_float(F.MISC[20]), P_IN(I_SUBNORM));
    }
}

__global__ void __launch_bounds__(NWAVES * 64, 2) fwd_kernel(Args args_kv) {
    extern __shared__ __attribute__((aligned(16))) unsigned char lds[];
    Frame F;
    F.lds = (LAS unsigned char*)lds;
    F.MISC = (volatile LAS unsigned*)(F.lds + MISC_OFF);
    F.tid = threadIdx.x; F.lane = F.tid & 63; F.wave = __builtin_amdgcn_readfirstlane(F.tid >> 6); F.G = gridDim.x;
    for (int u = F.tid; u < (LDS_BYTES - LDSCTL_OFF) / 4; u += NWAVES * 64) ((LAS unsigned*)(F.lds + LDSCTL_OFF))[u] = 0u;
    __syncthreads();
    const Args& args = args_kv;
    const int lo = args.ph_lo, hi = args.ph_hi;
    XcdBarrier bar; bar.bar = (unsigned*)(P_CTL + CW_BAR); bar.x = 0; bar.st = nullptr;
    if (hi - lo > 1) bar = xcd_barrier_post((unsigned*)(P_CTL + CW_BAR), F.MISC + 8);
    int ph = 0;
#define RUN() (ph >= lo && ph < hi)
#define SEAM() do { if (ph >= lo && ph + 1 < hi) xcd_barrier(bar); ++ph; } while (0)
#define SEAM_NOBAR() do { if (MK_PER_PHASE) { SEAM(); } else { ++ph; } } while (0)

    if (RUN() && EN_P0) p0_prologue(F, *largs());
    SEAM();
    for (int ls = 0; ls < 4; ++ls) {
        if (RUN() && EN_GU) {
            CArgs& args = *largs();
            pg8::Gemm g{P_X16, P_WGU + (size_t)ls * 11264 * DM, MROWS, 11264, DM}; pg8::SplitOrder S; S.init(11264, DM, F.G, lbid(), 2, ph * 128, P_SLAB, P_SCNT, 120, 1);
            const int si = ls == 0 ? 0 : ls == 1 ? 2 : ls == 2 ? 3 : 5;
            pg8::EpiGU E{P_HID, P_SSQ + (size_t)si * MROWS};
            pg8::gemm_phase<pg8::EpiGU, pg8::SplitOrder, PG8_ALIGN, PG8_SP2>(F.lds + RING_OFF, g, S, E);
        }
        SEAM();
        if (RUN() && EN_DN) {
            CArgs& args = *largs();
            pg8::Gemm g{P_HID, P_WDN + (size_t)ls * DM * DFF, MROWS, DM, DFF}; pg8::SplitOrder S; S.init(DM, DFF, F.G, lbid(), 8, ph * 128, P_SLAB, P_SCNT);
            const int so = ls == 0 ? 1 : ls == 1 ? 3 : ls == 2 ? 4 : 0;
            pg8::EpiRes E{P_X16, P_SSQ + (size_t)so * MROWS, 0.5f, ls == 3 ? 1 : 0, P_OUT + O_YP, P_OUT + O_YS};
            pg8::gemm_phase<pg8::EpiRes, pg8::SplitOrder, PG8_ALIGN, PG8_SP2>(F.lds + RING_OFF, g, S, E);
        }
        SEAM();
        if (ls == 0) {
            if (RUN() && EN_WIN) {
            CArgs& args = *largs();
                pg8::Gemm g{P_X16, P_WIN, MROWS, 4096, DM}; pg8::SplitOrder S; S.init(4096, DM, F.G, lbid(), 4, ph * 128, P_SLAB, P_SCNT);
                pg8::EpiWin E{P_GG, P_XB, P_SSQ + (size_t)1 * MROWS};
                pg8::gemm_phase<pg8::EpiWin, pg8::SplitOrder, PG8_ALIGN, PG8_SP2>(F.lds + RING_OFF, g, S, E);
            }
            SEAM();
            if (RUN() && EN_RG0) rg_phase<0>(F, *largs());
            SEAM();
            if (RUN() && EN_RG1) rg_phase<1>(F, *largs());
            SEAM();
        } else if (ls == 1) {
            if (RUN() && EN_KV) {
            CArgs& args = *largs();
                pg8::Gemm g{P_X16, P_WKV, MROWS, 4096, DM}; pg8::SplitOrder S; S.init(4096, DM, F.G, lbid(), 4, ph * 128, P_SLAB + (size_t)256 * 32768, P_SCNT);
                pg8::EpiKV E{P_SSQ + (size_t)3 * MROWS, P_IN(I_KNORM), P_OUT + O_KP, P_OUT + O_VP, P_OUT + O_KS, P_OUT + O_VS, P_KP, P_VP, P_KS, P_VS};
                pg8::gemm_phase<pg8::EpiKV, pg8::SplitOrder, PG8_ALIGN, PG8_SP2>(F.lds + RING_OFF, g, S, E);
            }
            SEAM_NOBAR();
        } else if (ls == 2) {
            if (RUN() && EN_Q) {
            CArgs& args = *largs();
                pg8::Gemm g{P_X16, P_WQ, MROWS, DM, DM}; pg8::SplitOrder S; S.init(DM, DM, F.G, lbid(), 4, ph * 128, P_SLAB, P_SCNT);
                pg8::EpiQ E{P_SSQ + (size_t)4 * MROWS, P_IN(I_QNORM), P_ACT, 0.125f * LOG2E};
                pg8::gemm_phase<pg8::EpiQ, pg8::SplitOrder, PG8_ALIGN, PG8_SP2>(F.lds + RING_OFF, g, S, E);
            }
            SEAM();
            if (RUN() && EN_ATT) attn_phase(F, *largs());
            SEAM();
        }
        if (ls == 0 || ls == 2) {
            if (RUN() && EN_RES) {
            CArgs& args = *largs();
                pg8::Gemm g{ls == 0 ? P_ACT : P_A3, ls == 0 ? P_WOUT : P_WO, MROWS, DM, DM}; pg8::SplitOrder S; S.init(DM, DM, F.G, lbid(), 4, ph * 128, P_SLAB, P_SCNT);
                pg8::EpiRes E{P_X16, P_SSQ + (size_t)(ls == 0 ? 2 : 5) * MROWS, 1.0f, 0, P_OUT + O_YP, P_OUT + O_YS};
                pg8::gemm_phase<pg8::EpiRes, pg8::SplitOrder, PG8_ALIGN, PG8_SP2>(F.lds + RING_OFF, g, S, E);
            }
            SEAM();
        }
    }
#undef RUN
#undef SEAM
}

extern "C" void kernel_launch(void* const* d_in, const int* in_sizes, int n_in, void* d_out, int out_size, void* d_ws, size_t ws_size, hipStream_t stream) {
    static int grid = 0;
    if (grid == 0) {
        if (n_in != 28 || in_sizes[0] != 16384 * DM || (size_t)out_size != O_END || ws_size < WS_END) {
            fprintf(stderr, "kernel_launch: unexpected shapes: n_in %d, in0 %d, out %d, ws %zu (need %zu); nothing launched\n", n_in, n_in > 0 ? in_sizes[0] : -1, out_size, ws_size, (size_t)WS_END); grid = -1; return; }
        int dev = 0, cus = 0, per_cu = 0;
        if (hipGetDevice(&dev) != hipSuccess || hipDeviceGetAttribute(&cus, hipDeviceAttributeMultiprocessorCount, dev) != hipSuccess) { grid = -1; return; }
        if (hipFuncSetAttribute((const void*)fwd_kernel, hipFuncAttributeMaxDynamicSharedMemorySize, LDS_BYTES) != hipSuccess) { fprintf(stderr, "kernel_launch: hipFuncSetAttribute failed\n"); grid = -1; return; }
        if (hipOccupancyMaxActiveBlocksPerMultiprocessor(&per_cu, (const void*)fwd_kernel, NWAVES * 64, LDS_BYTES) != hipSuccess || per_cu < 1) { fprintf(stderr, "kernel_launch: occupancy query says %d blocks per CU\n", per_cu); }
        (void)hipGetLastError();
        grid = cus;
    }
    if (grid < 0) return;
    if (hipMemsetAsync((char*)d_ws + WS_CTL, 0, CTL_ZERO_BYTES, stream) != hipSuccess) return;
    Args a{};
    for (int i = 0; i < 28; ++i) a.in[i] = (const float*)d_in[i];
    a.out = (float*)d_out; a.ws = (unsigned char*)d_ws;
#if MK_PER_PHASE
    for (int p = 0; p < NPHASE; ++p) { a.ph_lo = p; a.ph_hi = p + 1; hipLaunchKernelGGL(fwd_kernel, dim3(grid), dim3(NWAVES * 64), LDS_BYTES, stream, a); }
#else
    a.ph_lo = 0; a.ph_hi = NPHASE;
    hipLaunchKernelGGL(fwd_kernel, dim3(grid), dim3(NWAVES * 64), LDS_BYTES, stream, a);
#endif
    const hipError_t le = hipPeekAtLastError();
    if (le != hipSuccess) fprintf(stderr, "kernel_launch: launch failed: %s\n", hipGetErrorName(le));
}
```

```cpp
#include <hip/hip_runtime.h>
#include <cstdio>
#include <cstdint>
namespace pg8 {
#define PG8_LAS __attribute__((address_space(3)))
typedef unsigned short bf16_t;
typedef short bf16x8 __attribute__((ext_vector_type(8)));
typedef float f32x4 __attribute__((ext_vector_type(4)));
typedef unsigned u32x4 __attribute__((ext_vector_type(4)));
constexpr int BM = 256, BK = 64, HALF = 128, HTB = HALF * BK * 2  , STAGE_BYTES = 8 * HTB, NXCD = 8, WGM = 8;

__host__ __device__ __forceinline__ int lds_byte(int r, int c) { const int st = (r >> 4) * 2 + (c >> 5), rr = r & 15, cc = c & 31, ob = rr * 64 + cc * 2; return st * 1024 + (ob ^ (((ob >> 9) & 1) << 5)); }
__host__ __device__ __forceinline__ void stage_rc(int b, int& R, int& C) { const int st = b / 1024, sb = b % 1024, swz = sb ^ (((sb >> 9) & 1) << 5); R = (st >> 1) * 16 + swz / 64; C = (st & 1) * 32 + (swz % 64) / 2; }
__host__ __device__ __forceinline__ int perm32(int rho) { const int n = rho >> 4, i = rho & 15; return 8 * (i >> 2) + 4 * n + (i & 3); }

struct Unit { int pm, pn, kt0, nt, nsplit, slab, cidx, half; };
struct Gemm { const bf16_t* A; const bf16_t* Bt; int M, N, K; };

struct StaticOrder {
    int nM, nN, nwg, G, c;
    __host__ __device__ void init(int M, int N, int G_, int c_) { nM = M / BM; nN = N / BM; nwg = nM * nN; G = G_; c = c_; }
    __host__ __device__ bool next(int i, Unit& u) const {
        const long L = (long)i * G + c; if (L >= nwg) return false;
        int wgid = (int)L; { const int q = nwg / NXCD, r = nwg % NXCD, xcd = wgid % NXCD, off = wgid / NXCD; wgid = (xcd < r ? xcd * (q + 1) : r * (q + 1) + (xcd - r) * q) + off; }
        const int nig = WGM * nN, gid = wgid / nig, fm = gid * WGM, gsz = (nM - fm) < WGM ? (nM - fm) : WGM;
        u.pm = 2 * (fm + ((wgid % nig) % gsz)); u.pn = (wgid % nig) / gsz; u.kt0 = 0; u.nt = 0; u.nsplit = 1; u.slab = 0; u.cidx = 0; u.half = 0; return true;
    }
    __device__ __forceinline__ void a_ready(const Unit&) const {}
    __device__ __forceinline__ void done(const Unit&) const {}
};

__device__ __forceinline__ unsigned cvt_pk_bf16(float lo, float hi) { unsigned r; asm volatile("v_cvt_pk_bf16_f32 %0, %1, %2" : "=v"(r) : "v"(lo), "v"(hi)); return r; }
constexpr float RMS_EPS = 1e-6f;
__device__ __forceinline__ float row_rstd(const float* ssq, int row) { return __builtin_amdgcn_rsqf(ssq[row] * (1.0f / 2048.0f) + RMS_EPS); }
__device__ __forceinline__ float fast_sigmoid(float x) { return __builtin_amdgcn_rcpf(1.0f + __builtin_amdgcn_exp2f(-1.4426950408889634f * x)); }
__device__ __forceinline__ u32x4 pack8(const f32x4 a, const f32x4 b) { u32x4 w; w.x = cvt_pk_bf16(a[0], a[1]); w.y = cvt_pk_bf16(a[2], a[3]); w.z = cvt_pk_bf16(b[0], b[1]); w.w = cvt_pk_bf16(b[2], b[3]); return w; }

struct EpiGU {
    static constexpr bool PERM = true, AFTER_DRAIN = false;
    bf16_t* H; const float* ssq;
    template <bool HF> __device__ __forceinline__ void run(const f32x4 (&acc)[2][2][4][2], const Unit& u, int wr, int wc, int fr, int fq) const {
        typedef float f2 __attribute__((ext_vector_type(2)));
        typedef __bf16 b2 __attribute__((ext_vector_type(2)));
        const int colh = u.pn * 128 + wc * 32 + 8 * fq;
        float rsv[8];
#pragma unroll
        for (int i = 0; i < (HF ? 4 : 8); ++i) rsv[i] = row_rstd(ssq, u.pm * HALF + (i >> 2) * HALF + wr * 64 + (i & 3) * 16 + fr);
#pragma unroll
        for (int ai = 0; ai < (HF ? 1 : 2); ++ai)
#pragma unroll
            for (int m = 0; m < 4; ++m) {
                const int row = u.pm * HALF + ai * HALF + wr * 64 + m * 16 + fr; const float rs = rsv[ai * 4 + m];
                const float nrs = -1.4426950408889634f * rs, rs2 = rs * rs;
                f2 g[4], up[4], t[4], r[4];
#pragma unroll
                for (int p = 0; p < 4; ++p) { g[p] = (f2){acc[ai][0][m][p >> 1][2 * (p & 1)], acc[ai][0][m][p >> 1][2 * (p & 1) + 1]}; up[p] = (f2){acc[ai][1][m][p >> 1][2 * (p & 1)], acc[ai][1][m][p >> 1][2 * (p & 1) + 1]}; }
#pragma unroll
                for (int p = 0; p < 4; ++p) t[p] = g[p] * (f2){nrs, nrs};
#pragma unroll
                for (int p = 0; p < 4; ++p) { t[p].x = __builtin_amdgcn_exp2f(t[p].x); t[p].y = __builtin_amdgcn_exp2f(t[p].y); }
#pragma unroll
                for (int p = 0; p < 4; ++p) { t[p] = t[p] + (f2){1.0f, 1.0f}; g[p] = g[p] * up[p]; }
#pragma unroll
                for (int p = 0; p < 4; ++p) { r[p].x = __builtin_amdgcn_rcpf(t[p].x); r[p].y = __builtin_amdgcn_rcpf(t[p].y); }
                u32x4 w;
#pragma unroll
                for (int p = 0; p < 4; ++p) { const f2 h = g[p] * (r[p] * (f2){rs2, rs2}); w[p] = __builtin_bit_cast(unsigned, __builtin_convertvector(h, b2)); }
                *(u32x4*)(H + (size_t)row * 5632 + colh) = w;
            }
    }
    __device__ __forceinline__ void operator()(const f32x4 (&acc)[2][2][4][2], const Unit& u, int wr, int wc, int fr, int fq) const { run<false>(acc, u, wr, wc, fr, fq); }
    __device__ __forceinline__ void half(const f32x4 (&acc)[2][2][4][2], const Unit& u, int wr, int wc, int fr, int fq) const { run<true>(acc, u, wr, wc, fr, fq); }
};
struct EpiRes {
    static constexpr bool PERM = true, AFTER_DRAIN = false;
    bf16_t* x16; float* ssq; float scale; int final_; float* yp; float* ys;
    template <bool HF> __device__ __forceinline__ void run(const f32x4 (&acc)[2][2][4][2], const Unit& u, int wr, int wc, int fr, int fq) const {
        const int col = u.pn * BM + wc * 64 + 8 * fq;
        u32x4 xw[HF ? 4 : 8][2];
#pragma unroll
        for (int i = 0; i < (HF ? 4 : 8); ++i) { const bf16_t* xq = x16 + (size_t)(u.pm * HALF + (i >> 2) * HALF + wr * 64 + (i & 3) * 16 + fr) * 2048 + col; xw[i][0] = *(const u32x4*)xq; xw[i][1] = *(const u32x4*)(xq + 32); }
#pragma unroll
        for (int ai = 0; ai < (HF ? 1 : 2); ++ai)
#pragma unroll
            for (int m = 0; m < 4; ++m) {
                const int row = u.pm * HALF + ai * HALF + wr * 64 + m * 16 + fr;
                bf16_t* xp = x16 + (size_t)row * 2048 + col; float sq = 0.f;
                float* op = nullptr;
                if (final_) { if (row >= 16 && row < 16400) op = yp + (size_t)(row - 16) * 2048 + col; else if (row >= 16400 && row < 16656) op = ys + (size_t)(row - 16400) * 2048 + col; }
                const u32x4 w0 = xw[ai * 4 + m][0], w1 = xw[ai * 4 + m][1];
#pragma unroll
                for (int bj = 0; bj < 2; ++bj) {
                    const u32x4 w = bj ? w1 : w0;
                    const f32x4 x0 = (f32x4){__uint_as_float(w.x << 16), __uint_as_float(w.x & 0xffff0000u), __uint_as_float(w.y << 16), __uint_as_float(w.y & 0xffff0000u)};
                    const f32x4 x1 = (f32x4){__uint_as_float(w.z << 16), __uint_as_float(w.z & 0xffff0000u), __uint_as_float(w.w << 16), __uint_as_float(w.w & 0xffff0000u)};
                    const f32x4 v0 = x0 + acc[ai][bj][m][0] * scale, v1 = x1 + acc[ai][bj][m][1] * scale;
                    if (final_) { if (op) { *(f32x4*)(op + 32 * bj) = v0; *(f32x4*)(op + 32 * bj + 4) = v1; } }
                    else { *(u32x4*)(xp + 32 * bj) = pack8(v0, v1);
                        sq += (v0[0] * v0[0] + v0[1] * v0[1]) + (v0[2] * v0[2] + v0[3] * v0[3]) + (v1[0] * v1[0] + v1[1] * v1[1]) + (v1[2] * v1[2] + v1[3] * v1[3]); }
                }
                if (!final_) { sq += __shfl_xor(sq, 16); sq += __shfl_xor(sq, 32); if (fq == 0) atomicAdd(ssq + row, sq); }
            }
    }
    __device__ __forceinline__ void operator()(const f32x4 (&acc)[2][2][4][2], const Unit& u, int wr, int wc, int fr, int fq) const { run<false>(acc, u, wr, wc, fr, fq); }
    __device__ __forceinline__ void half(const f32x4 (&acc)[2][2][4][2], const Unit& u, int wr, int wc, int fr, int fq) const { run<true>(acc, u, wr, wc, fr, fq); }
};
struct EpiWin {
    static constexpr bool PERM = true, AFTER_DRAIN = false;
    bf16_t* GG; float* XB; const float* ssq;
    template <bool HF> __device__ __forceinline__ void run(const f32x4 (&acc)[2][2][4][2], const Unit& u, int wr, int wc, int fr, int fq) const {
        const int col = (u.pn & 7) * BM + wc * 64 + 8 * fq; const bool isg = u.pn < 8;
        float rsv[HF ? 4 : 8];
#pragma unroll
        for (int i = 0; i < (HF ? 4 : 8); ++i) rsv[i] = row_rstd(ssq, u.pm * HALF + (i >> 2) * HALF + wr * 64 + (i & 3) * 16 + fr);
#pragma unroll
        for (int ai = 0; ai < (HF ? 1 : 2); ++ai)
#pragma unroll
            for (int m = 0; m < 4; ++m) {
                const int row = u.pm * HALF + ai * HALF + wr * 64 + m * 16 + fr; const float rs = rsv[ai * 4 + m];
#pragma unroll
                for (int bj = 0; bj < 2; ++bj) {
                    f32x4 v0 = acc[ai][bj][m][0] * rs, v1 = acc[ai][bj][m][1] * rs;
                    if (isg) {
#pragma unroll
                        for (int e = 0; e < 4; ++e) { const float a = v0[e], b = v1[e];
                            v0[e] = a * fast_sigmoid(1.5957691216057308f * (a + 0.044715f * a * a * a)); v1[e] = b * fast_sigmoid(1.5957691216057308f * (b + 0.044715f * b * b * b)); }
                        *(u32x4*)(GG + (size_t)row * 2048 + col + 32 * bj) = pack8(v0, v1);
                    } else { float* xp = XB + (size_t)row * 2048 + col + 32 * bj; *(f32x4*)xp = v0; *(f32x4*)(xp + 4) = v1; }
                }
            }
    }
    __device__ __forceinline__ void operator()(const f32x4 (&acc)[2][2][4][2], const Unit& u, int wr, int wc, int fr, int fq) const { run<false>(acc, u, wr, wc, fr, fq); }
    __device__ __forceinline__ void half(const f32x4 (&acc)[2][2][4][2], const Unit& u, int wr, int wc, int fr, int fq) const { run<true>(acc, u, wr, wc, fr, fq); }
};
__device__ __forceinline__ float group_rstd64(const f32x4 (&v)[2][2]) {
    float s = 0.f;
#pragma unroll
    for (int bj = 0; bj < 2; ++bj)
#pragma unroll
        for (int n = 0; n < 2; ++n) s += (v[bj][n][0] * v[bj][n][0] + v[bj][n][1] * v[bj][n][1]) + (v[bj][n][2] * v[bj][n][2] + v[bj][n][3] * v[bj][n][3]);
    s += __shfl_xor(s, 16); s += __shfl_xor(s, 32);
    return __builtin_amdgcn_rsqf(s * (1.0f / 64.0f) + RMS_EPS);
}
struct EpiKV {
    static constexpr bool PERM = true, AFTER_DRAIN = false;
    const float* ssq; const float* kg;
    float* okp; float* ovp; float* oks; float* ovs;
    bf16_t* KP; bf16_t* VP; bf16_t* KS; bf16_t* VS;
    template <bool HF> __device__ __forceinline__ void run(const f32x4 (&acc)[2][2][4][2], const Unit& u, int wr, int wc, int fr, int fq) const {
        const bool isk = u.pn < 8; const int col = (u.pn & 7) * BM + wc * 64 + 8 * fq;
        f32x4 g[2][2];
#pragma unroll
        for (int bj = 0; bj < 2; ++bj)
#pragma unroll
            for (int n = 0; n < 2; ++n) g[bj][n] = isk ? *(const f32x4*)(kg + 32 * bj + 8 * fq + 4 * n) : (f32x4){1.f, 1.f, 1.f, 1.f};
        float* o32p = isk ? okp : ovp; float* o32s = isk ? oks : ovs; bf16_t* b16p = isk ? KP : VP; bf16_t* b16s = isk ? KS : VS;
        float rsv[HF ? 4 : 8];
#pragma unroll
        for (int i = 0; i < (HF ? 4 : 8); ++i) rsv[i] = row_rstd(ssq, u.pm * HALF + (i >> 2) * HALF + wr * 64 + (i & 3) * 16 + fr);
#pragma unroll
        for (int ai = 0; ai < (HF ? 1 : 2); ++ai)
#pragma unroll
            for (int m = 0; m < 4; ++m) {
                const int row = u.pm * HALF + ai * HALF + wr * 64 + m * 16 + fr; const float rs = rsv[ai * 4 + m];
                f32x4 v[2][2];
#pragma unroll
                for (int bj = 0; bj < 2; ++bj)
#pragma unroll
                    for (int n = 0; n < 2; ++n) v[bj][n] = acc[ai][bj][m][n] * rs;
                if (isk) { const float gr = group_rstd64(v);
#pragma unroll
                    for (int bj = 0; bj < 2; ++bj)
#pragma unroll
                        for (int n = 0; n < 2; ++n) v[bj][n] = v[bj][n] * gr * g[bj][n]; }
                float* o32 = nullptr; bf16_t* b16 = nullptr;
                if (row < 16400) { o32 = o32p + (size_t)row * 2048; b16 = b16p + (size_t)row * 2048; }
                else if (row < 16656) { const int sr = row - 16400; o32 = o32s + (size_t)sr * 2048; b16 = b16s + ((size_t)(sr >> 4) * 2112 + 2064 + (sr & 15)) * 2048; }
                if (o32) {
#pragma unroll
                    for (int bj = 0; bj < 2; ++bj) { float* p = o32 + col + 32 * bj; *(f32x4*)p = v[bj][0]; *(f32x4*)(p + 4) = v[bj][1]; *(u32x4*)(b16 + col + 32 * bj) = pack8(v[bj][0], v[bj][1]); }
                    if (row < 16) {
                        for (int b = 0; b < 16; ++b) { bf16_t* q = b16s + ((size_t)b * 2112 + row) * 2048 + col;
#pragma unroll
                            for (int bj = 0; bj < 2; ++bj) *(u32x4*)(q + 32 * bj) = pack8(v[bj][0], v[bj][1]); }
                    }
                }
            }
    }
    __device__ __forceinline__ void operator()(const f32x4 (&acc)[2][2][4][2], const Unit& u, int wr, int wc, int fr, int fq) const { run<false>(acc, u, wr, wc, fr, fq); }
    __device__ __forceinline__ void half(const f32x4 (&acc)[2][2][4][2], const Unit& u, int wr, int wc, int fr, int fq) const { run<true>(acc, u, wr, wc, fr, fq); }
};
struct EpiQ {
    static constexpr bool PERM = true, AFTER_DRAIN = false;
    const float* ssq; const float* qg; bf16_t* Q; float c2;
    template <bool HF> __device__ __forceinline__ void run(const f32x4 (&acc)[2][2][4][2], const Unit& u, int wr, int wc, int fr, int fq) const {
        const int col = u.pn * BM + wc * 64 + 8 * fq;
        f32x4 g[2][2];
        float rsv[HF ? 4 : 8];
#pragma unroll
        for (int i = 0; i < (HF ? 4 : 8); ++i) rsv[i] = row_rstd(ssq, u.pm * HALF + (i >> 2) * HALF + wr * 64 + (i & 3) * 16 + fr);
#pragma unroll
        for (int bj = 0; bj < 2; ++bj)
#pragma unroll
            for (int n = 0; n < 2; ++n) g[bj][n] = *(const f32x4*)(qg + 32 * bj + 8 * fq + 4 * n) * c2;
#pragma unroll
        for (int ai = 0; ai < (HF ? 1 : 2); ++ai)
#pragma unroll
            for (int m = 0; m < 4; ++m) {
                const int row = u.pm * HALF + ai * HALF + wr * 64 + m * 16 + fr; const float rs = rsv[ai * 4 + m];
                f32x4 v[2][2];
#pragma unroll
                for (int bj = 0; bj < 2; ++bj)
#pragma unroll
                    for (int n = 0; n < 2; ++n) v[bj][n] = acc[ai][bj][m][n] * rs;
                const float gr = group_rstd64(v);
#pragma unroll
                for (int bj = 0; bj < 2; ++bj) *(u32x4*)(Q + (size_t)row * 2048 + col + 32 * bj) = pack8(v[bj][0] * gr * g[bj][0], v[bj][1] * gr * g[bj][1]);
            }
    }
    __device__ __forceinline__ void operator()(const f32x4 (&acc)[2][2][4][2], const Unit& u, int wr, int wc, int fr, int fq) const { run<false>(acc, u, wr, wc, fr, fq); }
    __device__ __forceinline__ void half(const f32x4 (&acc)[2][2][4][2], const Unit& u, int wr, int wc, int fr, int fq) const { run<true>(acc, u, wr, wc, fr, fq); }
};

struct SplitOrder {
    int nN, nwgP, G, c, nsplit, nsB, TA, npairs, cbase; long skipP; float* slabs; unsigned* cnt;
    __device__ __forceinline__ void init(int N, int K, int G_, int c_, int nsplit_, int cbase_, float* slabs_, unsigned* cnt_, int TA_ = 1 << 20, int nsB_ = 1) {
        nN = N / BM; nwgP = 64 * nN; G = G_; c = c_; nsplit = nsplit_; nsB = nsB_; TA = TA_ < 3 * nN ? TA_ : 3 * nN; npairs = K / (2 * BK); cbase = cbase_; slabs = slabs_; cnt = cnt_; skipP = 0; }
    __device__ __forceinline__ bool next(int i, Unit& u) const {
        const long L = (long)i * G + c + skipP;
        if (L < nwgP) { int wgid = (int)L; { const int q = nwgP / NXCD, r = nwgP % NXCD, xcd = wgid % NXCD, off = wgid / NXCD; wgid = (xcd < r ? xcd * (q + 1) : r * (q + 1) + (xcd - r) * q) + off; }
            const int nig = WGM * nN, gid = wgid / nig, fm = gid * WGM;
            u.pm = 2 * (fm + ((wgid % nig) % WGM)); u.pn = (wgid % nig) / WGM; u.kt0 = 0; u.nt = 2 * npairs; u.nsplit = 1; u.slab = 0; u.cidx = 0; u.half = 0; return true; }
        const int m = (int)(L - nwgP); int tau, j, ns = nsplit, mm = m, t0 = 0;
        const int MA = ((TA + 7) & ~7) * nsplit;
        if (m >= MA) { mm = m - MA; ns = nsB; t0 = TA; }
        if (G == 256) { if (m >= 256) return false; const int x = mm & 7, v = mm >> 3; tau = t0 + 8 * (v / ns) + x; j = v % ns; }
        else { tau = t0 + mm / ns; j = mm % ns; }
        if (tau >= 3 * nN || (t0 == 0 && tau >= TA)) return false;
        const int per = npairs / ns, rem = npairs - per * ns;
        u.pm = 128 + tau / nN; u.pn = tau % nN; u.kt0 = 2 * (j * per + (j < rem ? j : rem)); u.nt = 2 * (per + (j < rem ? 1 : 0)); u.nsplit = ns; u.slab = m; u.cidx = cbase + tau; u.half = 1; return true;
    }
    __device__ __forceinline__ void a_ready(const Unit&) const {}
    __device__ __forceinline__ void done(const Unit&) const {}
    __device__ __forceinline__ bool split_combine(f32x4 (&acc)[2][2][4][2], const Unit& u, int wid, int lane) const {
        const __amdgpu_buffer_rsrc_t rs = __builtin_amdgcn_make_buffer_rsrc(slabs, 0, 256 * 131072, 0x00020000);
        const unsigned voff = ((unsigned)u.slab * 32768u + (unsigned)wid * 4096u + (unsigned)lane * 4u) * 4u;
#pragma unroll
        for (int i = 0; i < 8; ++i) __builtin_amdgcn_raw_buffer_store_b128(pack8(acc[0][(i >> 2) & 1][i & 3][0], acc[0][(i >> 2) & 1][i & 3][1]), rs, (int)(voff + (unsigned)i * 1024u), 0,   16);
        asm volatile("s_waitcnt vmcnt(0)" ::: "memory");
        unsigned t = 0; if (lane == 0) t = __hip_atomic_fetch_add(cnt + (size_t)u.cidx * 8 + wid, 1u, __ATOMIC_RELAXED, __HIP_MEMORY_SCOPE_AGENT);
        t = (unsigned)__builtin_amdgcn_readfirstlane((int)t);
        if (t != (unsigned)(u.nsplit - 1)) return false;
        __builtin_amdgcn_fence(__ATOMIC_ACQUIRE, "agent"); asm volatile("s_waitcnt vmcnt(0)" ::: "memory");
#pragma unroll
        for (int i = 0; i < 8; ++i) { const u32x4 w = pack8(acc[0][(i >> 2) & 1][i & 3][0], acc[0][(i >> 2) & 1][i & 3][1]);
            acc[0][(i >> 2) & 1][i & 3][0] = (f32x4){__uint_as_float(w.x << 16), __uint_as_float(w.x & 0xffff0000u), __uint_as_float(w.y << 16), __uint_as_float(w.y & 0xffff0000u)};
            acc[0][(i >> 2) & 1][i & 3][1] = (f32x4){__uint_as_float(w.z << 16), __uint_as_float(w.z & 0xffff0000u), __uint_as_float(w.w << 16), __uint_as_float(w.w & 0xffff0000u)}; }
        const int MA_ = ((TA + 7) & ~7) * nsplit, rb = u.slab >= MA_ ? MA_ : 0, sr = u.slab - rb;
        const int xs = sr & 7, vs = sr >> 3, own = (G == 256) ? (vs % u.nsplit) : (sr % u.nsplit), base = rb + ((G == 256) ? xs + 8 * ((vs / u.nsplit) * u.nsplit) : sr - own), stride = (G == 256) ? 8 : 1;
        const float* p0 = slabs + (size_t)wid * 4096 + lane * 4;
        const int nq = u.nsplit - 1;
        u32x4 bA[8], bB[8];
#define SC_SLAB(q) (p0 + (size_t)(base + stride * ((q) < own ? (q) : (q) + 1)) * 32768)
#define SC_LOAD(dst, q) do { const float* p_ = SC_SLAB(q); _Pragma("unroll") for (int k = 0; k < 8; ++k) dst[k] = *(const u32x4*)(p_ + k * 256); } while (0)
#define SC_ADD(src) do { _Pragma("unroll") for (int k = 0; k < 8; ++k) { const u32x4 w = src[k]; \
            acc[0][(k >> 2) & 1][k & 3][0] += (f32x4){__uint_as_float(w.x << 16), __uint_as_float(w.x & 0xffff0000u), __uint_as_float(w.y << 16), __uint_as_float(w.y & 0xffff0000u)}; \
            acc[0][(k >> 2) & 1][k & 3][1] += (f32x4){__uint_as_float(w.z << 16), __uint_as_float(w.z & 0xffff0000u), __uint_as_float(w.w << 16), __uint_as_float(w.w & 0xffff0000u)}; } } while (0)
        SC_LOAD(bA, 0);
        for (int q = 0; q < nq; q += 2) {
            if (q + 1 < nq) { SC_LOAD(bB, q + 1); asm volatile("s_waitcnt vmcnt(8)" ::: "memory"); } else asm volatile("s_waitcnt vmcnt(0)" ::: "memory");
            SC_ADD(bA);
            if (q + 1 < nq) {
                if (q + 2 < nq) { SC_LOAD(bA, q + 2); asm volatile("s_waitcnt vmcnt(8)" ::: "memory"); } else asm volatile("s_waitcnt vmcnt(0)" ::: "memory");
                SC_ADD(bB);
            }
        }
#undef SC_SLAB
#undef SC_LOAD
#undef SC_ADD
        return true;
    }
};

template <class Epi, class Sched, bool ALIGN_EPI = false, bool SP2 = false>
__device__ __forceinline__ void gemm_phase(PG8_LAS unsigned char* lds, const Gemm g, const Sched& S, const Epi& E) {
    int tid_l = threadIdx.x; asm volatile("" : "+v"(tid_l));
    const int tid = tid_l, wid = __builtin_amdgcn_readfirstlane(tid >> 6), lane = tid & 63, wr = wid >> 2, wc = wid & 3, fr = lane & 15, fq = lane >> 4;
    const int K = g.K;
    unsigned voffA[2], voffB[2];
#pragma unroll
    for (int i = 0; i < 2; ++i) { int R, C; stage_rc(tid * 16 + i * 8192, R, C); const int Rb = Epi::PERM ? ((R & ~31) + perm32(R & 31)) : R;
        voffA[i] = (unsigned)(R * K + C) * 2u; voffB[i] = (unsigned)(Rb * K + C) * 2u; }
    const size_t kstep = (size_t)(BK * 2);
    const size_t hstep = (size_t)HALF * K * 2;
    const size_t tstep = 2 * hstep;
    const unsigned ldsw = (unsigned)wid * 1024u;
    const int aoff = lds_byte(wr * 64 + fr, fq * 8), boff = lds_byte(wc * 32 + fr, fq * 8);
#define PG8_SA(b, h) (((b) * 2 + (h)) * HTB)
#define PG8_SB(b, h) ((4 + (b) * 2 + (h)) * HTB)
#define PG8_STAGE(bufoff, gbase, voff) do { _Pragma("unroll") for (int _i = 0; _i < 2; ++_i) \
        __builtin_amdgcn_global_load_lds((const unsigned*)((const char*)(gbase) + (voff)[_i]), (PG8_LAS unsigned*)(lds + (bufoff) + ldsw + _i * 8192), 16, 0, 0); } while (0)
#define PG8_LDA(dst, b, h) do { _Pragma("unroll") for (int m = 0; m < 4; ++m) _Pragma("unroll") for (int k = 0; k < 2; ++k) dst[m][k] = *(const PG8_LAS bf16x8*)(lds + PG8_SA(b, h) + aoff + m * 2048 + k * 1024); } while (0)
#define PG8_LDB(dst, b, h) do { _Pragma("unroll") for (int n = 0; n < 2; ++n) _Pragma("unroll") for (int k = 0; k < 2; ++k) dst[n][k] = *(const PG8_LAS bf16x8*)(lds + PG8_SB(b, h) + boff + n * 2048 + k * 1024); } while (0)
#define PG8_MMA(ai, bj, At, Bt) do { __builtin_amdgcn_s_setprio(1); _Pragma("unroll") for (int m = 0; m < 4; ++m) _Pragma("unroll") for (int n = 0; n < 2; ++n) _Pragma("unroll") for (int k = 0; k < 2; ++k) \
        acc[ai][bj][m][n] = __builtin_amdgcn_mfma_f32_16x16x32_bf16(Bt[n][k], At[m][k], acc[ai][bj][m][n], 0, 0, 0); __builtin_amdgcn_s_setprio(0); } while (0)
#define PG8_WAIT_V(n) asm volatile("s_waitcnt vmcnt(" #n ")" ::: "memory")
#define PG8_WAIT_L(n) asm volatile("s_waitcnt lgkmcnt(" #n ")" ::: "memory")
#define PG8_BAR __builtin_amdgcn_s_barrier()
#define PG8_SCHED __builtin_amdgcn_sched_barrier(0)
    Unit cur, nxt; int ui = 0;
    if (!S.next(0, cur)) return;
    f32x4 acc[2][2][4][2];
#pragma unroll
    for (int a = 0; a < 2; ++a)
#pragma unroll
        for (int b = 0; b < 2; ++b)
#pragma unroll
            for (int m = 0; m < 4; ++m)
#pragma unroll
                for (int n = 0; n < 2; ++n) acc[a][b][m][n] = (f32x4){0.f, 0.f, 0.f, 0.f};
    bf16x8 At[4][2], B0[2][2], B1[2][2];
    const char* cA = (const char*)g.A + (size_t)cur.pm * hstep + (size_t)cur.kt0 * kstep; const char* cB = (const char*)g.Bt + (size_t)cur.pn * tstep + (size_t)cur.kt0 * kstep;
    S.a_ready(cur);
    if constexpr (SP2) {
        PG8_STAGE(PG8_SB(0, 0), cB, voffB); PG8_STAGE(PG8_SB(0, 1), cB + hstep, voffB); PG8_STAGE(PG8_SA(0, 0), cA, voffA); PG8_STAGE(PG8_SA(0, 1), cA + hstep, voffA);
        if (wr == 1) PG8_BAR;
        PG8_WAIT_V(2); PG8_BAR;
        PG8_STAGE(PG8_SB(1, 0), cB + kstep, voffB); PG8_STAGE(PG8_SA(1, 0), cA + kstep, voffA); PG8_STAGE(PG8_SB(1, 1), cB + hstep + kstep, voffB);
        PG8_WAIT_V(6); PG8_BAR;
    } else {
        PG8_STAGE(PG8_SB(0, 0), cB, voffB); PG8_STAGE(PG8_SA(0, 0), cA, voffA); PG8_STAGE(PG8_SB(0, 1), cB + hstep, voffB); PG8_STAGE(PG8_SA(0, 1), cA + hstep, voffA);
        if (wr == 1) PG8_BAR;
        PG8_WAIT_V(4); PG8_BAR;
        PG8_STAGE(PG8_SB(1, 0), cB + kstep, voffB); PG8_STAGE(PG8_SA(1, 0), cA + kstep, voffA); PG8_STAGE(PG8_SB(1, 1), cB + hstep + kstep, voffB);
        PG8_WAIT_V(6); PG8_BAR;
    }
    for (;;) {
        const bool has_next = S.next(ui + 1, nxt);
        const char* nA = has_next ? (const char*)g.A + (size_t)nxt.pm * hstep + (size_t)nxt.kt0 * kstep : cA; const char* nB = has_next ? (const char*)g.Bt + (size_t)nxt.pn * tstep + (size_t)nxt.kt0 * kstep : cB;
        const int nt = cur.nt;
        if (!cur.half) {
        for (int t = 0; t < nt; t += 2) {
            const bool last = (t == nt - 2);
            const char* a1 = cA + (size_t)(t + 1) * kstep;
            const char* a2 = last ? nA : cA + (size_t)(t + 2) * kstep; const char* b2 = last ? nB : cB + (size_t)(t + 2) * kstep;
            const char* a3 = a2 + kstep; const char* b3 = b2 + kstep;
            if (last && has_next) S.a_ready(nxt);
            if constexpr (SP2) {
            PG8_LDB(B0, 0, 0); PG8_LDB(B1, 0, 1); PG8_SCHED; PG8_LDA(At, 0, 0); PG8_STAGE(PG8_SA(1, 1), a1 + hstep, voffA);
            PG8_WAIT_V(8); PG8_WAIT_L(0); PG8_BAR; PG8_MMA(0, 0, At, B0); PG8_MMA(0, 1, At, B1); PG8_BAR; PG8_SCHED;
            PG8_LDA(At, 0, 1); PG8_STAGE(PG8_SB(0, 0), b2, voffB); PG8_STAGE(PG8_SB(0, 1), b2 + hstep, voffB); PG8_STAGE(PG8_SA(0, 0), a2, voffA);
            PG8_WAIT_V(8); PG8_WAIT_L(0); PG8_BAR; PG8_MMA(1, 0, At, B0); PG8_MMA(1, 1, At, B1); PG8_BAR; PG8_SCHED;
            PG8_LDB(B0, 1, 0); PG8_LDB(B1, 1, 1); PG8_SCHED; PG8_LDA(At, 1, 0); PG8_STAGE(PG8_SA(0, 1), a2 + hstep, voffA);
            PG8_WAIT_V(8); PG8_WAIT_L(0); PG8_BAR; PG8_MMA(0, 0, At, B0); PG8_MMA(0, 1, At, B1); PG8_BAR; PG8_SCHED;
            PG8_LDA(At, 1, 1); PG8_STAGE(PG8_SB(1, 0), b3, voffB); PG8_STAGE(PG8_SB(1, 1), b3 + hstep, voffB); PG8_STAGE(PG8_SA(1, 0), a3, voffA);
            PG8_WAIT_V(8); PG8_WAIT_L(0); PG8_BAR; PG8_MMA(1, 0, At, B0); PG8_MMA(1, 1, At, B1); PG8_BAR; PG8_SCHED;
            } else {
            PG8_LDB(B0, 0, 0); PG8_SCHED; PG8_LDA(At, 0, 0); PG8_STAGE(PG8_SA(1, 1), a1 + hstep, voffA);
            PG8_WAIT_L(8); PG8_BAR; PG8_WAIT_L(0); PG8_MMA(0, 0, At, B0); PG8_BAR; PG8_SCHED;
            PG8_LDB(B1, 0, 1); PG8_STAGE(PG8_SB(0, 0), b2, voffB);
            PG8_BAR; PG8_WAIT_L(0); PG8_MMA(0, 1, At, B1); PG8_BAR;
            PG8_LDA(At, 0, 1); PG8_STAGE(PG8_SA(0, 0), a2, voffA);
            PG8_BAR; PG8_WAIT_L(0); PG8_MMA(1, 0, At, B0); PG8_BAR; PG8_SCHED;
            PG8_STAGE(PG8_SB(0, 1), b2 + hstep, voffB);
            PG8_WAIT_V(6); PG8_BAR; PG8_MMA(1, 1, At, B1); PG8_BAR;
            PG8_LDB(B0, 1, 0); PG8_SCHED; PG8_LDA(At, 1, 0); PG8_STAGE(PG8_SA(0, 1), a2 + hstep, voffA);
            PG8_WAIT_L(8); PG8_BAR; PG8_WAIT_L(0); PG8_MMA(0, 0, At, B0); PG8_BAR; PG8_SCHED;
            PG8_LDB(B1, 1, 1); PG8_STAGE(PG8_SB(1, 0), b3, voffB);
            PG8_BAR; PG8_WAIT_L(0); PG8_MMA(0, 1, At, B1); PG8_BAR;
            PG8_LDA(At, 1, 1); PG8_STAGE(PG8_SA(1, 0), a3, voffA);
            PG8_BAR; PG8_WAIT_L(0); PG8_MMA(1, 0, At, B0); PG8_BAR; PG8_SCHED;
            PG8_STAGE(PG8_SB(1, 1), b3 + hstep, voffB);
            PG8_WAIT_V(6); PG8_BAR; PG8_MMA(1, 1, At, B1); PG8_BAR;
            }
        }
        if constexpr (ALIGN_EPI) { if (wr == 0) PG8_BAR; }
        E(acc, cur, wr, wc, fr, fq); S.done(cur);
        } else {
        for (int t = 0; t < nt; t += 2) {
            const bool last = (t == nt - 2);
            const char* a1 = cA + (size_t)(t + 1) * kstep;
            const char* a2 = last ? nA : cA + (size_t)(t + 2) * kstep; const char* b2 = last ? nB : cB + (size_t)(t + 2) * kstep;
            const char* a3 = a2 + kstep; const char* b3 = b2 + kstep;
            if (last && has_next) S.a_ready(nxt);
            if constexpr (SP2) {
            PG8_LDB(B0, 0, 0); PG8_LDB(B1, 0, 1); PG8_SCHED; PG8_LDA(At, 0, 0); PG8_STAGE(PG8_SA(1, 1), a1 + hstep, voffA);
            PG8_WAIT_V(8); PG8_WAIT_L(0); PG8_BAR; PG8_MMA(0, 0, At, B0); PG8_MMA(0, 1, At, B1); PG8_BAR; PG8_SCHED;
            PG8_STAGE(PG8_SB(0, 0), b2, voffB); PG8_STAGE(PG8_SB(0, 1), b2 + hstep, voffB); PG8_STAGE(PG8_SA(0, 0), a2, voffA);
            PG8_WAIT_V(8); PG8_WAIT_L(0); PG8_BAR; PG8_BAR; PG8_SCHED;
            PG8_LDB(B0, 1, 0); PG8_LDB(B1, 1, 1); PG8_SCHED; PG8_LDA(At, 1, 0); PG8_STAGE(PG8_SA(0, 1), a2 + hstep, voffA);
            PG8_WAIT_V(8); PG8_WAIT_L(0); PG8_BAR; PG8_MMA(0, 0, At, B0); PG8_MMA(0, 1, At, B1); PG8_BAR; PG8_SCHED;
            PG8_STAGE(PG8_SB(1, 0), b3, voffB); PG8_STAGE(PG8_SB(1, 1), b3 + hstep, voffB); PG8_STAGE(PG8_SA(1, 0), a3, voffA);
            PG8_WAIT_V(8); PG8_WAIT_L(0); PG8_BAR; PG8_BAR; PG8_SCHED;
            } else {
            PG8_LDB(B0, 0, 0); PG8_SCHED; PG8_LDA(At, 0, 0); PG8_STAGE(PG8_SA(1, 1), a1 + hstep, voffA);
            PG8_WAIT_L(8); PG8_BAR; PG8_WAIT_L(0); PG8_MMA(0, 0, At, B0); PG8_BAR; PG8_SCHED;
            PG8_LDB(B1, 0, 1); PG8_STAGE(PG8_SB(0, 0), b2, voffB);
            PG8_BAR; PG8_WAIT_L(0); PG8_MMA(0, 1, At, B1); PG8_BAR;
            PG8_STAGE(PG8_SA(0, 0), a2, voffA);
            PG8_BAR; PG8_WAIT_L(0); PG8_BAR; PG8_SCHED;
            PG8_STAGE(PG8_SB(0, 1), b2 + hstep, voffB);
            PG8_WAIT_V(6); PG8_BAR; PG8_BAR;
            PG8_LDB(B0, 1, 0); PG8_SCHED; PG8_LDA(At, 1, 0); PG8_STAGE(PG8_SA(0, 1), a2 + hstep, voffA);
            PG8_WAIT_L(8); PG8_BAR; PG8_WAIT_L(0); PG8_MMA(0, 0, At, B0); PG8_BAR; PG8_SCHED;
            PG8_LDB(B1, 1, 1); PG8_STAGE(PG8_SB(1, 0), b3, voffB);
            PG8_BAR; PG8_WAIT_L(0); PG8_MMA(0, 1, At, B1); PG8_BAR;
            PG8_STAGE(PG8_SA(1, 0), a3, voffA);
            PG8_BAR; PG8_WAIT_L(0); PG8_BAR; PG8_SCHED;
            PG8_STAGE(PG8_SB(1, 1), b3 + hstep, voffB);
            PG8_WAIT_V(6); PG8_BAR; PG8_BAR;
            }
        }
        if constexpr (ALIGN_EPI) { if (wr == 0) PG8_BAR; }
        { bool fin = true; if (cur.nsplit > 1) fin = S.split_combine(acc, cur, wid, lane); if (fin) E.half(acc, cur, wr, wc, fr, fq); S.done(cur); }
        }
        if (!has_next) break;
#pragma unroll
        for (int a = 0; a < 2; ++a)
#pragma unroll
            for (int b = 0; b < 2; ++b)
#pragma unroll
                for (int m = 0; m < 4; ++m)
#pragma unroll
                    for (int n = 0; n < 2; ++n) acc[a][b][m][n] = (f32x4){0.f, 0.f, 0.f, 0.f};
        cur = nxt; cA = nA; cB = nB; ++ui;
        if constexpr (ALIGN_EPI) { if (wr == 1) PG8_BAR; }
    }
    PG8_WAIT_V(0);
    if constexpr (!ALIGN_EPI) { if (wr == 0) PG8_BAR; }
    PG8_BAR;
    if constexpr (Epi::AFTER_DRAIN) { E.fused(acc, cur, wr, wc, fr, fq, lds, wid, lane); S.done(cur); }
#undef PG8_SA
#undef PG8_SB
#undef PG8_STAGE
#undef PG8_LDA
#undef PG8_LDB
#undef PG8_MMA
#undef PG8_WAIT_V
#undef PG8_WAIT_L
#undef PG8_BAR
#undef PG8_SCHED
}
}

#ifndef PG8_SP2
#define PG8_SP2 true
#endif
#ifndef PG8_ALIGN
#define PG8_ALIGN true
#endif
#ifndef MK_PER_PHASE
#define MK_PER_PHASE 0
#endif

#ifndef EN_P0
#define EN_P0 1
#endif
#ifndef EN_RG0
#define EN_RG0 1
#endif
#ifndef EN_RG1
#define EN_RG1 1
#endif
#ifndef EN_ATT
#define EN_ATT 1
#endif
#ifndef EN_GU
#define EN_GU 1
#endif
#ifndef EN_DN
#define EN_DN 1
#endif
#ifndef EN_WIN
#define EN_WIN 1
#endif
#ifndef EN_KV
#define EN_KV 1
#endif
#ifndef EN_Q
#define EN_Q 1
#endif
#ifndef EN_RES
#define EN_RES 1
#endif
constexpr int NWAVES = 8;
constexpr int DM = 2048, DFF = 5632, NHEAD = 16;
constexpr int MROWS = 16896;
constexpr int ROW_P0 = 16, ROW_S0 = 16400, ROWS_REAL = 16656;
constexpr int KS_ROWS = 2112;
constexpr float LAM_INIT = 0.3555090675909693f;
constexpr float LOG2E = 1.4426950408889634f;
constexpr int NPHASE = 17;
constexpr size_t O_YP = 0, O_YS = 33554432, O_KP = 34078720, O_VP = 67665920, O_CP = 101253120, O_HP = 101259264, O_KS = 101261312, O_VS = 101785600, O_CS = 102309888, O_HS = 102408192, O_END = 102440960;

constexpr size_t MiB = 1u << 20;
constexpr size_t WS_CTL = 0, CTL_ZERO_BYTES = 1 * MiB;
constexpr size_t WS_GW = 1 * MiB;
constexpr size_t WS_WGU = 2 * MiB;
constexpr size_t WS_WDN = 178 * MiB;
constexpr size_t WS_WIN = 266 * MiB, WS_WOUT = 282 * MiB, WS_WKV = 290 * MiB, WS_WQ = 306 * MiB, WS_WO = 314 * MiB;
constexpr size_t WS_X16 = 322 * MiB;
constexpr size_t WS_BIG = 388 * MiB;
constexpr size_t WS_ACT = 586 * MiB;
constexpr size_t WS_KP = 652 * MiB, WS_VP = 717 * MiB;
constexpr size_t WS_KS = 782 * MiB, WS_VS = 914 * MiB;
constexpr size_t WS_TS = 1046 * MiB;
constexpr size_t WS_SLAB = 1048 * MiB;
constexpr size_t WS_AB = 1112 * MiB;
constexpr size_t WS_END = 1244 * MiB;
constexpr int CW_TMO = 0, CW_ATTQ = 64, CW_SCONV = 256, CW_BAR = 4096;
constexpr size_t CTL_SSQ = 65536;
constexpr size_t CTL_SCNT = 524288;
static_assert(CTL_SSQ + 6 * (size_t)MROWS * 4 <= CTL_SCNT && CTL_SCNT + 17 * 128 * 8 * 4 <= CTL_ZERO_BYTES, "ctl");

constexpr int RING_OFF = 0, RING_BYTES = 131072;
constexpr int LDSCTL_OFF = RING_BYTES, MISC_OFF = LDSCTL_OFF + 320;
constexpr int LDS_BYTES = 147456;

#define GAS __attribute__((address_space(1)))
#define LAS __attribute__((address_space(3)))
typedef unsigned short bf16;
typedef unsigned v4u __attribute__((ext_vector_type(4)));
typedef unsigned v2u __attribute__((ext_vector_type(2)));
typedef float f32x4 __attribute__((ext_vector_type(4)));
typedef float f32x2 __attribute__((ext_vector_type(2)));
typedef float f32x16 __attribute__((ext_vector_type(16)));
typedef short bf16x8 __attribute__((ext_vector_type(8)));
typedef short s16x4 __attribute__((ext_vector_type(4)));
typedef GAS unsigned gu32;
#define RLX_AGENT __ATOMIC_RELAXED, __HIP_MEMORY_SCOPE_AGENT
#define LDS_WAIT() asm volatile("s_waitcnt lgkmcnt(0)" ::: "memory")
#define VM_WAIT() asm volatile("s_waitcnt vmcnt(0)" ::: "memory")
__device__ __forceinline__ unsigned pk2(float lo, float hi) { typedef __bf16 bf16x2_t __attribute__((ext_vector_type(2))); f32x2 v = {lo, hi}; bf16x2_t b = __builtin_convertvector(v, bf16x2_t); return __builtin_bit_cast(unsigned, b); }
__device__ __forceinline__ unsigned f2bf(float f) { return pk2(f, 0.f) & 0xffffu; }
__device__ __forceinline__ float bf2f(bf16 b) { return __builtin_bit_cast(float, ((unsigned)b) << 16); }
__device__ __forceinline__ float wave_sum(float v) {
#pragma unroll
    for (int o = 1; o < 64; o <<= 1) v += __shfl_xor(v, o);
    return v;
}

#define XB_TMO      128
#define XB_XCNT(j)  (256  + 64 * (j))
#define XB_XSUB(j)  (1280 + 64 * (j))
#define XB_XGEN(j)  (2304 + 64 * (j))
#define XB_TOP      3328
#define XB_TOPGEN   3392
#define XCD_BAR_WORDS 3456
#define XB_SPIN_CAP (1u << 18)

__device__ __forceinline__ unsigned xb_ld(unsigned* p)              { return __hip_atomic_load(p, __ATOMIC_RELAXED, __HIP_MEMORY_SCOPE_AGENT); }
__device__ __forceinline__ unsigned xb_add(unsigned* p, unsigned v) { return __hip_atomic_fetch_add(p, v, __ATOMIC_RELAXED, __HIP_MEMORY_SCOPE_AGENT); }
__device__ __forceinline__ unsigned xb_xcc_id() { return (unsigned)__builtin_amdgcn_s_getreg((3 << 11) | 20) & 0xFu; }
#define XB_SPIN(cond, bar) do { unsigned _sp = 0; while (cond) { __builtin_amdgcn_s_sleep(1); \
    if ((++_sp & 255u) == 0u) { if (xb_ld(&(bar)[XB_TMO])) break; if (_sp > XB_SPIN_CAP) { atomicAdd(&(bar)[XB_TMO], 1u); break; } } } } while (0)

struct XcdBarrier {
    unsigned* bar; unsigned x;
    volatile LAS unsigned* st;
};

__device__ __forceinline__ XcdBarrier xcd_barrier_post(unsigned* bar, volatile LAS unsigned* st) {
    XcdBarrier b; b.bar = bar; b.x = xb_xcc_id(); b.st = st;
    if (threadIdx.x == 0) (void)xb_add(&bar[XB_XCNT(b.x)], 1u);
    return b;
}
__device__ __forceinline__ void xcd_barrier_complete(unsigned* bar, unsigned x, unsigned& nloc, unsigned& nx) {
    const unsigned G = gridDim.x * gridDim.y * gridDim.z;
    unsigned sum, cnt, mine, sp = 0u;
    for (;;) {
        sum = 0u; cnt = 0u; mine = 0u;
#pragma unroll
        for (unsigned j = 0; j < 16; ++j) { const unsigned c = xb_ld(&bar[XB_XCNT(j)]); sum += c; cnt += (c > 0u) ? 1u : 0u; mine = (j == x) ? c : mine; }
        if (sum == G) break;
        __builtin_amdgcn_s_sleep(1);
        if ((++sp & 255u) == 0u) { if (xb_ld(&bar[XB_TMO])) break; if (sp > XB_SPIN_CAP) { atomicAdd(&bar[XB_TMO], 1u); break; } }
    }
    nloc = mine > 0u ? mine : 1u; nx = cnt > 0u ? cnt : 1u;
}

__device__ __forceinline__ void xcd_barrier(const XcdBarrier& b) {
    asm volatile("s_waitcnt vmcnt(0)" ::: "memory");
    __syncthreads();
    if (threadIdx.x == 0) {
        unsigned* bar = b.bar;
        __builtin_amdgcn_s_waitcnt(0);
        unsigned nloc = b.st[0], nx = b.st[1];
        if (nloc == 0u) { xcd_barrier_complete(bar, b.x, nloc, nx); b.st[0] = nloc; b.st[1] = nx; }
        const unsigned old = xb_add(&bar[XB_XSUB(b.x)], 1u);
        const unsigned gen = old / nloc;
        if (old + 1u == (gen + 1u) * nloc) {
            __builtin_amdgcn_fence(__ATOMIC_RELEASE, "agent");
            asm volatile("s_waitcnt vmcnt(0)" ::: "memory");
            const unsigned og = xb_add(&bar[XB_TOP], 1u);
            const unsigned tg = og / nx;
            if (og + 1u == (tg + 1u) * nx) xb_add(&bar[XB_TOPGEN], 1u);
            else XB_SPIN(xb_ld(&bar[XB_TOPGEN]) == tg, bar);
            __builtin_amdgcn_fence(__ATOMIC_ACQUIRE, "agent");
            xb_add(&bar[XB_XGEN(b.x)], 1u);
            asm volatile("s_waitcnt vmcnt(0)" ::: "memory");
        } else {
            XB_SPIN(xb_ld(&bar[XB_XGEN(b.x)]) == gen, bar);
            __builtin_amdgcn_fence(__ATOMIC_ACQUIRE, "agent");
            asm volatile("s_waitcnt vmcnt(0)" ::: "memory");
        }
    }
    __syncthreads();
}

struct Args { const float* in[28]; float* out; unsigned char* ws; int ph_lo, ph_hi; };
typedef const __attribute__((address_space(4))) Args CArgs;
__device__ __forceinline__ CArgs* largs() { CArgs* p = (CArgs*)__builtin_amdgcn_kernarg_segment_ptr(); asm volatile("" : "+s"(p)); return p; }
__device__ __forceinline__ int lbid() { int b = (int)blockIdx.x; asm volatile("" : "+s"(b)); return b; }
struct Frame {
    LAS unsigned char* lds;
    volatile LAS unsigned* MISC;
    int tid, lane, wave, G;
};
#define P_IN(i) (args.in[i])
#define P_WS(T, off) ((T*)(args.ws + (off)))
#define P_GW P_WS(bf16, WS_GW)
#define P_WGU P_WS(bf16, WS_WGU)
#define P_WDN P_WS(bf16, WS_WDN)
#define P_WIN P_WS(bf16, WS_WIN)
#define P_WOUT P_WS(bf16, WS_WOUT)
#define P_WKV P_WS(bf16, WS_WKV)
#define P_WQ P_WS(bf16, WS_WQ)
#define P_WO P_WS(bf16, WS_WO)
#define P_X16 P_WS(bf16, WS_X16)
#define P_HID P_WS(bf16, WS_BIG)
#define P_GG P_WS(bf16, WS_BIG)
#define P_XB P_WS(float, WS_BIG + 66 * MiB)
#define P_A3 P_WS(bf16, WS_BIG)
#define P_ACT P_WS(bf16, WS_ACT)
#define P_KP P_WS(bf16, WS_KP)
#define P_VP P_WS(bf16, WS_VP)
#define P_KS P_WS(bf16, WS_KS)
#define P_VS P_WS(bf16, WS_VS)
#define P_TS P_WS(float, WS_TS)
#define P_SSQ P_WS(float, CTL_SSQ)
#define P_CTL ((gu32*)(args.ws + WS_CTL))
#define P_SLAB P_WS(float, WS_SLAB)
#define P_SCNT ((unsigned*)(args.ws + CTL_SCNT))
#define P_OUT (args.out)
enum { I_XP = 0, I_XS, I_CK, I_CV, I_SCONV, I_SH, I_META, I_FNORM, I_WG, I_WU, I_WD, I_RGNORM, I_RGWIN, I_CONVW, I_CONVB, I_GATEW, I_GATEB, I_LAMBDA, I_RGWOUT, I_KVNORM, I_WKV, I_KNORM, I_ATTNNORM, I_WQ, I_QNORM, I_DLAM, I_SUBNORM, I_WOP };

__device__ __forceinline__ void cvt_item(const float* W, int ldw, int n0, int k0, const float* gain, bf16* dst, int K, LAS float* scr, int lane) {
    float wv[32];
#pragma unroll
    for (int i = 0; i < 32; ++i) wv[i] = W[(size_t)(k0 + 2 * i + (lane >> 5)) * ldw + n0 + (lane & 31)];
#pragma unroll
    for (int i = 0; i < 32; ++i) { const int kk = 2 * i + (lane >> 5); const float g = gain ? gain[k0 + kk] : 1.f; scr[kk * 33 + (lane & 31)] = wv[i] * g; }
    LDS_WAIT(); asm volatile("" ::: "memory");
    const int c = lane & 7;
#pragma unroll
    for (int j = 0; j < 4; ++j) { const int n = (lane >> 3) + 8 * j; const LAS float* s = scr + (8 * c) * 33 + n;
        v4u o; o.x = pk2(s[0 * 33], s[1 * 33]); o.y = pk2(s[2 * 33], s[3 * 33]); o.z = pk2(s[4 * 33], s[5 * 33]); o.w = pk2(s[6 * 33], s[7 * 33]);
        *(GAS v4u*)(dst + (size_t)n * K + 8 * c) = o; }
    LDS_WAIT(); asm volatile("" ::: "memory");
}
__device__ __forceinline__ int p64col(int beta) { return 256 * (beta >> 3) + 64 * (beta & 3) + 32 * ((beta >> 2) & 1); }
__device__ __forceinline__ void p0_prologue(const Frame& F, CArgs& args) {
    int tid_l = threadIdx.x; asm volatile("" : "+v"(tid_l));
    const int lane = tid_l & 63, wave = __builtin_amdgcn_readfirstlane(tid_l >> 6);
    LAS float* scr = (LAS float*)(F.lds + RING_OFF + wave * 16384);
    const int gw = lbid() * NWAVES + wave, NGW = F.G * NWAVES;
    constexpr int IT_GU = 32 * 352, IT_DN = 88 * 64, IT_44 = 32 * 128, IT_22 = 32 * 64, IT_GW = 32 * 8;
    constexpr int NIT = 4 * IT_GU + 4 * IT_DN + 2 * IT_44 + 3 * IT_22 + IT_GW;
    for (int it = gw; it < NIT; it += NGW) {
        int r = it;
        if (r < 4 * IT_GU) { const int f = r / IT_GU; r -= f * IT_GU; const int kb = r / 352, beta = r % 352, pn = beta >> 3, bj = (beta >> 2) & 1, jb = beta & 3;
            const float* src = (bj ? P_IN(I_WU) : P_IN(I_WG)) + (size_t)f * DM * DFF;
            cvt_item(src, DFF, 128 * pn + 32 * jb, 64 * kb, P_IN(I_FNORM) + f * DM, P_WGU + (size_t)f * 11264 * DM + (size_t)(32 * beta) * DM + 64 * kb, DM, scr, lane); continue; }
        r -= 4 * IT_GU;
        if (r < 4 * IT_DN) { const int f = r / IT_DN; r -= f * IT_DN; const int kb = r / 64, beta = r % 64;
            cvt_item(P_IN(I_WD) + (size_t)f * DFF * DM, DM, p64col(beta), 64 * kb, nullptr, P_WDN + (size_t)f * DM * DFF + (size_t)(32 * beta) * DFF + 64 * kb, DFF, scr, lane); continue; }
        r -= 4 * IT_DN;
        if (r < IT_44) { const int kb = r / 128, beta = r % 128; cvt_item(P_IN(I_RGWIN), 4096, p64col(beta), 64 * kb, P_IN(I_RGNORM), P_WIN + (size_t)(32 * beta) * DM + 64 * kb, DM, scr, lane); continue; }
        r -= IT_44;
        if (r < IT_44) { const int kb = r / 128, beta = r % 128; cvt_item(P_IN(I_WKV), 4096, p64col(beta), 64 * kb, P_IN(I_KVNORM), P_WKV + (size_t)(32 * beta) * DM + 64 * kb, DM, scr, lane); continue; }
        r -= IT_44;
        if (r < IT_22) { const int kb = r / 64, beta = r % 64; cvt_item(P_IN(I_RGWOUT), DM, p64col(beta), 64 * kb, nullptr, P_WOUT + (size_t)(32 * beta) * DM + 64 * kb, DM, scr, lane); continue; }
        r -= IT_22;
        if (r < IT_22) { const int kb = r / 64, beta = r % 64; cvt_item(P_IN(I_WQ), DM, p64col(beta), 64 * kb, P_IN(I_ATTNNORM), P_WQ + (size_t)(32 * beta) * DM + 64 * kb, DM, scr, lane); continue; }
        r -= IT_22;
        if (r < IT_22) { const int kb = r / 64, beta = r % 64; cvt_item(P_IN(I_WOP), DM, p64col(beta), 64 * kb, nullptr, P_WO + (size_t)(32 * beta) * DM + 64 * kb, DM, scr, lane); continue; }
        r -= IT_22;
        { const int mat = r >> 3, i8 = r & 7; cvt_item(P_IN(I_GATEW) + (size_t)mat * 16384, 128, 32 * (i8 & 3), 64 * (i8 >> 2), nullptr, P_GW + (size_t)mat * 16384 + (size_t)(32 * (i8 & 3)) * 128 + 64 * (i8 >> 2), 128, scr, lane); }
    }
    for (int m = gw; m < MROWS; m += NGW) {
        const float* src = m < ROW_P0 ? P_IN(I_META) + (size_t)m * DM : m < ROW_S0 ? P_IN(I_XP) + (size_t)(m - ROW_P0) * DM : m < ROWS_REAL ? P_IN(I_XS) + (size_t)(m - ROW_S0) * DM : nullptr;
        float s = 0.f;
#pragma unroll
        for (int j = 0; j < 4; ++j) {
            f32x4 a = (f32x4){0.f, 0.f, 0.f, 0.f}, b = a;
            if (src) { a = *(const GAS f32x4*)(src + 512 * j + 8 * lane); b = *(const GAS f32x4*)(src + 512 * j + 8 * lane + 4); }
            s += (a[0] * a[0] + a[1] * a[1]) + (a[2] * a[2] + a[3] * a[3]) + (b[0] * b[0] + b[1] * b[1]) + (b[2] * b[2] + b[3] * b[3]);
            v4u o; o.x = pk2(a[0], a[1]); o.y = pk2(a[2], a[3]); o.z = pk2(b[0], b[1]); o.w = pk2(b[2], b[3]);
            *(GAS v4u*)(P_X16 + (size_t)m * DM + 512 * j + 8 * lane) = o;
        }
        s = wave_sum(s);
        if (lane == 0) P_SSQ[m] = s;
    }
}

constexpr int RG_XC = 0, RG_G = 17408, RG_SQ = RG_G + 2 * 64 * 528, RG_XCS = 272, RG_GS = 528;
template <int MODE> __device__ __forceinline__ void rg_phase(const Frame& F, CArgs& args) {
    LAS unsigned char* L = F.lds + RING_OFF;
    int tid_l = threadIdx.x; asm volatile("" : "+v"(tid_l));
    const int tid = tid_l, lane = tid & 63, wave = __builtin_amdgcn_readfirstlane(tid >> 6);
    const int c = tid & 127, q = tid >> 7, fr = lane & 15, fq = lane >> 4, k2 = wave >> 2, dq = wave & 3;
    const float* XB = P_XB;
    unsigned* AB = (unsigned*)(args.ws + WS_AB);
    for (int uidx = lbid(); uidx < 81 * 16; uidx += F.G) {
        int tl, n;
        if (uidx < 1024) { tl = 1 + (uidx >> 4); n = uidx & 15; } else { const int v = uidx - 1024; n = v & 15; const int t2 = v >> 4; tl = t2 == 0 ? 0 : 64 + t2; }
        const bool smp = tl >= 65; const int b = tl - 65;
        const bool full = !smp && tl != 0;
        const int row0 = smp ? ROW_S0 + 16 * b : (tl == 0 ? 0 : 16 + 256 * (tl - 1));
        const int nsub = full ? 4 : 1, nmb = full ? 4 : 1, nq = full ? 4 : 1;
        const int ch = n * 128 + c;
        const bool act = q < nq;
        if (MODE == 0) {
            const float cw0 = P_IN(I_CONVW)[ch], cw1 = P_IN(I_CONVW)[2048 + ch], cw2 = P_IN(I_CONVW)[4096 + ch], cw3 = P_IN(I_CONVW)[6144 + ch], cb = P_IN(I_CONVB)[ch];
            const float lam = P_IN(I_LAMBDA)[ch];
            const float ls8 = -8.0f * LOG2E * log1pf(__expf(-lam));
            bf16x8 Bw[2][4]; f32x4 gb[2];
            { const bf16* gwp = P_GW + ((size_t)(k2 * 16 + n) * 128 + 32 * dq + fr) * 128 + 8 * fq;
#pragma unroll
              for (int nb = 0; nb < 2; ++nb) {
#pragma unroll
                  for (int ks = 0; ks < 4; ++ks) Bw[nb][ks] = *(const GAS bf16x8*)(gwp + (size_t)(16 * nb) * 128 + 32 * ks);
                  gb[nb] = *(const GAS f32x4*)(P_IN(I_GATEB) + k2 * 2048 + n * 128 + 32 * dq + 16 * nb + 4 * fq); } }
            float At = 1.f, Bt = 0.f;
            float vn[19];
#define RG_LOADV(dst, ss) do { _Pragma("unroll") for (int j = 0; j < 19; ++j) { const int T = 64 * (ss) + 16 * q - 3 + j; float x = 0.f; \
                if (act) { if (smp) x = T >= 0 ? XB[(size_t)(row0 + T) * DM + ch] : P_IN(I_SCONV)[((size_t)b * 3 + 3 + T) * DM + ch]; \
                           else { const int g = row0 + T; x = g >= 0 ? XB[(size_t)g * DM + ch] : 0.f; } } \
                dst[j] = x; } } while (0)
            RG_LOADV(vn, 0);
            for (int s = 0; s < nsub; ++s) {
                float xc[16], v[19];
                const int T0 = 64 * s + 16 * q;
#pragma unroll
                for (int j = 0; j < 19; ++j) v[j] = vn[j];
                if (s + 1 < nsub) RG_LOADV(vn, s + 1);
#pragma unroll
                for (int i = 0; i < 16; ++i) { xc[i] = cb + cw0 * v[i] + cw1 * v[i + 1] + cw2 * v[i + 2] + cw3 * v[i + 3];
                    if (act) *(LAS bf16*)(L + RG_XC + (16 * q + i) * RG_XCS + 2 * c) = (bf16)f2bf(xc[i]); }
                __syncthreads();
#pragma unroll
                for (int m = 0; m < 4; ++m) {
                    if (m < nmb) {
                        f32x4 acc0 = (f32x4){0.f, 0.f, 0.f, 0.f}, acc1 = acc0;
#pragma unroll
                        for (int ks = 0; ks < 4; ++ks) { const bf16x8 a = *(const LAS bf16x8*)(L + RG_XC + (16 * m + fr) * RG_XCS + 64 * ks + 16 * fq);
                            acc0 = __builtin_amdgcn_mfma_f32_16x16x32_bf16(Bw[0][ks], a, acc0, 0, 0, 0); acc1 = __builtin_amdgcn_mfma_f32_16x16x32_bf16(Bw[1][ks], a, acc1, 0, 0, 0); }
                        f32x4 g0, g1;
#pragma unroll
                        for (int e = 0; e < 4; ++e) { g0[e] = pg8::fast_sigmoid(acc0[e] + gb[0][e]); g1[e] = pg8::fast_sigmoid(acc1[e] + gb[1][e]); }
                        LAS unsigned char* gp = L + RG_G + k2 * (64 * RG_GS) + (16 * m + fr) * RG_GS + (32 * dq + 4 * fq) * 4;
                        *(LAS f32x4*)gp = g0; *(LAS f32x4*)(gp + 64) = g1;
                    }
                }
                __syncthreads();
                float A = 1.f, B = 0.f;
#pragma unroll
                for (int i = 0; i < 16; ++i) {
                    if (act) { const float r = *(const LAS float*)(L + RG_G + (16 * q + i) * RG_GS + 4 * c), ig = *(const LAS float*)(L + RG_G + 64 * RG_GS + (16 * q + i) * RG_GS + 4 * c);
                        const float a = __builtin_amdgcn_exp2f(r * ls8), bb = __builtin_sqrtf(fmaxf(1.f - a * a, 0.f)) * (ig * xc[i]);
                        const unsigned w = pk2(1.f - a, bb);
                        const int T = T0 + i; const size_t row = (size_t)(row0 + T);
                        AB[row * DM + ch] = w;
                        const float ar = 1.f - __uint_as_float(w << 16), br = __uint_as_float(w & 0xffff0000u);
                        A *= ar; B = ar * B + br;
                        if (smp) { if (T >= 13) P_OUT[O_CS + ((size_t)b * 3 + (T - 13)) * DM + ch] = v[i + 3]; }
                        else { if (row >= 16397) P_OUT[O_CP + (row - 16397) * DM + ch] = v[i + 3]; }
                    }
                }
                *(LAS f32x2*)(L + RG_SQ + (q * 128 + c) * 8) = (f32x2){A, B};
                __syncthreads();
                float As = 1.f, Bs = 0.f;
#pragma unroll
                for (int qq = 0; qq < 4; ++qq) { const f32x2 sq = *(const LAS f32x2*)(L + RG_SQ + (qq * 128 + c) * 8); Bs = sq.x * Bs + sq.y; As *= sq.x; }
                Bt = As * Bt + Bs; At = As * At;
            }
            if (q == 0 && !smp) *(GAS f32x2*)(P_TS + ((size_t)tl * 2048 + ch) * 2) = (f32x2){At, Bt};
#undef RG_LOADV
        } else {
            float hc = 0.f;
            if (smp) hc = P_IN(I_SH)[b * 2048 + ch];
            else {
                float As = 1.f, Bs = 0.f;
#pragma unroll
                for (int hb = 0; hb < 2; ++hb) { f32x2 ab[8];
#pragma unroll
                    for (int k = 0; k < 8; ++k) { const int i = 16 * q + 8 * hb + k; ab[k] = i < tl ? *(const GAS f32x2*)(P_TS + ((size_t)i * 2048 + ch) * 2) : (f32x2){1.f, 0.f}; }
#pragma unroll
                    for (int k = 0; k < 8; ++k) { Bs = ab[k].x * Bs + ab[k].y; As *= ab[k].x; } }
                *(LAS f32x2*)(L + RG_SQ + (q * 128 + c) * 8) = (f32x2){As, Bs};
                __syncthreads();
#pragma unroll
                for (int qq = 0; qq < 4; ++qq) { const f32x2 sg = *(const LAS f32x2*)(L + RG_SQ + (qq * 128 + c) * 8); hc = sg.x * hc + sg.y; }
                __syncthreads();
            }
            unsigned wn[16]; unsigned short gn[16];
#define RG_LOADAB(ss) do { _Pragma("unroll") for (int i = 0; i < 16; ++i) { const size_t row = (size_t)(row0 + 64 * (ss) + 16 * q + i); wn[i] = act ? AB[row * DM + ch] : 0u; gn[i] = act ? P_GG[row * DM + ch] : (unsigned short)0; } } while (0)
            RG_LOADAB(0);
            for (int s = 0; s < nsub; ++s) {
                unsigned w[16]; unsigned short gg[16];
#pragma unroll
                for (int i = 0; i < 16; ++i) { w[i] = wn[i]; gg[i] = gn[i]; }
                if (s + 1 < nsub) RG_LOADAB(s + 1);
                const int T0 = 64 * s + 16 * q;
                float A = 1.f, B = 0.f;
#pragma unroll
                for (int i = 0; i < 16; ++i) { const float ar = 1.f - __uint_as_float(w[i] << 16), br = __uint_as_float(w[i] & 0xffff0000u); A *= ar; B = ar * B + br; }
                *(LAS f32x2*)(L + RG_SQ + (q * 128 + c) * 8) = (f32x2){A, B};
                __syncthreads();
                float h = hc, hn = hc;
#pragma unroll
                for (int qq = 0; qq < 4; ++qq) { const f32x2 sq = *(const LAS f32x2*)(L + RG_SQ + (qq * 128 + c) * 8); if (qq < q) h = sq.x * h + sq.y; hn = sq.x * hn + sq.y; }
                hc = hn;
                __syncthreads();
                if (act) {
#pragma unroll
                    for (int i = 0; i < 16; ++i) {
                        const float ar = 1.f - __uint_as_float(w[i] << 16), br = __uint_as_float(w[i] & 0xffff0000u);
                        h = ar * h + br;
                        const int T = T0 + i; const size_t row = (size_t)(row0 + T);
                        P_ACT[row * DM + ch] = (bf16)f2bf(bf2f(gg[i]) * h);
                        if (smp) { if (T == 15) P_OUT[O_HS + (size_t)b * DM + ch] = h; }
                        else { if (row == 16399) P_OUT[O_HP + ch] = h; }
                    }
                }
            }
#undef RG_LOADAB
        }
    }
}

namespace att {
typedef __attribute__((address_space(3))) const char* lcp;
constexpr int KSLOT = 16384, VRING = 65536, STG_OFF = 65536, STG_ROW = 272;
__device__ __forceinline__ int crow(int r, int hi) { return (r & 3) + 8 * (r >> 2) + 4 * hi; }
__device__ __forceinline__ void glds16(const void* gsrc, unsigned lds_dst) { unsigned keep;
    asm volatile("s_mov_b32 %0, m0\n\ts_mov_b32 m0, %2\n\ts_nop 0\n\tglobal_load_lds_dwordx4 %1, off\n\ts_mov_b32 m0, %0" : "=&s"(keep) : "v"(gsrc), "s"(lds_dst) : "memory"); }
__device__ __forceinline__ s16x4 vtr(lcp p) { typedef short v4i16_t __attribute__((ext_vector_type(4))); return __builtin_bit_cast(s16x4, __builtin_amdgcn_ds_read_tr16_b64_v4i16((__attribute__((address_space(3))) v4i16_t*)p)); }
__device__ __forceinline__ unsigned cvtpk(float lo, float hi) { typedef __bf16 bf16x2_t __attribute__((ext_vector_type(2))); f32x2 v = {lo, hi}; bf16x2_t b = __builtin_convertvector(v, bf16x2_t); return __builtin_bit_cast(unsigned, b); }
#define ATT_WAIT_BAR(N) asm volatile("s_waitcnt vmcnt(" #N ") lgkmcnt(0)\n\ts_barrier" ::: "memory")
struct UnitDesc { const bf16* Kb; const bf16* Vb; int qrow0, kb0, NT, NTF, h, sample, nvalid, dyn; float mref; };

template <int THR> __device__ __forceinline__ void attn_unit_s(LAS unsigned char* lds, const bf16* Q, bf16* O, const UnitDesc U, const float slope2, const float lam, const float* subg) {
    int tid_l = threadIdx.x; asm volatile("" : "+v"(tid_l));
    const int tid = tid_l, lane = tid & 63, r32 = lane & 31, hi = lane >> 5; const int wid = __builtin_amdgcn_readfirstlane(tid >> 6), rg = wid & 3, cc = wid >> 2;
    const unsigned lds0 = (unsigned)(uintptr_t)lds;
    const lcp L3 = (lcp)lds;
    const int qrow = U.qrow0 + (U.sample ? 0 : 32 * rg) + r32;
    const int qpos = U.sample ? 2064 + r32 : qrow;
    const int t_first = U.sample ? 0 : 1 - (rg >> 1);
    const bool wactive = U.sample ? (rg == 0) : true;
    const int NT = U.NT;
    const int kkey0 = 8 * wid + (lane >> 4);
    const bf16* ksrc = U.Kb + (size_t)kkey0 * DM + U.h * 128 + (((lane & 15) ^ (kkey0 & 15)) * 8);
    const bf16* ksrc2 = U.Kb + (size_t)(kkey0 + 4) * DM + U.h * 128 + (((lane & 15) ^ ((kkey0 + 4) & 15)) * 8);
    const bf16* vsrc = U.Vb + (size_t)(32 * (wid & 1) + (lane >> 2)) * DM + U.h * 128 + (wid >> 1) * 32 + (lane & 3) * 8;
    const unsigned kdst = lds0 + 2048u * (unsigned)wid, vdst = lds0 + VRING + 2048u * (unsigned)wid;
#define ATT_DMA_K(t) do { int kb_ = U.kb0 - 64 * (t); kb_ = kb_ < 0 ? 0 : kb_; const size_t ro_ = (size_t)kb_ * DM; const unsigned so_ = (unsigned)(((t) & 3) * KSLOT); \
        glds16(ksrc + ro_, (unsigned)__builtin_amdgcn_readfirstlane(kdst + so_)); glds16(ksrc2 + ro_, (unsigned)__builtin_amdgcn_readfirstlane(kdst + so_ + 1024u)); } while (0)
#define ATT_DMA_V(t) do { int kb_ = U.kb0 - 64 * (t); kb_ = kb_ < 0 ? 0 : kb_; const size_t ro_ = (size_t)kb_ * DM; const unsigned so_ = (unsigned)(((t) & 3) * KSLOT); \
        glds16(vsrc + ro_, (unsigned)__builtin_amdgcn_readfirstlane(vdst + so_)); glds16(vsrc + ro_ + 16 * DM, (unsigned)__builtin_amdgcn_readfirstlane(vdst + so_ + 1024u)); } while (0)
    bf16x8 qf[4];
    { const bf16* qp = Q + (size_t)qrow * DM + U.h * 128 + cc * 64 + hi * 8;
#pragma unroll
      for (int d0 = 0; d0 < 4; ++d0) qf[d0] = *(const GAS bf16x8*)(qp + d0 * 16); }
    asm volatile("s_waitcnt vmcnt(0)" ::: "memory");
    ATT_DMA_K(0); ATT_DMA_V(0);
    if (NT > 1) { ATT_DMA_K(1); ATT_DMA_V(1); }
    if (NT > 2) ATT_DMA_K(2);
    const bool dyn = U.dyn != 0;
    float m = dyn ? 0.f : U.mref, l = 0.f; bool first = dyn;
    f32x16 o[4];
#pragma unroll
    for (int d = 0; d < 4; ++d)
#pragma unroll
        for (int r = 0; r < 16; ++r) o[d][r] = 0.f;
    f32x16 pA0, pA1; v4u pw[4];
#define ATT_QK(tt, P0, P1) do { int kb = U.kb0 - 64 * (tt); kb = kb < 0 ? 0 : kb; \
        const bool gen = ((tt) == t_first) || (!U.sample && (tt) == U.NTF - 1); \
        if (gen) { const int vhi = (!U.sample && (tt) == U.NTF - 1) ? 16 : (U.sample ? 2080 : (1 << 30)); \
            _Pragma("unroll") for (int r = 0; r < 16; ++r) { const int kp = kb + crow(r, hi); \
                P0[r] = kp < vhi ? -slope2 * __builtin_fabsf((float)(qpos - kp)) - m : -INFINITY; \
                P1[r] = kp + 32 < vhi ? -slope2 * __builtin_fabsf((float)(qpos - kp - 32)) - m : -INFINITY; } \
        } else { const float tb = slope2 * (float)(kb + 4 * hi - qpos) - m; \
            const float s8_ = 8.0f * slope2, s32_ = 32.0f * slope2; \
            _Pragma("unroll") for (int r = 0; r < 16; ++r) { P0[r] = (r == 0) ? tb : ((r & 3) == 0 ? P0[r - 4] + s8_ : P0[r - 1] + slope2); P1[r] = P0[r] + s32_; } } \
        const lcp kp_ = L3 + (unsigned)(((tt) & 3) * KSLOT) + r32 * 256; \
        bf16x8 ka0_[2], ka1_[2]; { const int po_ = ((8 * cc + hi) ^ (r32 & 15)) * 16; ka0_[0] = *(const LAS bf16x8*)(kp_ + po_); ka1_[0] = *(const LAS bf16x8*)(kp_ + po_ + 32 * 256); }     \
        _Pragma("unroll") for (int d0 = 0; d0 < 4; ++d0) { \
            if (d0 + 1 < 4) { const int po_ = ((8 * cc + 2 * (d0 + 1) + hi) ^ (r32 & 15)) * 16; ka0_[(d0 + 1) & 1] = *(const LAS bf16x8*)(kp_ + po_); ka1_[(d0 + 1) & 1] = *(const LAS bf16x8*)(kp_ + po_ + 32 * 256); } \
            P0 = __builtin_amdgcn_mfma_f32_32x32x16_bf16(ka0_[d0 & 1], qf[d0], P0, 0, 0, 0); P1 = __builtin_amdgcn_mfma_f32_32x32x16_bf16(ka1_[d0 & 1], qf[d0], P1, 0, 0, 0); } } while (0)
#define ATT_PV(tt) do { const lcp vp = L3 + VRING + (unsigned)(((tt) & 3) * KSLOT) + (4 * hi + ((lane & 15) >> 2)) * 64 + ((lane >> 4) & 1) * 32 + (lane & 3) * 8; \
        s16x4 vl_[3], vh_[3]; vl_[0] = vtr(vp); vh_[0] = vtr(vp + 512); vl_[1] = vtr(vp + 1024); vh_[1] = vtr(vp + 1024 + 512);     \
        _Pragma("unroll") for (int i16 = 0; i16 < 16; ++i16) { const int db = i16 >> 2, ks = i16 & 3; \
            if (i16 + 2 < 16) { vl_[(i16 + 2) % 3] = vtr(vp + (i16 + 2) * 1024); vh_[(i16 + 2) % 3] = vtr(vp + (i16 + 2) * 1024 + 512); } \
            const s16x4 lo = vl_[i16 % 3], hh = vh_[i16 % 3]; \
            const bf16x8 a = (bf16x8){lo[0], lo[1], lo[2], lo[3], hh[0], hh[1], hh[2], hh[3]}; \
            o[db] = __builtin_amdgcn_mfma_f32_32x32x16_bf16(a, __builtin_bit_cast(bf16x8, pw[ks]), o[db], 0, 0, 0); } \
        __builtin_amdgcn_sched_barrier(0); } while (0)
#define ATT_STEP(t, PC0, PC1) do { \
        { const int nw_ = (((t) + 2 < NT) ? 2 : 0) + (((t) + 1 < NT) ? 2 : 0); if (nw_ == 4) { ATT_WAIT_BAR(4); } else if (nw_ == 2) { ATT_WAIT_BAR(2); } else { ATT_WAIT_BAR(0); } } \
        if ((t) + 3 < NT) ATT_DMA_K((t) + 3); \
        if ((t) + 2 < NT) ATT_DMA_V((t) + 2); \
        if (pvpend) { ATT_PV((t) - 1); pvpend = false; } \
        if (wactive && (t) >= t_first) { \
            ATT_QK(t, PC0, PC1); \
            if (dyn) { \
                float mx = __builtin_fmaxf(PC0[0], PC1[0]); \
                _Pragma("unroll") for (int r = 1; r < 16; ++r) mx = __builtin_fmaxf(mx, __builtin_fmaxf(PC0[r], PC1[r])); \
                { auto rr = __builtin_amdgcn_permlane32_swap(__float_as_uint(mx), __float_as_uint(mx), false, false); mx = __builtin_fmaxf(__uint_as_float(rr[0]), __uint_as_float(rr[1])); } \
                if (first || __any(mx > (float)THR)) { \
                    const float dl = first ? mx : __builtin_fmaxf(mx, 0.f); m += dl; \
                    _Pragma("unroll") for (int r = 0; r < 16; ++r) { PC0[r] -= dl; PC1[r] -= dl; } \
                    if (!first) { const float f = __builtin_amdgcn_exp2f(-dl); l *= f; \
                        _Pragma("unroll") for (int d = 0; d < 4; ++d) _Pragma("unroll") for (int r = 0; r < 16; ++r) o[d][r] *= f; } \
                    first = false; } } \
            float sacc = 0.f; \
            _Pragma("unroll") for (int r = 0; r < 16; ++r) { PC0[r] = __builtin_amdgcn_exp2f(PC0[r]); PC1[r] = __builtin_amdgcn_exp2f(PC1[r]); sacc += PC0[r] + PC1[r]; } \
            l += sacc; \
            _Pragma("unroll") for (int j = 0; j < 4; ++j) { pw[0][j] = cvtpk(PC0[2 * j], PC0[2 * j + 1]); pw[1][j] = cvtpk(PC0[8 + 2 * j], PC0[8 + 2 * j + 1]); pw[2][j] = cvtpk(PC1[2 * j], PC1[2 * j + 1]); pw[3][j] = cvtpk(PC1[8 + 2 * j], PC1[8 + 2 * j + 1]); } \
            if (cc == 0) { ATT_PV(t); } else pvpend = true; \
        } } while (0)
    if (NT > 2) { ATT_WAIT_BAR(6); } else if (NT > 1) { ATT_WAIT_BAR(4); } else { ATT_WAIT_BAR(0); }
    bool pvpend = false;
    for (int t = 0; t < NT; ++t) ATT_STEP(t, pA0, pA1);
    if (pvpend) ATT_PV(NT - 1);
#undef ATT_QK
#undef ATT_PV
#undef ATT_STEP
    { auto rr = __builtin_amdgcn_permlane32_swap(__float_as_uint(l), __float_as_uint(l), false, false); l = __uint_as_float(rr[0]) + __uint_as_float(rr[1]); }
    ATT_WAIT_BAR(0);
    const float inv = 1.0f / l;
    if (wactive && cc == 1) { const float sc = inv * lam;
#pragma unroll
        for (int db = 0; db < 4; ++db)
#pragma unroll
            for (int r = 0; r < 16; ++r) *(LAS float*)(lds + rg * 16384 + ((db * 16 + r) * 64 + lane) * 4) = o[db][r] * sc; }
    ATT_WAIT_BAR(0);
    if (wactive && cc == 0) {
        float ss = 0.f;
#pragma unroll
        for (int db = 0; db < 4; ++db)
#pragma unroll
            for (int r = 0; r < 16; ++r) { const float x = *(const LAS float*)(lds + rg * 16384 + ((db * 16 + r) * 64 + lane) * 4); const float d = o[db][r] * inv - x; o[db][r] = d; ss += d * d; }
        { auto rr = __builtin_amdgcn_permlane32_swap(__float_as_uint(ss), __float_as_uint(ss), false, false); ss = __uint_as_float(rr[0]) + __uint_as_float(rr[1]); }
        const float rs = __builtin_amdgcn_rsqf(ss * (1.0f / 128.0f) + 1e-6f) * (1.0f - LAM_INIT);
        LAS unsigned char* stg = lds + STG_OFF + rg * (32 * STG_ROW);
#pragma unroll
        for (int db = 0; db < 4; ++db)
#pragma unroll
            for (int rq = 0; rq < 4; ++rq) { const int dv = 32 * db + 8 * rq + 4 * hi; const f32x4 g = *(const GAS f32x4*)(subg + dv);
                v2u w; w.x = cvtpk(o[db][4 * rq] * rs * g[0], o[db][4 * rq + 1] * rs * g[1]); w.y = cvtpk(o[db][4 * rq + 2] * rs * g[2], o[db][4 * rq + 3] * rs * g[3]);
                *(LAS v2u*)(stg + r32 * STG_ROW + dv * 2) = w; }
        asm volatile("s_waitcnt lgkmcnt(0)" ::: "memory");
        bf16* Ow = O + (size_t)(U.qrow0 + (U.sample ? 0 : 32 * rg)) * DM + U.h * 128;
#pragma unroll
        for (int it = 0; it < 8; ++it) { const int row = it * 4 + (lane >> 4), chk = lane & 15; const v4u vv = *(const LAS v4u*)(stg + row * STG_ROW + chk * 16);
            if (row < U.nvalid) *(GAS v4u*)(Ow + (size_t)row * DM + chk * 8) = vv; }
    }
    asm volatile("s_waitcnt vmcnt(0)" ::: "memory");
    ATT_WAIT_BAR(0);
#undef ATT_DMA_K
#undef ATT_DMA_V
}
__device__ __forceinline__ void attn_unit_p(LAS unsigned char* lds, const bf16* Q, bf16* O, const UnitDesc U, const float slope2, volatile LAS unsigned* lamp, const float* subg) {
    int tid_l = threadIdx.x; asm volatile("" : "+v"(tid_l));
    const int tid = tid_l, lane = tid & 63, r32 = lane & 31, hi = lane >> 5; const int wid = __builtin_amdgcn_readfirstlane(tid >> 6);
    const unsigned lds0 = (unsigned)(uintptr_t)lds;
    const lcp L3 = (lcp)lds;
    const int qpos = U.qrow0 + 32 * wid + r32;
    const int t_first = 3 - (wid >> 1);
    const int NT = U.NT;
    const int kkey0 = 8 * wid + (lane >> 4);
    const bf16* ksrc = U.Kb + (size_t)kkey0 * DM + U.h * 128 + (((lane & 15) ^ (kkey0 & 15)) * 8);
    const int kd2 = 4 * DM + (((((lane & 15) ^ (kkey0 & 15)) & 4) != 0) ? -32 : 32);
    const bf16* vsrc = U.Vb + (size_t)(32 * (wid & 1) + (lane >> 2)) * DM + U.h * 128 + (wid >> 1) * 32 + (lane & 3) * 8;
    const unsigned kxo = (unsigned)(r32 * 256 + ((hi ^ (r32 & 15)) * 16));
    const unsigned kdst = lds0 + 2048u * (unsigned)wid, vdst = lds0 + 32768u + 2048u * (unsigned)wid;
#define ATT_DMA2(t) do { int kb_ = U.kb0 - 64 * (t); kb_ = kb_ < 0 ? 0 : kb_; const size_t ro_ = (size_t)kb_ * DM; const unsigned so_ = (unsigned)(((t) & 1) * KSLOT); \
        glds16(ksrc + ro_, (unsigned)__builtin_amdgcn_readfirstlane(kdst + so_)); glds16(ksrc + ro_ + kd2, (unsigned)__builtin_amdgcn_readfirstlane(kdst + so_ + 1024u)); \
        glds16(vsrc + ro_, (unsigned)__builtin_amdgcn_readfirstlane(vdst + so_)); glds16(vsrc + ro_ + 16 * DM, (unsigned)__builtin_amdgcn_readfirstlane(vdst + so_ + 1024u)); } while (0)
    const lcp qb_ = L3 + 65536 + wid * 8192 + lane * 16;
    { const bf16* qp = Q + (size_t)qpos * DM + U.h * 128 + hi * 8;
      bf16x8 qv[8];
#pragma unroll
      for (int f = 0; f < 8; ++f) qv[f] = *(const GAS bf16x8*)(qp + (f >> 2) * 64 + (f & 3) * 16);
#pragma unroll
      for (int f = 0; f < 8; ++f) *(LAS bf16x8*)(lds + 65536 + wid * 8192 + f * 1024 + lane * 16) = qv[f]; }
    asm volatile("s_waitcnt vmcnt(0) lgkmcnt(0)" ::: "memory");
    ATT_DMA2(0);
    const float mref = U.mref < 60.0f ? U.mref : 60.0f;
    f32x2 l0v = (f32x2){0.f, 0.f}, l1v = l0v;
    f32x16 o[2][4];
#pragma unroll
    for (int c = 0; c < 2; ++c)
#pragma unroll
        for (int d = 0; d < 4; ++d)
#pragma unroll
            for (int r = 0; r < 16; ++r) o[c][d][r] = 0.f;
    ATT_WAIT_BAR(0);
    for (int t = 0; t < NT; ++t) {
        if (t + 1 < NT) ATT_DMA2(t + 1);
        if (t >= t_first) {
            int kb = U.kb0 - 64 * t; kb = kb < 0 ? 0 : kb;
            const bool gen = (t == t_first) || (t == U.NTF - 1);
            const int vhi = (t == U.NTF - 1) ? 16 : (1 << 30);
            unsigned kxt = kxo + (unsigned)((t & 1) * KSLOT); asm volatile("" : "+v"(kxt));
            const lcp vp = L3 + 32768 + (unsigned)((t & 1) * KSLOT) + (4 * hi + ((lane & 15) >> 2)) * 64 + ((lane >> 4) & 1) * 32 + (lane & 3) * 8;
#pragma unroll
            for (int hf = 0; hf < 2; ++hf) {
                v4u pw[2][2];
#pragma unroll
                for (int c = 0; c < 2; ++c) {
                    f32x16 pp;
                    { const float tb = slope2 * (float)(kb + 32 * hf + 4 * hi - qpos), s8_ = 8.0f * slope2;
                      if (gen) {
                          const int thr = vhi - kb - 32 * hf - 4 * hi; float x = tb;
#pragma unroll
                          for (int r = 0; r < 16; ++r) { const int cr = (r & 3) + 8 * (r >> 2); x = (r == 0) ? tb : ((r & 3) == 0 ? x + (s8_ - 3.0f * slope2) : x + slope2); pp[r] = cr < thr ? -__builtin_fabsf(x) - mref : -INFINITY; }
                      } else { const float tb2 = tb - mref;
                          f32x2 b01 = (f32x2){tb2, tb2 + slope2}, b23 = b01 + (f32x2){2.0f * slope2, 2.0f * slope2};
#pragma unroll
                          for (int q4 = 0; q4 < 4; ++q4) { pp[4 * q4] = b01.x; pp[4 * q4 + 1] = b01.y; pp[4 * q4 + 2] = b23.x; pp[4 * q4 + 3] = b23.y; if (q4 < 3) { b01 += (f32x2){s8_, s8_}; b23 += (f32x2){s8_, s8_}; } } } }
                    {
                        bf16x8 ka[3], qa[3];
                        ka[0] = *(const LAS bf16x8*)(L3 + ((kxt ^ (unsigned)((8 * c) * 16)) + (unsigned)(hf * 32 * 256))); qa[0] = *(const LAS bf16x8*)(qb_ + (4 * c) * 1024);
                        ka[1] = *(const LAS bf16x8*)(L3 + ((kxt ^ (unsigned)((8 * c + 2) * 16)) + (unsigned)(hf * 32 * 256))); qa[1] = *(const LAS bf16x8*)(qb_ + (4 * c + 1) * 1024);
#pragma unroll
                        for (int d0 = 0; d0 < 4; ++d0) {
                            if (d0 + 2 < 4) { ka[(d0 + 2) % 3] = *(const LAS bf16x8*)(L3 + ((kxt ^ (unsigned)((8 * c + 2 * (d0 + 2)) * 16)) + (unsigned)(hf * 32 * 256))); qa[(d0 + 2) % 3] = *(const LAS bf16x8*)(qb_ + (4 * c + d0 + 2) * 1024); }
                            pp = __builtin_amdgcn_mfma_f32_32x32x16_bf16(ka[d0 % 3], qa[d0 % 3], pp, 0, 0, 0); } }
#pragma unroll
                    for (int r = 0; r < 16; ++r) pp[r] = __builtin_amdgcn_exp2f(pp[r]);
#pragma unroll
                    for (int r = 0; r < 16; r += 2) { if (c == 0) l0v += (f32x2){pp[r], pp[r + 1]}; else l1v += (f32x2){pp[r], pp[r + 1]}; }
#pragma unroll
                    for (int j = 0; j < 4; ++j) { pw[c][0][j] = cvtpk(pp[2 * j], pp[2 * j + 1]); pw[c][1][j] = cvtpk(pp[8 + 2 * j], pp[8 + 2 * j + 1]); }
                }
                {
                    s16x4 vlo[3], vhh[3];
                    vlo[0] = vtr(vp + (2 * hf) * 1024); vhh[0] = vtr(vp + (2 * hf) * 1024 + 512);
                    vlo[1] = vtr(vp + (2 * hf + 1) * 1024); vhh[1] = vtr(vp + (2 * hf + 1) * 1024 + 512);
#pragma unroll
                    for (int i8 = 0; i8 < 8; ++i8) { const int db = i8 >> 1, k2 = i8 & 1;
                        if (i8 + 2 < 8) { const int dn = (i8 + 2) >> 1, kn = 2 * hf + ((i8 + 2) & 1); vlo[(i8 + 2) % 3] = vtr(vp + (dn * 4 + kn) * 1024); vhh[(i8 + 2) % 3] = vtr(vp + (dn * 4 + kn) * 1024 + 512); }
                        const s16x4 lo = vlo[i8 % 3], hh = vhh[i8 % 3];
                        const bf16x8 a = (bf16x8){lo[0], lo[1], lo[2], lo[3], hh[0], hh[1], hh[2], hh[3]};
                        o[0][db] = __builtin_amdgcn_mfma_f32_32x32x16_bf16(a, __builtin_bit_cast(bf16x8, pw[0][k2]), o[0][db], 0, 0, 0);
                        o[1][db] = __builtin_amdgcn_mfma_f32_32x32x16_bf16(a, __builtin_bit_cast(bf16x8, pw[1][k2]), o[1][db], 0, 0, 0); } }
                __builtin_amdgcn_sched_barrier(0);
            }
        }
        ATT_WAIT_BAR(0);
    }
    {
        float l0 = l0v.x + l0v.y, l1 = l1v.x + l1v.y;
        { auto rr = __builtin_amdgcn_permlane32_swap(__float_as_uint(l0), __float_as_uint(l0), false, false); l0 = __uint_as_float(rr[0]) + __uint_as_float(rr[1]); }
        { auto rr = __builtin_amdgcn_permlane32_swap(__float_as_uint(l1), __float_as_uint(l1), false, false); l1 = __uint_as_float(rr[0]) + __uint_as_float(rr[1]); }
        const float i0 = 1.0f / l0, i1 = __uint_as_float(lamp[0]) / l1;
        float ss = 0.f;
#pragma unroll
        for (int db = 0; db < 4; ++db)
#pragma unroll
            for (int r = 0; r < 16; ++r) { const float d = o[0][db][r] * i0 - o[1][db][r] * i1; o[0][db][r] = d; ss += d * d; }
        { auto rr = __builtin_amdgcn_permlane32_swap(__float_as_uint(ss), __float_as_uint(ss), false, false); ss = __uint_as_float(rr[0]) + __uint_as_float(rr[1]); }
        const float rs = __builtin_amdgcn_rsqf(ss * (1.0f / 128.0f) + 1e-6f) * (1.0f - LAM_INIT);
        LAS unsigned char* stg = lds + 65536 + wid * 8192;
        const float* sg_ = subg; asm volatile("" : "+s"(sg_));
#pragma unroll
        for (int db = 0; db < 4; ++db)
#pragma unroll
            for (int rq = 0; rq < 4; ++rq) { const int dv = 32 * db + 8 * rq + 4 * hi; const f32x4 g = *(const GAS f32x4*)(sg_ + dv);
                v2u w; w.x = cvtpk(o[0][db][4 * rq] * rs * g[0], o[0][db][4 * rq + 1] * rs * g[1]); w.y = cvtpk(o[0][db][4 * rq + 2] * rs * g[2], o[0][db][4 * rq + 3] * rs * g[3]);
                *(LAS v2u*)(stg + r32 * 256 + dv * 2) = w; }
        asm volatile("s_waitcnt lgkmcnt(0)" ::: "memory");
        bf16* Ow = O + (size_t)(U.qrow0 + 32 * wid) * DM + U.h * 128;
#pragma unroll
        for (int it = 0; it < 8; ++it) { const int row = it * 4 + (lane >> 4), chk = lane & 15; const v4u vv = *(const LAS v4u*)(stg + row * 256 + chk * 16);
            *(GAS v4u*)(Ow + (size_t)row * DM + chk * 8) = vv; }
    }
    asm volatile("s_waitcnt vmcnt(0) lgkmcnt(0)" ::: "memory");
    ATT_WAIT_BAR(0);
#undef ATT_DMA2
}
}


__device__ __forceinline__ void attn_conv_unit(CArgs& args, int cu) {
    int tid_l = threadIdx.x; asm volatile("" : "+v"(tid_l));
    const int lane = tid_l & 63, wave = __builtin_amdgcn_readfirstlane(tid_l >> 6);
    const __amdgpu_buffer_rsrc_t rs = __builtin_amdgcn_make_buffer_rsrc(P_KS, 0, (int)(264 * MiB), 0x00020000);
#pragma unroll 1
    for (int k = 0; k < 16; k += 2) {
        f32x4 va[2][8];
#pragma unroll
        for (int rr = 0; rr < 2; ++rr) { const int ri = 128 * cu + 16 * wave + k + rr, which = ri >> 15, idx = ri & 32767;
            const float* src = (which ? P_IN(I_CV) : P_IN(I_CK)) + (size_t)idx * DM;
#pragma unroll
            for (int j = 0; j < 4; ++j) { va[rr][2 * j] = *(const GAS f32x4*)(src + 512 * j + 8 * lane); va[rr][2 * j + 1] = *(const GAS f32x4*)(src + 512 * j + 8 * lane + 4); } }
#pragma unroll
        for (int rr = 0; rr < 2; ++rr) { const int ri = 128 * cu + 16 * wave + k + rr, which = ri >> 15, idx = ri & 32767, b = idx >> 11, p = idx & 2047;
            const unsigned off = (unsigned)(((size_t)which * 16 * KS_ROWS + (size_t)b * KS_ROWS + 16 + p) * DM * 2);
#pragma unroll
            for (int j = 0; j < 4; ++j) { const f32x4 a = va[rr][2 * j], bq = va[rr][2 * j + 1];
                v4u o; o.x = pk2(a[0], a[1]); o.y = pk2(a[2], a[3]); o.z = pk2(bq[0], bq[1]); o.w = pk2(bq[2], bq[3]);
                __builtin_amdgcn_raw_buffer_store_b128(o, rs, (int)(off + (unsigned)(512 * j + 8 * lane) * 2u), 0,   16); } }
    }
    asm volatile("s_waitcnt vmcnt(0)" ::: "memory");
    __syncthreads();
    if (threadIdx.x == 0) { const int b = ((128 * cu) & 32767) >> 11; __hip_atomic_fetch_add((unsigned*)(P_CTL + CW_SCONV) + 16 * b, 1u, __ATOMIC_RELAXED, __HIP_MEMORY_SCOPE_AGENT); }
}
__device__ __forceinline__ void attn_phase(const Frame& F, CArgs& args) {
    int ln = threadIdx.x & 63; asm volatile("" : "+v"(ln));
    float lam;
    { const float* dl = P_IN(I_DLAM); const float a = wave_sum(dl[ln] * dl[64 + ln]), b = wave_sum(dl[128 + ln] * dl[192 + ln]); lam = __expf(a) - __expf(b) + LAM_INIT; }
    float tcut, smax2;
    { float mq = __builtin_fabsf(P_IN(I_QNORM)[ln]), mk = __builtin_fabsf(P_IN(I_KNORM)[ln]);
#pragma unroll
      for (int o = 1; o < 64; o <<= 1) { mq = __builtin_fmaxf(mq, __shfl_xor(mq, o)); mk = __builtin_fmaxf(mk, __shfl_xor(mk, o)); }
      tcut = 2.0f * (8.0f * mq * mk * 1.02f) + 106.0f; smax2 = 8.0f * mq * mk * 1.02f * LOG2E; }
    if (threadIdx.x == 0) { F.MISC[20] = __float_as_uint(lam); F.MISC[21] = __float_as_uint(tcut); F.MISC[22] = __float_as_uint(smax2); }
    __syncthreads();
    const bf16* Q = P_ACT; bf16* O = P_A3;
    const int nun = 1024 + 512 + 256;
    unsigned* qctr = (unsigned*)(P_CTL + CW_ATTQ);
    for (;;) {
        if (threadIdx.x == 0) F.MISC[16] = atomicAdd(qctr, 1u);
        __syncthreads();
        const int idx = (int)F.MISC[16];
        if (idx >= nun) break;
        int uid, sunit = -1;
        if (idx < 256) uid = idx;
        else if (idx < 1280) { const int g = (idx - 256) >> 1; if (idx & 1) { attn_conv_unit(args, g); continue; } uid = 256 + g; }
        else { const int g = (idx - 1280) >> 1; if (idx & 1) sunit = g; uid = 768 + g; }
        const float tcut_u = __uint_as_float((unsigned)__builtin_amdgcn_readfirstlane((int)F.MISC[21])), smax2_u = __uint_as_float((unsigned)__builtin_amdgcn_readfirstlane((int)F.MISC[22]));
        att::UnitDesc U;
        if (sunit < 0) { const int jb = 63 - (uid >> 4); U.h = 15 - (uid & 15); U.Kb = P_KP; U.Vb = P_VP; U.qrow0 = 16 + 256 * jb; U.kb0 = 16 + 64 * (4 * jb + 3); U.NTF = 4 * jb + 5; U.sample = 0; U.nvalid = 32;
            const float slope = exp2f(-0.5f * (float)(U.h + 1));
            const float w = (tcut_u / slope + 255.0f) * (1.0f / 64.0f); const int wt = w > 1000.f ? 1000 : (int)w + 1;
            U.NT = wt < U.NTF ? wt : U.NTF; U.dyn = smax2_u < 40.0f ? 0 : 1; U.mref = smax2_u; }
        else {
            const int b = sunit >> 4;
            if (threadIdx.x == 0) { unsigned* cw = (unsigned*)(P_CTL + CW_SCONV) + 16 * b; unsigned sp = 0;
                while (__hip_atomic_load(cw, __ATOMIC_RELAXED, __HIP_MEMORY_SCOPE_AGENT) < 32u && ++sp < (1u << 22)) __builtin_amdgcn_s_sleep(2);
                __builtin_amdgcn_fence(__ATOMIC_ACQUIRE, "agent"); asm volatile("s_waitcnt vmcnt(0)" ::: "memory"); }
            __syncthreads();
            U.h = sunit & 15; U.Kb = P_KS + (size_t)b * KS_ROWS * DM; U.Vb = P_VS + (size_t)b * KS_ROWS * DM; U.qrow0 = ROW_S0 + 16 * b; U.kb0 = 2048; U.NT = 33; U.NTF = 33; U.sample = 1; U.nvalid = 16; U.dyn = 1; U.mref = 0.f; }
        const float slope2 = exp2f(-0.5f * (float)(U.h + 1)) * LOG2E;
        if (sunit < 0) att::attn_unit_p(F.lds + RING_OFF, Q, O, U, slope2, F.MISC + 20, P_IN(I_SUBNORM)); else att::attn_unit_s<8>(F.lds + RING_OFF, Q, O, U, slope2, __uint_as_float(F.MISC[20]), P_IN(I_SUBNORM));
    }
}

__global__ void __launch_bounds__(NWAVES * 64, 2) fwd_kernel(Args args_kv) {
    extern __shared__ __attribute__((aligned(16))) unsigned char lds[];
    Frame F;
    F.lds = (LAS unsigned char*)lds;
    F.MISC = (volatile LAS unsigned*)(F.lds + MISC_OFF);
    F.tid = threadIdx.x; F.lane = F.tid & 63; F.wave = __builtin_amdgcn_readfirstlane(F.tid >> 6); F.G = gridDim.x;
    for (int u = F.tid; u < (LDS_BYTES - LDSCTL_OFF) / 4; u += NWAVES * 64) ((LAS unsigned*)(F.lds + LDSCTL_OFF))[u] = 0u;
    __syncthreads();
    const Args& args = args_kv;
    const int lo = args.ph_lo, hi = args.ph_hi;
    XcdBarrier bar; bar.bar = (unsigned*)(P_CTL + CW_BAR); bar.x = 0; bar.st = nullptr;
    if (hi - lo > 1) bar = xcd_barrier_post((unsigned*)(P_CTL + CW_BAR), F.MISC + 8);
    int ph = 0;
#define RUN() (ph >= lo && ph < hi)
#define SEAM() do { if (ph >= lo && ph + 1 < hi) xcd_barrier(bar); ++ph; } while (0)
#define SEAM_NOBAR() do { if (MK_PER_PHASE) { SEAM(); } else { ++ph; } } while (0)

    if (RUN() && EN_P0) p0_prologue(F, *largs());
    SEAM();
    for (int ls = 0; ls < 4; ++ls) {
        if (RUN() && EN_GU) {
            CArgs& args = *largs();
            pg8::Gemm g{P_X16, P_WGU + (size_t)ls * 11264 * DM, MROWS, 11264, DM}; pg8::SplitOrder S; S.init(11264, DM, F.G, lbid(), 2, ph * 128, P_SLAB, P_SCNT, 120, 1);
            const int si = ls == 0 ? 0 : ls == 1 ? 2 : ls == 2 ? 3 : 5;
            pg8::EpiGU E{P_HID, P_SSQ + (size_t)si * MROWS};
            pg8::gemm_phase<pg8::EpiGU, pg8::SplitOrder, PG8_ALIGN, PG8_SP2>(F.lds + RING_OFF, g, S, E);
        }
        SEAM();
        if (RUN() && EN_DN) {
            CArgs& args = *largs();
            pg8::Gemm g{P_HID, P_WDN + (size_t)ls * DM * DFF, MROWS, DM, DFF}; pg8::SplitOrder S; S.init(DM, DFF, F.G, lbid(), 8, ph * 128, P_SLAB, P_SCNT);
            const int so = ls == 0 ? 1 : ls == 1 ? 3 : ls == 2 ? 4 : 0;
            pg8::EpiRes E{P_X16, P_SSQ + (size_t)so * MROWS, 0.5f, ls == 3 ? 1 : 0, P_OUT + O_YP, P_OUT + O_YS};
            pg8::gemm_phase<pg8::EpiRes, pg8::SplitOrder, PG8_ALIGN, PG8_SP2>(F.lds + RING_OFF, g, S, E);
        }
        SEAM();
        if (ls == 0) {
            if (RUN() && EN_WIN) {
            CArgs& args = *largs();
                pg8::Gemm g{P_X16, P_WIN, MROWS, 4096, DM}; pg8::SplitOrder S; S.init(4096, DM, F.G, lbid(), 4, ph * 128, P_SLAB, P_SCNT);
                pg8::EpiWin E{P_GG, P_XB, P_SSQ + (size_t)1 * MROWS};
                pg8::gemm_phase<pg8::EpiWin, pg8::SplitOrder, PG8_ALIGN, PG8_SP2>(F.lds + RING_OFF, g, S, E);
            }
            SEAM();
            if (RUN() && EN_RG0) rg_phase<0>(F, *largs());
            SEAM();
            if (RUN() && EN_RG1) rg_phase<1>(F, *largs());
            SEAM();
        } else if (ls == 1) {
            if (RUN() && EN_KV) {
            CArgs& args = *largs();
                pg8::Gemm g{P_X16, P_WKV, MROWS, 4096, DM}; pg8::SplitOrder S; S.init(4096, DM, F.G, lbid(), 4, ph * 128, P_SLAB + (size_t)256 * 32768, P_SCNT);
                pg8::EpiKV E{P_SSQ + (size_t)3 * MROWS, P_IN(I_KNORM), P_OUT + O_KP, P_OUT + O_VP, P_OUT + O_KS, P_OUT + O_VS, P_KP, P_VP, P_KS, P_VS};
                pg8::gemm_phase<pg8::EpiKV, pg8::SplitOrder, PG8_ALIGN, PG8_SP2>(F.lds + RING_OFF, g, S, E);
            }
            SEAM_NOBAR();
        } else if (ls == 2) {
            if (RUN() && EN_Q) {
            CArgs& args = *largs();
                pg8::Gemm g{P_X16, P_WQ, MROWS, DM, DM}; pg8::SplitOrder S; S.init(DM, DM, F.G, lbid(), 4, ph * 128, P_SLAB, P_SCNT);
                pg8::EpiQ E{P_SSQ + (size_t)4 * MROWS, P_IN(I_QNORM), P_ACT, 0.125f * LOG2E};
                pg8::gemm_phase<pg8::EpiQ, pg8::SplitOrder, PG8_ALIGN, PG8_SP2>(F.lds + RING_OFF, g, S, E);
            }
            SEAM();
            if (RUN() && EN_ATT) attn_phase(F, *largs());
            SEAM();
        }
        if (ls == 0 || ls == 2) {
            if (RUN() && EN_RES) {
            CArgs& args = *largs();
                pg8::Gemm g{ls == 0 ? P_ACT : P_A3, ls == 0 ? P_WOUT : P_WO, MROWS, DM, DM}; pg8::SplitOrder S; S.init(DM, DM, F.G, lbid(), 4, ph * 128, P_SLAB, P_SCNT);
                pg8::EpiRes E{P_X16, P_SSQ + (size_t)(ls == 0 ? 2 : 5) * MROWS, 1.0f, 0, P_OUT + O_YP, P_OUT + O_YS};
                pg8::gemm_phase<pg8::EpiRes, pg8::SplitOrder, PG8_ALIGN, PG8_SP2>(F.lds + RING_OFF, g, S, E);
            }
            SEAM();
        }
    }
#undef RUN
#undef SEAM
}

extern "C" void kernel_launch(void* const* d_in, const int* in_sizes, int n_in, void* d_out, int out_size, void* d_ws, size_t ws_size, hipStream_t stream) {
    static int grid = 0;
    if (grid == 0) {
        if (n_in != 28 || in_sizes[0] != 16384 * DM || (size_t)out_size != O_END || ws_size < WS_END) {
            fprintf(stderr, "kernel_launch: unexpected shapes: n_in %d, in0 %d, out %d, ws %zu (need %zu); nothing launched\n", n_in, n_in > 0 ? in_sizes[0] : -1, out_size, ws_size, (size_t)WS_END); grid = -1; return; }
        int dev = 0, cus = 0, per_cu = 0;
        if (hipGetDevice(&dev) != hipSuccess || hipDeviceGetAttribute(&cus, hipDeviceAttributeMultiprocessorCount, dev) != hipSuccess) { grid = -1; return; }
        if (hipFuncSetAttribute((const void*)fwd_kernel, hipFuncAttributeMaxDynamicSharedMemorySize, LDS_BYTES) != hipSuccess) { fprintf(stderr, "kernel_launch: hipFuncSetAttribute failed\n"); grid = -1; return; }
        if (hipOccupancyMaxActiveBlocksPerMultiprocessor(&per_cu, (const void*)fwd_kernel, NWAVES * 64, LDS_BYTES) != hipSuccess || per_cu < 1) { fprintf(stderr, "kernel_launch: occupancy query says %d blocks per CU\n", per_cu); }
        (void)hipGetLastError();
        grid = cus;
    }
    if (grid < 0) return;
    if (hipMemsetAsync((char*)d_ws + WS_CTL, 0, CTL_ZERO_BYTES, stream) != hipSuccess) return;
    Args a{};
    for (int i = 0; i < 28; ++i) a.in[i] = (const float*)d_in[i];
    a.out = (float*)d_out; a.ws = (unsigned char*)d_ws;
#if MK_PER_PHASE
    for (int p = 0; p < NPHASE; ++p) { a.ph_lo = p; a.ph_hi = p + 1; hipLaunchKernelGGL(fwd_kernel, dim3(grid), dim3(NWAVES * 64), LDS_BYTES, stream, a); }
#else
    a.ph_lo = 0; a.ph_hi = NPHASE;
    hipLaunchKernelGGL(fwd_kernel, dim3(grid), dim3(NWAVES * 64), LDS_BYTES, stream, a);
#endif
    const hipError_t le = hipPeekAtLastError();
    if (le != hipSuccess) fprintf(stderr, "kernel_launch: launch failed: %s\n", hipGetErrorName(le));
}
```
